# Optimizing an MI355X kernel written in HIP

```python
import math
import jax
import jax.numpy as jnp
from jax import lax
import numpy as np

D_MODEL = 2048
BATCH = 2
SEQ = 8192
DEPTH = 4

GRID_W = 64
CTX_LEN = 256

HY_W = 1024
HY_ORDER = 2
HY_EMB = 33
HY_BANDS = (HY_EMB - 1) // 2
HY_HID = 64
HY_FAST_DECAY = 0.3
HY_SLOW_DECAY = 1.5
HY_TARGET = 1e-2

MLA_HEADS = 8
MLA_NOPE = 128
MLA_ROPE = 64
MLA_V = 128
MLA_Q_RANK = 512
MLA_KV_RANK = 256
MLA_SCALE = (MLA_NOPE + MLA_ROPE) ** -0.5
Q_BLOCK = 128
ROPE_BASE = 10000.0

O_HY = 3 * HY_W
O_Q = O_HY + MLA_Q_RANK
O_KV = O_Q + MLA_KV_RANK
IN_W = O_KV + MLA_ROPE

S5_GC = 16
S5_NG = D_MODEL // S5_GC
S5_P = 64
S5_GB = 16
S5_NBLK = S5_NG // S5_GB

PEER_HEADS = 8
PEER_NK = 128
PEER_N = PEER_NK * PEER_NK
PEER_DK = 256
PEER_TOPK = 16
PEER_BLOCK = 128

N_EVEN = (DEPTH + 1) // 2
N_ODD = DEPTH // 2
DN_ALPHA = (2.0 * DEPTH) ** 0.25
DN_BETA = (8.0 * DEPTH) ** -0.25
LN_EPS = 1e-5
RMS_EPS = 1e-6
F32 = jnp.float32

kernel_name = 'hybrid_hyena_mla_s5_peer_dit'


def layer_norm(x, g, b):
    xf = x.astype(F32)
    xc = xf - jnp.mean(xf, axis=-1, keepdims=True)
    var = jnp.mean(xc * xc, axis=-1, keepdims=True)
    return (xc * lax.rsqrt(var + LN_EPS) * g + b).astype(x.dtype)


def rms_norm(x, g):
    xf = x.astype(F32)
    return (xf * lax.rsqrt(jnp.mean(xf * xf, axis=-1, keepdims=True) + RMS_EPS) * g).astype(x.dtype)


def axial_rope(L):
    rows = L // GRID_W
    row = jnp.repeat(jnp.arange(rows), GRID_W).astype(F32)
    col = jnp.tile(jnp.arange(GRID_W), rows).astype(F32)
    half = MLA_ROPE // 2
    inv = ROPE_BASE ** (-jnp.arange(0, half, 2, dtype=F32) / half)
    ar, ac = row[:, None] * inv, col[:, None] * inv
    ang = jnp.concatenate([ar, ar, ac, ac], axis=-1)
    return jnp.cos(ang), jnp.sin(ang)


def apply_axial_rope(x, cos, sin):
    xs = x.reshape(x.shape[:-1] + (2, 2, MLA_ROPE // 4))
    rot = jnp.concatenate([-xs[..., 1:, :], xs[..., :1, :]], axis=-2).reshape(x.shape)
    return (x * cos + rot * sin).astype(x.dtype)


def short_conv3(z, w, b):
    L = z.shape[1]
    zp = jnp.pad(z, ((0, 0), (1, 1), (0, 0)))
    return zp[:, :L] * w[0] + zp[:, 1:L + 1] * w[1] + zp[:, 2:] * w[2] + b


def hyena_pos_features(L):
    t = jnp.linspace(0.0, 1.0, L, dtype=F32)[:, None]
    w = (2.0 * math.pi / L) * jnp.arange(L, dtype=F32)[:, None]
    f = jnp.linspace(1e-4, HY_BANDS - 1, HY_BANDS, dtype=F32)[None, :]
    return jnp.concatenate([t, jnp.cos(f * w), -jnp.sin(f * w)], axis=-1)


def hyena_filter_spectrum(L, w1, b1, w2, b2, w3, b3, w4, freq):
    act = lambda a: jnp.sin(freq * a)
    hdn = act(hyena_pos_features(L) @ w1 + b1)
    hdn = act(hdn @ w2 + b2)
    hdn = act(hdn @ w3 + b3)
    h = (hdn @ w4).astype(F32).reshape(L, 2, HY_ORDER, HY_W)
    deltas = jnp.abs(jnp.linspace(math.log(HY_TARGET) / HY_SLOW_DECAY, math.log(HY_TARGET) / HY_FAST_DECAY,
                                  HY_ORDER * HY_W, dtype=F32)).reshape(HY_ORDER, HY_W)
    t = jnp.linspace(0.0, 1.0, L, dtype=F32)[:, None, None, None]
    h = h * jnp.exp(-t * deltas)
    h = h / jnp.sum(jnp.abs(h), axis=(0, 1), keepdims=True)
    k = jnp.concatenate([h[:, 0], jnp.zeros((1, HY_ORDER, HY_W), F32), h[1:, 1][::-1]], axis=0)
    return jnp.fft.rfft(k, axis=0)


def fft_long_conv(u, k_f):
    L = u.shape[1]
    u_f = jnp.fft.rfft(u.astype(F32), n=2 * L, axis=1)
    return jnp.fft.irfft(u_f * k_f[None], n=2 * L, axis=1)[:, :L]


def hyena_mixer(z, conv_w, conv_b, w1, b1, w2, b2, w3, b3, w4, freq, bias):
    L = z.shape[1]
    zc = short_conv3(z, conv_w, conv_b)
    x1, x2, v = jnp.split(zc, 3, axis=-1)
    k_f = hyena_filter_spectrum(L, w1, b1, w2, b2, w3, b3, w4, freq)
    y = v.astype(F32)
    for o, gate in enumerate((x1, x2)):
        y = gate * (fft_long_conv(y, k_f[:, o]) + y * bias[o])
    return y.astype(z.dtype)


def mla_heads(z, q_norm, w_uq, kv_norm, w_ukv):
    Bn, L, _ = z.shape
    q = (rms_norm(z[..., O_HY:O_Q], q_norm) @ w_uq).reshape(Bn, L, MLA_HEADS, MLA_NOPE + MLA_ROPE)
    kv = (rms_norm(z[..., O_Q:O_KV], kv_norm) @ w_ukv).reshape(Bn, L, MLA_HEADS, MLA_NOPE + MLA_V)
    return q[..., :MLA_NOPE], q[..., MLA_NOPE:], kv[..., :MLA_NOPE], z[..., O_KV:], kv[..., MLA_NOPE:]


def mla_attend(qn, qr, kn, kr, v):
    s = jnp.einsum('bqhd,bkhd->bhqk', qn, kn) + jnp.einsum('bqhr,bkr->bhqk', qr, kr)
    p = jax.nn.softmax(s.astype(F32) * MLA_SCALE, axis=-1).astype(v.dtype)
    return jnp.einsum('bhqk,bkhd->bqhd', p, v)


def even_mixer(in_ctx, in_lat, cos, sin, need_ctx, w_in, hy, mla, w_o):
    z_ctx = in_ctx @ w_in
    z_lat = in_lat @ w_in
    cqn, cqr, ckn, ckr, cv = mla_heads(z_ctx, *mla)
    lqn, lqr, lkn, lkr, lv = mla_heads(z_lat, *mla)
    lqr = apply_axial_rope(lqr, cos[:, None, :], sin[:, None, :])
    lkr = apply_axial_rope(lkr, cos, sin)
    kn = jnp.concatenate([ckn, lkn], axis=1)
    kr = jnp.concatenate([ckr, lkr], axis=1)
    vv = jnp.concatenate([cv, lv], axis=1)
    Bn, L = in_lat.shape[:2]
    nb = L // Q_BLOCK
    blocks = lambda t: t.reshape((Bn, nb, Q_BLOCK) + t.shape[2:]).swapaxes(0, 1)
    att = lax.map(lambda q: mla_attend(q[0], q[1], kn, kr, vv), (blocks(lqn), blocks(lqr)))
    att = att.swapaxes(0, 1).reshape(Bn, L, MLA_HEADS * MLA_V)
    y_lat = jnp.concatenate([hyena_mixer(z_lat[..., :O_HY], *hy), att.astype(z_lat.dtype)], axis=-1) @ w_o
    y_ctx = None
    if need_ctx:
        att_c = mla_attend(cqn, cqr, ckn, ckr, cv).reshape(Bn, in_ctx.shape[1], MLA_HEADS * MLA_V)
        y_ctx = jnp.concatenate([hyena_mixer(z_ctx[..., :O_HY], *hy), att_c.astype(z_ctx.dtype)], axis=-1) @ w_o
    return y_ctx, y_lat


def _scan_op(e1, e2):
    a1, b1 = e1
    a2, b2 = e2
    return a1 * a2, a2 * b1 + b2


def linear_scan(a_bar, bu, s0):
    bu = bu.at[:, 0].add(a_bar * s0)
    a = jnp.broadcast_to(a_bar, bu.shape)
    _, s = lax.associative_scan(_scan_op, (a, bu), axis=1)
    return s


def _rev(s, d):
    return s[:, ::-1] if d == 1 else s


def s5_mixer(in_ctx, in_lat, need_ctx, lam_re, lam_im, log_dt, b_re, b_im, c_re, c_im, d_skip, w_o, w_g):
    def to_blocks(h):
        Bn, L, _ = h.shape
        return h.astype(F32).reshape(Bn, L, S5_NBLK, S5_GB, S5_GC).transpose(2, 0, 1, 3, 4)

    def from_blocks(y):
        nbk, Bn, L = y.shape[:3]
        return y.transpose(1, 2, 0, 3, 4).reshape(Bn, L, D_MODEL)

    def par_blocks(a):
        a = a.astype(F32)
        return a.reshape((2, S5_NBLK, S5_GB) + a.shape[2:]).swapaxes(0, 1)

    lam = lax.complex(par_blocks(lam_re), par_blocks(lam_im))
    dt = jnp.exp(par_blocks(log_dt))
    bmat = lax.complex(par_blocks(b_re), par_blocks(b_im))
    cmat = lax.complex(par_blocks(c_re), par_blocks(c_im))

    def block_fn(args):
        u_ctx, u_lat, lm, dtb, bm, cm = args
        a_bar = jnp.exp(lm * dtb[..., None])
        b_bar = ((a_bar - 1.0) / lm)[..., None] * bm
        zero = jnp.zeros((u_ctx.shape[0], S5_GB, S5_P), jnp.complex64)
        outs_ctx, outs_lat = [], []
        for d in range(2):
            bu_ctx = jnp.einsum('blgc,gpc->blgp', _rev(u_ctx, d).astype(jnp.complex64), b_bar[d])
            bu_lat = jnp.einsum('blgc,gpc->blgp', _rev(u_lat, d).astype(jnp.complex64), b_bar[d])
            s_ctx = linear_scan(a_bar[d], bu_ctx, zero)
            s_lat = linear_scan(a_bar[d], bu_lat, s_ctx[:, -1])
            outs_lat.append(_rev(jnp.einsum('blgp,gcp->blgc', s_lat, cm[d]).real, d))
            if need_ctx:
                outs_ctx.append(_rev(jnp.einsum('blgp,gcp->blgc', s_ctx, cm[d]).real, d))
        y_lat = outs_lat[0] + outs_lat[1]
        if need_ctx:
            return y_lat, outs_ctx[0] + outs_ctx[1]
        return (y_lat,)

    outs = lax.map(block_fn, (to_blocks(in_ctx), to_blocks(in_lat), lam, dt, bmat, cmat))

    def finish(yb, h):
        y = from_blocks(yb) + d_skip * h.astype(F32)
        y = jax.nn.gelu(y).astype(h.dtype)
        return (y @ w_o) * jax.nn.sigmoid(y @ w_g)

    y_lat = finish(outs[0], in_lat)
    y_ctx = finish(outs[1], in_ctx) if need_ctx else None
    return y_ctx, y_lat


def peer_ffn(h, w_q, keys, u_tab, v_tab):
    Bn, L, D = h.shape
    hb = h.reshape(Bn * L // PEER_BLOCK, PEER_BLOCK, D)

    def block_fn(xb):
        q = (xb @ w_q).reshape(PEER_BLOCK, PEER_HEADS, 2, PEER_DK // 2)
        s = jnp.einsum('thsk,hsnk->thsn', q, keys).astype(F32)
        top_s, top_i = lax.top_k(s, PEER_TOPK)
        cand = top_s[:, :, 0, :, None] + top_s[:, :, 1, None, :]
        cand_s, cand_j = lax.top_k(cand.reshape(PEER_BLOCK, PEER_HEADS, PEER_TOPK * PEER_TOPK), PEER_TOPK)
        idx = (jnp.take_along_axis(top_i[:, :, 0], cand_j // PEER_TOPK, axis=-1) * PEER_NK
               + jnp.take_along_axis(top_i[:, :, 1], cand_j % PEER_TOPK, axis=-1))
        g = jax.nn.softmax(cand_s, axis=-1)
        act = jax.nn.gelu(jnp.einsum('thkd,td->thk', u_tab[idx], xb).astype(F32))
        return jnp.einsum('thk,thkd->td', (g * act).astype(xb.dtype), v_tab[idx])

    return lax.map(block_fn, hb).reshape(Bn, L, D)


def setup_inputs(seed: int = 0) -> dict:
    key = jax.random.key(seed)
    ks = list(jax.random.split(key, 48))

    def nrm(shape, scale):
        return jax.random.normal(ks.pop(), shape, F32) * scale

    def gain(shape):
        return 1.0 + nrm(shape, 0.02)

    D = D_MODEL
    return {
        'x': nrm((BATCH, SEQ, D), 1.0),
        'c': nrm((BATCH, D), 1.0),
        'ctx': nrm((BATCH, CTX_LEN, D), 1.0),
        'c_ctx': nrm((D,), 1.0),
        'mod_w': nrm((DEPTH, D, 6 * D), 0.5 * D ** -0.5),
        'mod_b': nrm((DEPTH, 6 * D), 0.02),
        'ln_mix_g': gain((DEPTH, D)),
        'ln_mix_b': nrm((DEPTH, D), 0.02),
        'ln_ffn_g': gain((DEPTH, D)),
        'ln_ffn_b': nrm((DEPTH, D), 0.02),
        'ev_w_in': nrm((N_EVEN, D, IN_W), D ** -0.5),
        'ev_conv_w': nrm((N_EVEN, 3, O_HY), 0.5),
        'ev_conv_b': nrm((N_EVEN, O_HY), 0.02),
        'hy_w1': nrm((N_EVEN, HY_EMB, HY_HID), HY_EMB ** -0.5),
        'hy_b1': nrm((N_EVEN, HY_HID), 0.02),
        'hy_w2': nrm((N_EVEN, HY_HID, HY_HID), HY_HID ** -0.5),
        'hy_b2': nrm((N_EVEN, HY_HID), 0.02),
        'hy_w3': nrm((N_EVEN, HY_HID, HY_HID), HY_HID ** -0.5),
        'hy_b3': nrm((N_EVEN, HY_HID), 0.02),
        'hy_w4': nrm((N_EVEN, HY_HID, 2 * HY_ORDER * HY_W), HY_HID ** -0.5),
        'hy_freq': gain((N_EVEN, HY_HID)),
        'hy_bias': nrm((N_EVEN, HY_ORDER, HY_W), 0.1),
        'mla_q_norm': gain((N_EVEN, MLA_Q_RANK)),
        'mla_w_uq': nrm((N_EVEN, MLA_Q_RANK, MLA_HEADS * (MLA_NOPE + MLA_ROPE)), MLA_Q_RANK ** -0.5),
        'mla_kv_norm': gain((N_EVEN, MLA_KV_RANK)),
        'mla_w_ukv': nrm((N_EVEN, MLA_KV_RANK, MLA_HEADS * (MLA_NOPE + MLA_V)), MLA_KV_RANK ** -0.5),
        'ev_w_o': nrm((N_EVEN, D, D), DN_BETA * D ** -0.5),
        's5_lam_re': -0.5 + nrm((N_ODD, 2, S5_NG, S5_P), 0.01),
        's5_lam_im': math.pi * jnp.arange(S5_P, dtype=F32) + nrm((N_ODD, 2, S5_NG, S5_P), 0.01),
        's5_log_dt': jax.random.uniform(ks.pop(), (N_ODD, 2, S5_NG), F32, math.log(1e-3), math.log(1e-1)),
        's5_b_re': nrm((N_ODD, 2, S5_NG, S5_P, S5_GC), (2 * S5_GC) ** -0.5),
        's5_b_im': nrm((N_ODD, 2, S5_NG, S5_P, S5_GC), (2 * S5_GC) ** -0.5),
        's5_c_re': nrm((N_ODD, 2, S5_NG, S5_GC, S5_P), S5_P ** -0.5),
        's5_c_im': nrm((N_ODD, 2, S5_NG, S5_GC, S5_P), S5_P ** -0.5),
        's5_d': nrm((N_ODD, D), 1.0),
        'od_w_o': nrm((N_ODD, D, D), DN_BETA * D ** -0.5),
        'od_w_g': nrm((N_ODD, D, D), D ** -0.5),
        'peer_w_q': nrm((DEPTH, D, PEER_HEADS * PEER_DK), D ** -0.5),
        'peer_keys': nrm((DEPTH, PEER_HEADS, 2, PEER_NK, PEER_DK // 2), (PEER_DK // 2) ** -0.5),
        'peer_u': nrm((DEPTH, PEER_N, D), D ** -0.5),
        'peer_v': nrm((DEPTH, PEER_N, D), DN_BETA * PEER_HEADS ** -0.5),
    }


def reference(x, c, ctx, c_ctx, mod_w, mod_b, ln_mix_g, ln_mix_b, ln_ffn_g, ln_ffn_b,
              ev_w_in, ev_conv_w, ev_conv_b, hy_w1, hy_b1, hy_w2, hy_b2, hy_w3, hy_b3, hy_w4,
              hy_freq, hy_bias, mla_q_norm, mla_w_uq, mla_kv_norm, mla_w_ukv, ev_w_o,
              s5_lam_re, s5_lam_im, s5_log_dt, s5_b_re, s5_b_im, s5_c_re, s5_c_im, s5_d,
              od_w_o, od_w_g, peer_w_q, peer_keys, peer_u, peer_v):
    cos, sin = axial_rope(x.shape[1])
    act_lat = jax.nn.silu(c)
    act_ctx = jax.nn.silu(c_ctx)
    h_lat, h_ctx = x, ctx
    for layer in range(DEPTH):
        need_ctx = layer < DEPTH - 1
        m_lat = jnp.split((act_lat @ mod_w[layer] + mod_b[layer])[:, None, :], 6, axis=-1)
        m_ctx = jnp.split((act_ctx @ mod_w[layer] + mod_b[layer])[None, None, :], 6, axis=-1)
        in_lat = h_lat * (1.0 + m_lat[1]) + m_lat[0]
        in_ctx = h_ctx * (1.0 + m_ctx[1]) + m_ctx[0]
        i = layer // 2
        if layer % 2 == 0:
            hy = (ev_conv_w[i], ev_conv_b[i], hy_w1[i], hy_b1[i], hy_w2[i], hy_b2[i], hy_w3[i], hy_b3[i],
                  hy_w4[i], hy_freq[i], hy_bias[i])
            mla = (mla_q_norm[i], mla_w_uq[i], mla_kv_norm[i], mla_w_ukv[i])
            y_ctx, y_lat = even_mixer(in_ctx, in_lat, cos, sin, need_ctx, ev_w_in[i], hy, mla, ev_w_o[i])
        else:
            y_ctx, y_lat = s5_mixer(in_ctx, in_lat, need_ctx, s5_lam_re[i], s5_lam_im[i], s5_log_dt[i],
                                    s5_b_re[i], s5_b_im[i], s5_c_re[i], s5_c_im[i], s5_d[i],
                                    od_w_o[i], od_w_g[i])
        h_lat = layer_norm(DN_ALPHA * h_lat + m_lat[2] * y_lat, ln_mix_g[layer], ln_mix_b[layer])
        f_lat = peer_ffn(h_lat * (1.0 + m_lat[4]) + m_lat[3], peer_w_q[layer], peer_keys[layer],
                         peer_u[layer], peer_v[layer])
        h_lat = layer_norm(DN_ALPHA * h_lat + m_lat[5] * f_lat, ln_ffn_g[layer], ln_ffn_b[layer])
        if need_ctx:
            h_ctx = layer_norm(DN_ALPHA * h_ctx + m_ctx[2] * y_ctx, ln_mix_g[layer], ln_mix_b[layer])
            f_ctx = peer_ffn(h_ctx * (1.0 + m_ctx[4]) + m_ctx[3], peer_w_q[layer], peer_keys[layer],
                             peer_u[layer], peer_v[layer])
            h_ctx = layer_norm(DN_ALPHA * h_ctx + m_ctx[5] * f_ctx, ln_ffn_g[layer], ln_ffn_b[layer])
    return h_lat
```

```cpp
#include <hip/hip_runtime.h>
#include <cstdio>
#include <cstdint>
#include <cstddef>

#ifndef NLAUNCH
#define NLAUNCH 1
#endif

typedef unsigned short bf16_t;
typedef short bf16x8 __attribute__((ext_vector_type(8)));
typedef short s16x4 __attribute__((ext_vector_type(4)));
typedef float f32x4 __attribute__((ext_vector_type(4)));
typedef float f32x16 __attribute__((ext_vector_type(16)));
typedef unsigned u32x4 __attribute__((ext_vector_type(4)));
typedef unsigned u32x2 __attribute__((ext_vector_type(2)));
typedef float cf2 __attribute__((ext_vector_type(2)));

constexpr int DM = 2048, NB = 2, SEQ = 8192, CTXL = 256, TPB = SEQ + CTXL, MROWS = NB * TPB;
constexpr int NTHREADS = 512, NWAVES = 8;
constexpr int HYW = 1024, OHY = 3072, OQ = 3584, OKV = 3840, INW = 3904, INWP = 4096;
constexpr int NH = 8, DQK = 192, DVH = 128, QRANK = 512, KVRANK = 256;
constexpr float DN_ALPHA = 1.6817928305074290f;
constexpr float LN_EPS = 1e-5f, RMS_EPS = 1e-6f;
constexpr float MLA_SCALE = 0.07216878364870322f;
constexpr int S5T = 128, S5NCH = TPB / S5T;
constexpr int LDS_BYTES = 155648;

constexpr size_t al256(size_t x) { return (x + 255) & ~(size_t)255; }
constexpr size_t WS_CTL   = 0;
constexpr size_t WS_MVEC  = 16384;
constexpr size_t WS_H     = al256(WS_MVEC + (size_t)4 * 3 * 12288 * 4);
constexpr size_t WS_XIN   = al256(WS_H + (size_t)MROWS * DM * 4);
constexpr size_t WS_XFFN  = al256(WS_XIN + (size_t)MROWS * DM * 2);
constexpr size_t WS_Z     = al256(WS_XFFN + (size_t)MROWS * DM * 2);
constexpr size_t WS_QN    = al256(WS_Z + (size_t)MROWS * 4096 * 2);
constexpr size_t WS_KVN   = al256(WS_QN + (size_t)MROWS * 512 * 2);
constexpr size_t WS_Q     = al256(WS_KVN + (size_t)MROWS * 256 * 2);
constexpr size_t WS_K     = al256(WS_Q + (size_t)NB * NH * TPB * DQK * 2);
constexpr size_t WS_V     = al256(WS_K + (size_t)NB * NH * TPB * DQK * 2);
constexpr size_t WS_CAT   = al256(WS_V + (size_t)NB * NH * TPB * DVH * 2);
constexpr size_t WS_ZCT   = al256(WS_CAT + (size_t)MROWS * DM * 2);
constexpr size_t WS_YT    = al256(WS_ZCT + (size_t)3072 * MROWS * 2);
constexpr size_t WS_YMIX  = al256(WS_YT + (size_t)1024 * MROWS * 2);
constexpr size_t WS_PQ    = al256(WS_YMIX + (size_t)MROWS * DM * 2);
constexpr size_t WS_PIDX  = al256(WS_PQ + (size_t)MROWS * DM * 2);
constexpr size_t WS_PGATE = al256(WS_PIDX + (size_t)MROWS * 128 * 4);
constexpr size_t WS_WIN   = al256(WS_PGATE + (size_t)MROWS * 128 * 4);
constexpr size_t WS_WUQ   = al256(WS_WIN + (size_t)2 * 4096 * 2048 * 2);
constexpr size_t WS_WUKV  = al256(WS_WUQ + (size_t)2 * 1536 * 512 * 2);
constexpr size_t WS_WO    = al256(WS_WUKV + (size_t)2 * 2048 * 256 * 2);
constexpr size_t WS_OD    = al256(WS_WO + (size_t)2 * 2048 * 2048 * 2);
constexpr size_t WS_WQ    = al256(WS_OD + (size_t)2 * 4096 * 2048 * 2);
constexpr size_t WS_KEYS  = al256(WS_WQ + (size_t)4 * 2048 * 2048 * 2);
constexpr size_t WS_PU    = al256(WS_KEYS + (size_t)4 * 8 * 2 * 128 * 128 * 2);
constexpr size_t WS_PV    = al256(WS_PU + (size_t)4 * 16384 * 2048 * 2);
constexpr size_t WS_HDN3  = al256(WS_PV + (size_t)4 * 16384 * 2048 * 2);
constexpr size_t HK_LAT   = (size_t)2 * 1024 * 2 * 8192;
constexpr size_t HK_CTX   = (size_t)2 * 1024 * 2 * 256;
constexpr size_t WS_HK    = al256(WS_HDN3 + (size_t)2 * 8448 * 64 * 4);
constexpr size_t WS_ABAR  = al256(WS_HK + 2 * (HK_LAT + HK_CTX) * 4);
constexpr size_t WS_AT    = al256(WS_ABAR + (size_t)2 * 2 * 128 * 64 * 8);
constexpr size_t WS_BFRAG = al256(WS_AT + (size_t)2 * 2 * 128 * 64 * 8);
constexpr size_t WS_CFRAG = al256(WS_BFRAG + (size_t)2 * 2 * 128 * 4 * 64 * 16);
constexpr size_t WS_EST   = al256(WS_CFRAG + (size_t)2 * 2 * 128 * 4 * 64 * 16);
constexpr size_t WS_TW    = al256(WS_EST + (size_t)2 * 128 * 2 * S5NCH * 64 * 8);
constexpr size_t WS_END   = al256(WS_TW + (size_t)8192 * 8);
constexpr size_t FFT_SCR_PER_BLOCK = 512 * 1024;
static_assert(256 * FFT_SCR_PER_BLOCK <= (size_t)MROWS * 4096 * 2, "fft scratch must fit the z region");

struct Params {
    const float* in[41];
    float* out;
    unsigned char* ws;
    int ph_lo, ph_hi;
};

#define LAS __attribute__((address_space(3)))
typedef const __attribute__((address_space(4))) Params* KP;
#ifndef PHASE_FN
#define PHASE_FN __device__ __forceinline__
#endif

__device__ __forceinline__ int opaque_tid() { int t = (int)threadIdx.x; asm volatile("" : "+v"(t)); return t; }
__device__ __forceinline__ KP launder_kp(KP p) { unsigned long long v = (unsigned long long)p; asm volatile("" : "+s"(v)); return (KP)v; }
__device__ __forceinline__ int opaque_bid() { int t = (int)blockIdx.x; asm volatile("" : "+s"(t)); return t; }
#define TID  (opaque_tid())

__device__ __forceinline__ cf2 mk2(float a, float b) { cf2 r; r.x = a; r.y = b; return r; }
__device__ __forceinline__ float bf2f(bf16_t b) { return __uint_as_float(((unsigned)b) << 16); }
__device__ __forceinline__ float bflo(unsigned w) { return __uint_as_float(w << 16); }
__device__ __forceinline__ float bfhi(unsigned w) { return __uint_as_float(w & 0xffff0000u); }
__device__ __forceinline__ unsigned cvt_pk(float lo, float hi) { unsigned r; asm volatile("v_cvt_pk_bf16_f32 %0, %1, %2" : "=v"(r) : "v"(lo), "v"(hi)); return r; }
__device__ __forceinline__ bf16_t f2bf(float f) { return (bf16_t)(cvt_pk(f, 0.f) & 0xffffu); }
__device__ __forceinline__ float wave_sum(float v) {
#pragma unroll
    for (int o = 32; o >= 1; o >>= 1) v += __shfl_xor(v, o);
    return v;
}
__device__ __forceinline__ float gelu_tanh(float x) {
    const float z = 0.7978845608028654f * (x + 0.044715f * x * x * x);
    const float e = __expf(2.0f * z);
    const float t = 1.0f - 2.0f / (e + 1.0f);
    return 0.5f * x * (1.0f + t);
}
__device__ __forceinline__ void unpack8(const u32x4 w, float (&f)[8]) {
    f[0] = bflo(w.x); f[1] = bfhi(w.x); f[2] = bflo(w.y); f[3] = bfhi(w.y); f[4] = bflo(w.z); f[5] = bfhi(w.z); f[6] = bflo(w.w); f[7] = bfhi(w.w);
}
__device__ __forceinline__ u32x4 pack8(const float (&f)[8]) {
    u32x4 w; w.x = cvt_pk(f[0], f[1]); w.y = cvt_pk(f[2], f[3]); w.z = cvt_pk(f[4], f[5]); w.w = cvt_pk(f[6], f[7]); return w;
}

namespace pg8 {
#define PG8_LAS __attribute__((address_space(3)))
typedef unsigned short bf16_t;
typedef short bf16x8 __attribute__((ext_vector_type(8)));
typedef float f32x4 __attribute__((ext_vector_type(4)));
typedef unsigned u32x4 __attribute__((ext_vector_type(4)));
constexpr int BM = 256, BK = 64, HALF = 128, HTB = HALF * BK * 2  , STAGE_BYTES = 8 * HTB, NXCD = 8, WGM = 8;

__host__ __device__ __forceinline__ int lds_byte(int r, int c) { const int st = (r >> 4) * 2 + (c >> 5), rr = r & 15, cc = c & 31, ob = rr * 64 + cc * 2; return st * 1024 + (ob ^ (((ob >> 9) & 1) << 5)); }
__host__ __device__ __forceinline__ void stage_rc(int b, int& R, int& C) { const int st = b / 1024, sb = b % 1024, swz = sb ^ (((sb >> 9) & 1) << 5); R = (st >> 1) * 16 + swz / 64; C = (st & 1) * 32 + (swz % 64) / 2; }
__host__ __device__ __forceinline__ int perm32(int rho) { const int n = rho >> 4, i = rho & 15; return 8 * (i >> 2) + 4 * n + (i & 3); }

struct Unit { int pm, pn; };
struct Gemm { const bf16_t* A; const bf16_t* Bt; int M, N, K; };

struct StaticOrder {
    int nM, nN, nwg, G, c;
    __host__ __device__ void init(int M, int N, int G_, int c_) { nM = M / BM; nN = N / BM; nwg = nM * nN; G = G_; c = c_; }
    __host__ __device__ bool next(int i, Unit& u) const {
        const long L = (long)i * G + c; if (L >= nwg) return false;
        int wgid = (int)L; { const int q = nwg / NXCD, r = nwg % NXCD, xcd = wgid % NXCD, off = wgid / NXCD; wgid = (xcd < r ? xcd * (q + 1) : r * (q + 1) + (xcd - r) * q) + off; }
        const int nig = WGM * nN, gid = wgid / nig, fm = gid * WGM, gsz = (nM - fm) < WGM ? (nM - fm) : WGM;
        u.pm = fm + ((wgid % nig) % gsz); u.pn = (wgid % nig) / gsz; return true;
    }
    __device__ __forceinline__ void a_ready(const Unit&) const {}
    __device__ __forceinline__ void done(const Unit&) const {}
};
__device__ __forceinline__ unsigned cvt_pk_bf16(float lo, float hi) { unsigned r; asm volatile("v_cvt_pk_bf16_f32 %0, %1, %2" : "=v"(r) : "v"(lo), "v"(hi)); return r; }
typedef float f32x2 __attribute__((ext_vector_type(2)));
__device__ __forceinline__ f32x2 gelu_pk(f32x2 v) {
    const f32x2 av = __builtin_elementwise_abs(v), d = av * 0.2316418882f + 1.0f;
    f32x2 t; t.x = __builtin_amdgcn_rcpf(d.x); t.y = __builtin_amdgcn_rcpf(d.y);
    f32x2 q = t * 0.5307027145f + (-0.7265760135f); q = q * t + 0.7107068705f; q = q * t + (-0.142248368f); q = q * t + 0.127414796f; q = q * t;
    const f32x2 s = (v * v) * (-0.72134752044f);
    f32x2 e; e.x = __builtin_amdgcn_exp2f(s.x); e.y = __builtin_amdgcn_exp2f(s.y);
    const f32x2 m = v * (q * e), r = v - m;
    f32x2 o; o.x = v.x < 0.f ? m.x : r.x; o.y = v.y < 0.f ? m.y : r.y; return o;
}

template <class Epi, class Sched, bool STAMP = false>
__device__ __forceinline__ void gemm_phase(PG8_LAS unsigned char* lds, const Gemm g, const Sched& S, const Epi& E, unsigned long long* stamps) {
    const int tid = TID, wid = __builtin_amdgcn_readfirstlane(tid >> 6), lane = tid & 63, wr = wid >> 2, wc = wid & 3, fr = lane & 15, fq = lane >> 4;
    const int K = g.K, nt = K / BK;
    int ts_lo = 0, ts_hi = 0, nts = 0; const unsigned long long rt_entry = STAMP ? (unsigned long long)wall_clock64() : 0ull;
#define PG8_STAMP() do { if (STAMP && wid == 0 && nts < 64) { const unsigned long long _c = (unsigned long long)clock64(); \
        ts_lo = (lane == nts) ? (int)(unsigned)_c : ts_lo; ts_hi = (lane == nts) ? (int)(unsigned)(_c >> 32) : ts_hi; ++nts; } } while (0)
    PG8_STAMP();
    unsigned voffA[2], voffB[2];
#pragma unroll
    for (int i = 0; i < 2; ++i) { int R, C; stage_rc(tid * 16 + i * 8192, R, C); const int Rb = Epi::PERM ? ((R & ~31) + perm32(R & 31)) : R;
        voffA[i] = (unsigned)(R * K + C) * 2u; voffB[i] = (unsigned)(Rb * K + C) * 2u; }
    const size_t kstep = (size_t)(BK * 2);
    const size_t hstep = (size_t)HALF * K * 2;
    const size_t tstep = 2 * hstep;
    const unsigned ldsw = (unsigned)wid * 1024u;
    const int aoff = lds_byte(wr * 64 + fr, fq * 8), boff = lds_byte(wc * 32 + fr, fq * 8);
#define PG8_SA(b, h) (((b) * 2 + (h)) * HTB)
#define PG8_SB(b, h) ((4 + (b) * 2 + (h)) * HTB)
#define PG8_STAGE(bufoff, gbase, voff) do { _Pragma("unroll") for (int _i = 0; _i < 2; ++_i) \
        __builtin_amdgcn_global_load_lds((const unsigned*)((const char*)(gbase) + (voff)[_i]), (PG8_LAS unsigned*)(lds + (bufoff) + ldsw + _i * 8192), 16, 0, 0); } while (0)
#define PG8_LDA(dst, b, h) do { _Pragma("unroll") for (int m = 0; m < 4; ++m) _Pragma("unroll") for (int k = 0; k < 2; ++k) dst[m][k] = *(const PG8_LAS bf16x8*)(lds + PG8_SA(b, h) + aoff + m * 2048 + k * 1024); } while (0)
#define PG8_LDB(dst, b, h) do { _Pragma("unroll") for (int n = 0; n < 2; ++n) _Pragma("unroll") for (int k = 0; k < 2; ++k) dst[n][k] = *(const PG8_LAS bf16x8*)(lds + PG8_SB(b, h) + boff + n * 2048 + k * 1024); } while (0)
#define PG8_MMA(ai, bj, At, Bt) do { __builtin_amdgcn_s_setprio(1); _Pragma("unroll") for (int m = 0; m < 4; ++m) _Pragma("unroll") for (int n = 0; n < 2; ++n) _Pragma("unroll") for (int k = 0; k < 2; ++k) \
        acc[ai][bj][m][n] = __builtin_amdgcn_mfma_f32_16x16x32_bf16(Bt[n][k], At[m][k], acc[ai][bj][m][n], 0, 0, 0); __builtin_amdgcn_s_setprio(0); } while (0)
#define PG8_WAIT_V(n) asm volatile("s_waitcnt vmcnt(" #n ")" ::: "memory")
#define PG8_WAIT_L(n) asm volatile("s_waitcnt lgkmcnt(" #n ")" ::: "memory")
#define PG8_BAR __builtin_amdgcn_s_barrier()
#define PG8_SCHED __builtin_amdgcn_sched_barrier(0)
    Unit cur, nxt; int ui = 0;
    if (!S.next(0, cur)) return;
    f32x4 acc[2][2][4][2];
#pragma unroll
    for (int a = 0; a < 2; ++a)
#pragma unroll
        for (int b = 0; b < 2; ++b)
#pragma unroll
            for (int m = 0; m < 4; ++m)
#pragma unroll
                for (int n = 0; n < 2; ++n) acc[a][b][m][n] = (f32x4){0.f, 0.f, 0.f, 0.f};
    bf16x8 At[4][2], B0[2][2], B1[2][2];
    const char* cA = (const char*)g.A + (size_t)cur.pm * tstep; const char* cB = (const char*)g.Bt + (size_t)cur.pn * tstep;
    S.a_ready(cur);
    PG8_STAGE(PG8_SB(0, 0), cB, voffB); PG8_STAGE(PG8_SA(0, 0), cA, voffA); PG8_STAGE(PG8_SB(0, 1), cB + hstep, voffB); PG8_STAGE(PG8_SA(0, 1), cA + hstep, voffA);
    if (wr == 1) PG8_BAR;
    PG8_WAIT_V(4); PG8_BAR;
    PG8_STAGE(PG8_SB(1, 0), cB + kstep, voffB); PG8_STAGE(PG8_SA(1, 0), cA + kstep, voffA); PG8_STAGE(PG8_SB(1, 1), cB + hstep + kstep, voffB);
    PG8_WAIT_V(6); PG8_BAR;
    PG8_STAMP();
    for (;;) {
        const bool has_next = S.next(ui + 1, nxt);
        const char* nA = has_next ? (const char*)g.A + (size_t)nxt.pm * tstep : cA; const char* nB = has_next ? (const char*)g.Bt + (size_t)nxt.pn * tstep : cB;
        for (int t = 0; t < nt; t += 2) {
            const bool last = (t == nt - 2);
            const char* a1 = cA + (size_t)(t + 1) * kstep;
            const char* a2 = last ? nA : cA + (size_t)(t + 2) * kstep; const char* b2 = last ? nB : cB + (size_t)(t + 2) * kstep;
            const char* a3 = a2 + kstep; const char* b3 = b2 + kstep;
            if (last && has_next) S.a_ready(nxt);
            PG8_LDB(B0, 0, 0); PG8_SCHED; PG8_LDA(At, 0, 0); PG8_STAGE(PG8_SA(1, 1), a1 + hstep, voffA);
            PG8_WAIT_L(8); PG8_BAR; PG8_WAIT_L(0); PG8_MMA(0, 0, At, B0); PG8_BAR; PG8_SCHED;
            PG8_LDB(B1, 0, 1); PG8_STAGE(PG8_SB(0, 0), b2, voffB);
            PG8_BAR; PG8_WAIT_L(0); PG8_MMA(0, 1, At, B1); PG8_BAR;
            PG8_LDA(At, 0, 1); PG8_STAGE(PG8_SA(0, 0), a2, voffA);
            PG8_BAR; PG8_WAIT_L(0); PG8_MMA(1, 0, At, B0); PG8_BAR; PG8_SCHED;
            PG8_STAGE(PG8_SB(0, 1), b2 + hstep, voffB);
            PG8_WAIT_V(6); PG8_BAR; PG8_MMA(1, 1, At, B1); PG8_BAR;
            PG8_LDB(B0, 1, 0); PG8_SCHED; PG8_LDA(At, 1, 0); PG8_STAGE(PG8_SA(0, 1), a2 + hstep, voffA);
            PG8_WAIT_L(8); PG8_BAR; PG8_WAIT_L(0); PG8_MMA(0, 0, At, B0); PG8_BAR; PG8_SCHED;
            PG8_LDB(B1, 1, 1); PG8_STAGE(PG8_SB(1, 0), b3, voffB);
            PG8_BAR; PG8_WAIT_L(0); PG8_MMA(0, 1, At, B1); PG8_BAR;
            PG8_LDA(At, 1, 1); PG8_STAGE(PG8_SA(1, 0), a3, voffA);
            PG8_BAR; PG8_WAIT_L(0); PG8_MMA(1, 0, At, B0); PG8_BAR; PG8_SCHED;
            PG8_STAGE(PG8_SB(1, 1), b3 + hstep, voffB);
            PG8_WAIT_V(6); PG8_BAR; PG8_MMA(1, 1, At, B1); PG8_BAR;
        }
        PG8_STAMP();
        if constexpr (!Epi::AFTER_DRAIN) { E(acc, cur, wr, wc, fr, fq); S.done(cur); }
        PG8_STAMP();
        if (!has_next) break;
#pragma unroll
        for (int a = 0; a < 2; ++a)
#pragma unroll
            for (int b = 0; b < 2; ++b)
#pragma unroll
                for (int m = 0; m < 4; ++m)
#pragma unroll
                    for (int n = 0; n < 2; ++n) acc[a][b][m][n] = (f32x4){0.f, 0.f, 0.f, 0.f};
        cur = nxt; cA = nA; cB = nB; ++ui;
    }
    PG8_WAIT_V(0);
    if (wr == 0) PG8_BAR;
    PG8_BAR;
    if constexpr (Epi::AFTER_DRAIN) { E.fused(acc, cur, wr, wc, fr, fq, lds, wid, lane); S.done(cur); }
    PG8_STAMP();
    if (STAMP && wid == 0) { stamps[lane] = lane < nts ? (((unsigned long long)(unsigned)ts_hi << 32) | (unsigned)ts_lo) : 0ull;
        if (lane == 62) stamps[62] = rt_entry; if (lane == 63) stamps[63] = (unsigned long long)wall_clock64(); }
#undef PG8_STAMP
#undef PG8_SA
#undef PG8_SB
#undef PG8_STAGE
#undef PG8_LDA
#undef PG8_LDB
#undef PG8_MMA
#undef PG8_WAIT_V
#undef PG8_WAIT_L
#undef PG8_BAR
#undef PG8_SCHED
}
}

#define XB_TMO      128
#define XB_XCNT(j)  (256  + 64 * (j))
#define XB_XSUB(j)  (1280 + 64 * (j))
#define XB_XGEN(j)  (2304 + 64 * (j))
#define XB_TOP      3328
#define XB_TOPGEN   3392
#define XCD_BAR_WORDS 3456
#define XB_SPIN_CAP (1u << 22)
#define LAS __attribute__((address_space(3)))

__device__ __forceinline__ unsigned xb_ld(unsigned* p)              { return __hip_atomic_load(p, __ATOMIC_RELAXED, __HIP_MEMORY_SCOPE_AGENT); }
__device__ __forceinline__ unsigned xb_add(unsigned* p, unsigned v) { return __hip_atomic_fetch_add(p, v, __ATOMIC_RELAXED, __HIP_MEMORY_SCOPE_AGENT); }
__device__ __forceinline__ unsigned xb_xcc_id() { return (unsigned)__builtin_amdgcn_s_getreg((3 << 11) | 20) & 0xFu; }
#define XB_SPIN(cond, bar) do { unsigned _sp = 0; while (cond) { __builtin_amdgcn_s_sleep(1); \
    if ((++_sp & 255u) == 0u) { if (xb_ld(&(bar)[XB_TMO])) break; if (_sp > XB_SPIN_CAP) { atomicAdd(&(bar)[XB_TMO], 1u); break; } } } } while (0)

struct XcdBarrier {
    unsigned* bar; unsigned x;
    volatile LAS unsigned* st;
};

__device__ __forceinline__ XcdBarrier xcd_barrier_post(unsigned* bar, volatile LAS unsigned* st) {
    XcdBarrier b; b.bar = bar; b.x = xb_xcc_id(); b.st = st;
    if (threadIdx.x == 0) (void)xb_add(&bar[XB_XCNT(b.x)], 1u);
    return b;
}
__device__ __forceinline__ void xcd_barrier_complete(unsigned* bar, unsigned x, unsigned& nloc, unsigned& nx) {
    const unsigned G = gridDim.x * gridDim.y * gridDim.z;
    unsigned sum, cnt, mine, sp = 0u;
    for (;;) {
        sum = 0u; cnt = 0u; mine = 0u;
#pragma unroll
        for (unsigned j = 0; j < 16; ++j) { const unsigned c = xb_ld(&bar[XB_XCNT(j)]); sum += c; cnt += (c > 0u) ? 1u : 0u; mine = (j == x) ? c : mine; }
        if (sum == G) break;
        __builtin_amdgcn_s_sleep(1);
        if ((++sp & 255u) == 0u) { if (xb_ld(&bar[XB_TMO])) break; if (sp > XB_SPIN_CAP) { atomicAdd(&bar[XB_TMO], 1u); break; } }
    }
    nloc = mine > 0u ? mine : 1u; nx = cnt > 0u ? cnt : 1u;
}

__device__ __forceinline__ void xcd_barrier(const XcdBarrier& b) {
    asm volatile("s_waitcnt vmcnt(0)" ::: "memory");
    __syncthreads();
    if (threadIdx.x == 0) {
        unsigned* bar = b.bar;
        __builtin_amdgcn_s_waitcnt(0);
        unsigned nloc = b.st[0], nx = b.st[1];
        if (nloc == 0u) { xcd_barrier_complete(bar, b.x, nloc, nx); b.st[0] = nloc; b.st[1] = nx; }
        const unsigned old = xb_add(&bar[XB_XSUB(b.x)], 1u);
        const unsigned gen = old / nloc;
        if (old + 1u == (gen + 1u) * nloc) {
            __builtin_amdgcn_fence(__ATOMIC_RELEASE, "agent");
            asm volatile("s_waitcnt vmcnt(0)" ::: "memory");
            const unsigned og = xb_add(&bar[XB_TOP], 1u);
            const unsigned tg = og / nx;
            if (og + 1u == (tg + 1u) * nx) xb_add(&bar[XB_TOPGEN], 1u);
            else XB_SPIN(xb_ld(&bar[XB_TOPGEN]) == tg, bar);
            __builtin_amdgcn_fence(__ATOMIC_ACQUIRE, "agent");
            xb_add(&bar[XB_XGEN(b.x)], 1u);
            asm volatile("s_waitcnt vmcnt(0)" ::: "memory");
        } else {
            XB_SPIN(xb_ld(&bar[XB_XGEN(b.x)]) == gen, bar);
            __builtin_amdgcn_fence(__ATOMIC_ACQUIRE, "agent");
            asm volatile("s_waitcnt vmcnt(0)" ::: "memory");
        }
    }
    __syncthreads();
}


#define BID  (opaque_bid())
#define NBLK ((int)gridDim.x)

PHASE_FN void ph_mod(KP p, LAS unsigned char* lds) {
    p = launder_kp(p);
    LAS float* act = (LAS float*)lds;
    LAS float* red = act + 3 * 2048;
    const int tid = TID;
    for (int i = tid; i < 3 * 2048; i += NTHREADS) {
        const int kind = i >> 11, k = i & 2047;
        const float c = kind < 2 ? p->in[1][kind * 2048 + k] : p->in[3][k];
        act[i] = c / (1.0f + expf(-c));
    }
    __syncthreads();
    float* mvec = (float*)(p->ws + WS_MVEC);
    const int cg = tid % 48, kg = tid / 48;
    for (int unit = BID; unit < 256; unit += NBLK) {
        const int col4 = unit * 48 + cg, layer = col4 / 3072, n4 = col4 % 3072;
        f32x4 a0 = {0.f, 0.f, 0.f, 0.f}, a1 = a0, a2 = a0;
        if (kg < 10) {
            const f32x4* w = (const f32x4*)(p->in[4] + (size_t)layer * 2048 * 12288) + n4;
            for (int k = kg; k < 2048; k += 10) {
                const f32x4 wv = w[(size_t)k * 3072];
                a0 += act[k] * wv; a1 += act[2048 + k] * wv; a2 += act[4096 + k] * wv;
            }
            LAS float* r = red + (kg * 48 + cg) * 12;
#pragma unroll
            for (int j = 0; j < 4; ++j) { r[j] = a0[j]; r[4 + j] = a1[j]; r[8 + j] = a2[j]; }
        }
        __syncthreads();
        if (tid < 48 * 12) {
        }
        for (int o = tid; o < 48 * 12; o += NTHREADS) {
            const int c2 = o / 12, q = o % 12, kind = q >> 2, j = q & 3;
            float s = 0.f;
#pragma unroll
            for (int g = 0; g < 10; ++g) s += red[(g * 48 + c2) * 12 + q];
            const int cc4 = unit * 48 + c2, ly = cc4 / 3072, n = (cc4 % 3072) * 4 + j;
            mvec[((size_t)ly * 3 + kind) * 12288 + n] = s + p->in[5][(size_t)ly * 12288 + n];
        }
        __syncthreads();
    }
}

__device__ __forceinline__ void transpose_cvt(const float* __restrict__ src, int K, int N, bf16_t* __restrict__ dst, int Npad, LAS unsigned char* lds) {
    LAS float* t = (LAS float*)lds;
    const int tid = TID, tk = K / 64, tn = Npad / 64;
    for (int u = BID; u < tk * tn; u += NBLK) {
        const int k0 = (u % tk) * 64, n0 = (u / tk) * 64;
#pragma unroll
        for (int h = 0; h < 2; ++h) {
            const int r = (tid >> 4) + 32 * h, c4 = (tid & 15) * 4;
            f32x4 v = {0.f, 0.f, 0.f, 0.f};
            if (n0 + c4 < N) v = *(const f32x4*)(src + (size_t)(k0 + r) * N + n0 + c4);
#pragma unroll
            for (int j = 0; j < 4; ++j) t[r * 65 + c4 + j] = v[j];
        }
        __syncthreads();
        {
            const int n = tid >> 3, kc = (tid & 7) * 8;
            float f[8];
#pragma unroll
            for (int j = 0; j < 8; ++j) f[j] = t[(kc + j) * 65 + n];
            *(u32x4*)(dst + (size_t)(n0 + n) * K + k0 + kc) = pack8(f);
        }
        __syncthreads();
    }
}

__device__ __forceinline__ void cvt_bf16(const float* __restrict__ src, bf16_t* __restrict__ dst, size_t n) {
    const size_t n8 = n / 8, stride = (size_t)NBLK * NTHREADS;
    for (size_t i = (size_t)BID * NTHREADS + TID; i < n8; i += stride) {
        const f32x4 a = *(const f32x4*)(src + i * 8), b = *(const f32x4*)(src + i * 8 + 4);
        u32x4 w; w.x = cvt_pk(a[0], a[1]); w.y = cvt_pk(a[2], a[3]); w.z = cvt_pk(b[0], b[1]); w.w = cvt_pk(b[2], b[3]);
        *(u32x4*)(dst + i * 8) = w;
    }
}

PHASE_FN void ph_hdn3(KP p) {
    p = launder_kp(p);
    const int lane = TID & 63, wid = TID >> 6;
    float* hdn3 = (float*)(p->ws + WS_HDN3);
    for (int pp = BID * NWAVES + wid; pp < 2 * 8448; pp += NBLK * NWAVES) {
        const int e = pp / 8448, pos = pp % 8448;
        const int L = pos < 8192 ? 8192 : 256, i = pos < 8192 ? pos : pos - 8192;
        const float* w1 = p->in[13] + (size_t)e * 33 * 64; const float* b1 = p->in[14] + e * 64;
        const float* w2 = p->in[15] + (size_t)e * 64 * 64; const float* b2 = p->in[16] + e * 64;
        const float* w3 = p->in[17] + (size_t)e * 64 * 64; const float* b3 = p->in[18] + e * 64;
        const float fr = p->in[20][e * 64 + lane];
        const float t = (float)i / (float)(L - 1);
        const float w = (float)(6.283185307179586 / (double)L) * (float)i;
        float feat = 0.f;
        if (lane == 0) feat = t;
        else if (lane < 33) {
            const int k = (lane - 1) & 15;
            const float fk = 1e-4f + (float)k * ((15.0f - 1e-4f) / 15.0f);
            feat = lane < 17 ? cosf(fk * w) : -sinf(fk * w);
        }
        float acc = b1[lane];
#pragma unroll
        for (int f = 0; f < 33; ++f) acc += __builtin_bit_cast(float, __builtin_amdgcn_readlane(__builtin_bit_cast(int, feat), f)) * w1[f * 64 + lane];
        float hcur = sinf(fr * acc);
        acc = b2[lane];
#pragma unroll
        for (int f = 0; f < 64; ++f) acc += __builtin_bit_cast(float, __builtin_amdgcn_readlane(__builtin_bit_cast(int, hcur), f)) * w2[f * 64 + lane];
        hcur = sinf(fr * acc);
        acc = b3[lane];
#pragma unroll
        for (int f = 0; f < 64; ++f) acc += __builtin_bit_cast(float, __builtin_amdgcn_readlane(__builtin_bit_cast(int, hcur), f)) * w3[f * 64 + lane];
        hcur = sinf(fr * acc);
        hdn3[((size_t)e * 8448 + pos) * 64 + lane] = hcur;
    }
}

PHASE_FN void ph_hk(KP p, LAS unsigned char* lds) {
    p = launder_kp(p);
    LAS float* hd = (LAS float*)lds;
    LAS float* wt = hd + 64 * 65;
    const int tid = TID;
    const float* hdn3 = (const float*)(p->ws + WS_HDN3);
    float* hk = (float*)(p->ws + WS_HK);
    for (int u = BID; u < 2 * 132 * 64; u += NBLK) {
        const int ctile = u % 64, ptile = (u / 64) % 132, e = u / (64 * 132);
        const int pos0 = ptile * 64, n0 = ctile * 64;
        {
            const int r = tid >> 3, k8 = (tid & 7) * 8;
            const f32x4 a = *(const f32x4*)(hdn3 + ((size_t)e * 8448 + pos0 + r) * 64 + k8), b = *(const f32x4*)(hdn3 + ((size_t)e * 8448 + pos0 + r) * 64 + k8 + 4);
#pragma unroll
            for (int j = 0; j < 4; ++j) { hd[r * 65 + k8 + j] = a[j]; hd[r * 65 + k8 + 4 + j] = b[j]; }
            const float* w4 = p->in[19] + (size_t)e * 64 * 4096;
            const f32x4 c = *(const f32x4*)(w4 + (size_t)r * 4096 + n0 + k8), d = *(const f32x4*)(w4 + (size_t)r * 4096 + n0 + k8 + 4);
#pragma unroll
            for (int j = 0; j < 4; ++j) { wt[r * 64 + k8 + j] = c[j]; wt[r * 64 + k8 + 4 + j] = d[j]; }
        }
        __syncthreads();
        {
            const int i = tid & 63, ng = tid >> 6;
            float acc[8];
#pragma unroll
            for (int j = 0; j < 8; ++j) acc[j] = 0.f;
            for (int k = 0; k < 64; ++k) {
                const float hv = hd[i * 65 + k];
#pragma unroll
                for (int j = 0; j < 8; ++j) acc[j] += hv * wt[k * 64 + ng * 8 + j];
            }
            const int pos = pos0 + i;
            const bool lat = pos < 8192;
            const int L = lat ? 8192 : 256, ii = lat ? pos : pos - 8192;
            const float t = (float)ii / (float)(L - 1);
            float* base = hk + (size_t)e * (HK_LAT + HK_CTX) + (lat ? 0 : HK_LAT);
#pragma unroll
            for (int j = 0; j < 8; ++j) {
                const int col = n0 + ng * 8 + j, dir = col >> 11, o = (col >> 10) & 1, c = col & 1023;
                const float a0 = -3.0701134573253944f, a1 = -15.350567286626973f;
                const float delta = fabsf(a0 + (float)(o * 1024 + c) * ((a1 - a0) / 2047.0f));
                base[((size_t)(o * 1024 + c) * 2 + dir) * L + ii] = acc[j] * expf(-t * delta);
            }
        }
        __syncthreads();
    }
}

PHASE_FN void ph_s5par(KP p) {
    p = launder_kp(p);
    cf2* abar = (cf2*)(p->ws + WS_ABAR); cf2* aT = (cf2*)(p->ws + WS_AT);
    bf16_t* bfrag = (bf16_t*)(p->ws + WS_BFRAG); bf16_t* cfrag = (bf16_t*)(p->ws + WS_CFRAG);
    for (int i = BID * NTHREADS + TID; i < 2 * 2 * 128 * 64; i += NBLK * NTHREADS) {
        const int pp = i & 63, g = (i >> 6) & 127, d = (i >> 13) & 1, il = i >> 14;
        const int gi = (il * 2 + d) * 128 + g;
        const double lre = p->in[27][(size_t)gi * 64 + pp], lim = p->in[28][(size_t)gi * 64 + pp];
        const double dt = exp((double)p->in[29][gi]);
        const double zr = lre * dt, zi = lim * dt;
        const double er = exp(zr), ar = er * cos(zi), ai = er * sin(zi);
        abar[i] = mk2((float)ar, (float)ai);
        const double eT = exp(zr * S5T);
        aT[i] = mk2((float)(eT * cos(zi * S5T)), (float)(eT * sin(zi * S5T)));
        const double nr = ar - 1.0, ni = ai, den = lre * lre + lim * lim;
        const double qr = (nr * lre + ni * lim) / den, qi = (ni * lre - nr * lim) / den;
        const size_t fb = (size_t)gi * 4 * 64 * 8;
#pragma unroll
        for (int c = 0; c < 16; ++c) {
            const double br = p->in[30][((size_t)gi * 64 + pp) * 16 + c], bi = p->in[31][((size_t)gi * 64 + pp) * 16 + c];
            const double rr = qr * br - qi * bi, ri = qr * bi + qi * br;
            const int ln = (pp & 31) + 32 * (c >> 3), j = c & 7;
            bfrag[fb + ((size_t)(0 + (pp >> 5)) * 64 + ln) * 8 + j] = f2bf((float)rr);
            bfrag[fb + ((size_t)(2 + (pp >> 5)) * 64 + ln) * 8 + j] = f2bf((float)ri);
            const float cr = p->in[32][((size_t)gi * 16 + c) * 64 + pp], ci = p->in[33][((size_t)gi * 16 + c) * 64 + pp];
#pragma unroll
            for (int ri2 = 0; ri2 < 2; ++ri2) {
                const int k = 2 * pp + ri2, ks = k >> 5, kgq = (k & 31) >> 3, jj = k & 7;
                cfrag[fb + ((size_t)ks * 64 + c + 16 * kgq) * 8 + jj] = f2bf(ri2 ? -ci : cr);
            }
        }
    }
}

PHASE_FN void ph_tw(KP p) {
    p = launder_kp(p);
    cf2* tw = (cf2*)(p->ws + WS_TW);
    for (int i = BID * NTHREADS + TID; i < 8192; i += NBLK * NTHREADS) {
        const double a = -6.283185307179586476925 * (double)i / 16384.0;
        tw[i] = mk2((float)cos(a), (float)sin(a));
    }
}

PHASE_FN void ph_hinit(KP p) {
    p = launder_kp(p);
    float* h = (float*)(p->ws + WS_H); bf16_t* xin = (bf16_t*)(p->ws + WS_XIN);
    const float* mvec = (const float*)(p->ws + WS_MVEC);
    const size_t n8 = (size_t)MROWS * DM / 8;
    for (size_t i = (size_t)BID * NTHREADS + TID; i < n8; i += (size_t)NBLK * NTHREADS) {
        const int r = (int)(i / 256), col = (int)(i % 256) * 8, b = r / TPB, pos = r % TPB;
        const float* src = pos < CTXL ? p->in[2] + ((size_t)b * CTXL + pos) * DM + col : p->in[0] + ((size_t)b * SEQ + (pos - CTXL)) * DM + col;
        const float* mv = mvec + (size_t)(pos < CTXL ? 2 : b) * 12288;
        const f32x4 a = *(const f32x4*)src, c = *(const f32x4*)(src + 4);
        *(f32x4*)(h + (size_t)r * DM + col) = a; *(f32x4*)(h + (size_t)r * DM + col + 4) = c;
        float f[8];
#pragma unroll
        for (int j = 0; j < 4; ++j) { f[j] = a[j] * (1.0f + mv[2048 + col + j]) + mv[col + j]; f[4 + j] = c[j] * (1.0f + mv[2048 + col + 4 + j]) + mv[col + 4 + j]; }
        *(u32x4*)(xin + (size_t)r * DM + col) = pack8(f);
    }
}

template <class AddrF> struct EpiBf16G {
    static constexpr bool PERM = true, AFTER_DRAIN = false;
    AddrF F;
    __device__ __forceinline__ void operator()(const pg8::f32x4 (&acc)[2][2][4][2], const pg8::Unit& u, int wr, int wc, int fr, int fq) const {
        const int row0 = u.pm * 256 + wr * 64 + fr, col0 = u.pn * 256 + wc * 32 + 8 * fq;
#pragma unroll
        for (int ai = 0; ai < 2; ++ai)
#pragma unroll
            for (int m = 0; m < 4; ++m)
#pragma unroll
                for (int bj = 0; bj < 2; ++bj) {
                    const pg8::f32x4 v0 = acc[ai][bj][m][0], v1 = acc[ai][bj][m][1];
                    u32x4 w; w.x = cvt_pk(v0[0], v0[1]); w.y = cvt_pk(v0[2], v0[3]); w.z = cvt_pk(v1[0], v1[1]); w.w = cvt_pk(v1[2], v1[3]);
                    *(u32x4*)F(row0 + ai * 128 + m * 16, col0 + bj * 128) = w;
                }
    }
};
struct AddrPlain { bf16_t* base; int ld; __device__ __forceinline__ bf16_t* operator()(int row, int col) const { return base + (size_t)row * ld + col; } };
struct AddrQ { bf16_t* q; __device__ __forceinline__ bf16_t* operator()(int row, int col) const {
    const int b = row / TPB, pos = row - b * TPB, h = col / DQK, d = col - h * DQK; return q + ((size_t)(b * NH + h) * TPB + pos) * DQK + d; } };
struct AddrKV { bf16_t* k; bf16_t* v; __device__ __forceinline__ bf16_t* operator()(int row, int col) const {
    const int b = row / TPB, pos = row - b * TPB, h = col >> 8, w = col & 255; const size_t rr = (size_t)(b * NH + h) * TPB + pos;
    return w < 128 ? k + rr * DQK + w : v + rr * DVH + (w - 128); } };

template <class Epi> __device__ __forceinline__ void run_gemm(LAS unsigned char* lds, const bf16_t* A, const bf16_t* Bt, int M, int N, int K, const Epi& E) {
    pg8::Gemm g{A, Bt, M, N, K}; pg8::StaticOrder S; S.init(M, N, NBLK, BID);
    pg8::gemm_phase<Epi, pg8::StaticOrder, false>((PG8_LAS unsigned char*)lds, g, S, E, nullptr);
}

PHASE_FN void ph_e2a_rows(KP p, int e) {
    p = launder_kp(p);
    const int lane = TID & 63, wid = TID >> 6;
    const bf16_t* z = (const bf16_t*)(p->ws + WS_Z);
    bf16_t* qn = (bf16_t*)(p->ws + WS_QN); bf16_t* kvn = (bf16_t*)(p->ws + WS_KVN); bf16_t* Kb = (bf16_t*)(p->ws + WS_K);
    const float* qg = p->in[22] + e * QRANK; const float* kg = p->in[24] + e * KVRANK;
    float qgv[8], kgv[4];
#pragma unroll
    for (int j = 0; j < 8; ++j) qgv[j] = qg[lane * 8 + j];
#pragma unroll
    for (int j = 0; j < 4; ++j) kgv[j] = kg[lane * 4 + j];
    const int f16i = lane & 15;
    const float inv = exp2f(-(float)f16i * (13.287712379549449f / 16.0f));
    for (int r = BID * NWAVES + wid; r < MROWS; r += NBLK * NWAVES) {
        const bf16_t* zr = z + (size_t)r * INWP;
        const int b = r / TPB, pos = r - b * TPB;
        {
            const u32x4 w = *(const u32x4*)(zr + OHY + lane * 8);
            float f[8]; unpack8(w, f);
            float ss = 0.f;
#pragma unroll
            for (int j = 0; j < 8; ++j) ss += f[j] * f[j];
            ss = wave_sum(ss);
            const float rs = rsqrtf(ss * (1.0f / QRANK) + RMS_EPS);
#pragma unroll
            for (int j = 0; j < 8; ++j) f[j] = f[j] * rs * qgv[j];
            *(u32x4*)(qn + (size_t)r * QRANK + lane * 8) = pack8(f);
        }
        {
            const u32x2 w = *(const u32x2*)(zr + OQ + lane * 4);
            float f0 = bflo(w.x), f1 = bfhi(w.x), f2 = bflo(w.y), f3 = bfhi(w.y);
            float ss = wave_sum(f0 * f0 + f1 * f1 + f2 * f2 + f3 * f3);
            const float rs = rsqrtf(ss * (1.0f / KVRANK) + RMS_EPS);
            u32x2 o; o.x = cvt_pk(f0 * rs * kgv[0], f1 * rs * kgv[1]); o.y = cvt_pk(f2 * rs * kgv[2], f3 * rs * kgv[3]);
            *(u32x2*)(kvn + (size_t)r * KVRANK + lane * 4) = o;
        }
        {
            const float x = bf2f(zr[OKV + lane]);
            const float xp = __shfl_xor(x, 16);
            float o = x;
            if (pos >= CTXL) {
                const int t = pos - CTXL;
                const float ang = (float)((lane & 32) ? (t & 63) : (t >> 6)) * inv;
                const float rev = ang * 0.15915494309189535f; const float fr_ = rev - floorf(rev); const float sn = __builtin_amdgcn_sinf(fr_), cs = __builtin_amdgcn_cosf(fr_);
                o = (lane & 16) ? x * cs + xp * sn : x * cs - xp * sn;
            }
            const bf16_t ob = f2bf(o);
#pragma unroll
            for (int h = 0; h < NH; ++h) Kb[((size_t)(b * NH + h) * TPB + pos) * DQK + 128 + lane] = ob;
        }
    }
}

PHASE_FN void ph_e2a_conv(KP p, int e, LAS unsigned char* lds) {
    p = launder_kp(p);
    LAS bf16_t* T = (LAS bf16_t*)lds;
    const int tid = TID;
    const bf16_t* z = (const bf16_t*)(p->ws + WS_Z);
    bf16_t* zct = (bf16_t*)(p->ws + WS_ZCT);
    const float* cw = p->in[11] + (size_t)e * 3 * OHY; const float* cb = p->in[12] + (size_t)e * OHY;
    for (int u = BID; u < 264 * 24; u += NBLK) {
        const int ct = u % 24, rt = u / 24, b = rt / 132, tt = rt % 132;
        const int pos0 = tt * 64, seq_lo = tt < 4 ? 0 : CTXL, seq_hi = tt < 4 ? CTXL : TPB;
        {
            const int row = tid >> 3, chunk = tid & 7, ch0 = ct * 128 + chunk * 16, pos = pos0 + row;
            const bf16_t* zc = z + ((size_t)(b * TPB + pos)) * INWP + ch0;
            float cur[16], prv[16], nxt[16];
            { float f[8]; unpack8(*(const u32x4*)zc, f); for (int j = 0; j < 8; ++j) cur[j] = f[j]; unpack8(*(const u32x4*)(zc + 8), f); for (int j = 0; j < 8; ++j) cur[8 + j] = f[j]; }
            if (pos - 1 >= seq_lo) { float f[8]; unpack8(*(const u32x4*)(zc - INWP), f); for (int j = 0; j < 8; ++j) prv[j] = f[j]; unpack8(*(const u32x4*)(zc - INWP + 8), f); for (int j = 0; j < 8; ++j) prv[8 + j] = f[j]; }
            else { for (int j = 0; j < 16; ++j) prv[j] = 0.f; }
            if (pos + 1 < seq_hi) { float f[8]; unpack8(*(const u32x4*)(zc + INWP), f); for (int j = 0; j < 8; ++j) nxt[j] = f[j]; unpack8(*(const u32x4*)(zc + INWP + 8), f); for (int j = 0; j < 8; ++j) nxt[8 + j] = f[j]; }
            else { for (int j = 0; j < 16; ++j) nxt[j] = 0.f; }
#pragma unroll
            for (int j = 0; j < 16; ++j) {
                const int ch = ch0 + j;
                const float o = prv[j] * cw[ch] + cur[j] * cw[OHY + ch] + nxt[j] * cw[2 * OHY + ch] + cb[ch];
                T[(chunk * 16 + j) * 72 + row] = f2bf(o);
            }
        }
        __syncthreads();
#pragma unroll
        for (int k = 0; k < 2; ++k) {
            const int q = tid + k * NTHREADS, ch = q >> 3, pc = q & 7;
            const u32x4 w = *(const LAS u32x4*)(T + ch * 72 + pc * 8);
            *(u32x4*)(zct + ((size_t)(ct * 128 + ch) * NB + b) * TPB + pos0 + pc * 8) = w;
        }
        __syncthreads();
    }
}

PHASE_FN void ph_e4_transpose(KP p, LAS unsigned char* lds) {
    p = launder_kp(p);
    LAS bf16_t* T = (LAS bf16_t*)lds;
    const int tid = TID;
    const bf16_t* yt = (const bf16_t*)(p->ws + WS_YT);
    bf16_t* cat = (bf16_t*)(p->ws + WS_CAT);
    for (int u = BID; u < NB * 132 * 16; u += NBLK) {
        const int ct = u % 16, tt = (u / 16) % 132, b = u / (16 * 132);
        const int pos0 = tt * 64, c0 = ct * 64;
        {
            const int ch = tid >> 3, pc = tid & 7;
            *(LAS u32x4*)(T + ch * 72 + pc * 8) = *(const u32x4*)(yt + ((size_t)(c0 + ch) * NB + b) * TPB + pos0 + pc * 8);
        }
        __syncthreads();
        {
            const int pos = tid >> 3, cc = tid & 7;
            unsigned short s[8];
#pragma unroll
            for (int j = 0; j < 8; ++j) s[j] = T[(cc * 8 + j) * 72 + pos];
            u32x4 w; w.x = s[0] | ((unsigned)s[1] << 16); w.y = s[2] | ((unsigned)s[3] << 16); w.z = s[4] | ((unsigned)s[5] << 16); w.w = s[6] | ((unsigned)s[7] << 16);
            *(u32x4*)(cat + ((size_t)(b * TPB + pos0 + pos)) * DM + c0 + cc * 8) = w;
        }
        __syncthreads();
    }
}

template <bool GATED> PHASE_FN void ph_ln_mix(KP p, int layer) {
    p = launder_kp(p);
    const int lane = TID & 63, wid = TID >> 6;
    float* h = (float*)(p->ws + WS_H); bf16_t* xffn = (bf16_t*)(p->ws + WS_XFFN);
    const bf16_t* ysrc = (const bf16_t*)(p->ws + (GATED ? WS_Z : WS_YMIX));
    const float* mvec = (const float*)(p->ws + WS_MVEC) + (size_t)layer * 3 * 12288;
    const float* lg = p->in[6] + (size_t)layer * DM; const float* lb = p->in[7] + (size_t)layer * DM;
    for (int r = BID * NWAVES + wid; r < MROWS; r += NBLK * NWAVES) {
        const int b = r / TPB, pos = r - b * TPB;
        const float* mv = mvec + (size_t)(pos < CTXL ? 2 : b) * 12288;
        float x[32];
        float s = 0.f;
#pragma unroll
        for (int c = 0; c < 4; ++c) {
            const int col = c * 512 + lane * 8;
            const f32x4 h0 = *(const f32x4*)(h + (size_t)r * DM + col), h1 = *(const f32x4*)(h + (size_t)r * DM + col + 4);
            float y[8];
            if (GATED) {
                float o[8], g[8];
                unpack8(*(const u32x4*)(ysrc + (size_t)r * 4096 + col), o); unpack8(*(const u32x4*)(ysrc + (size_t)r * 4096 + 2048 + col), g);
#pragma unroll
                for (int j = 0; j < 8; ++j) y[j] = o[j] / (1.0f + __expf(-g[j]));
            } else unpack8(*(const u32x4*)(ysrc + (size_t)r * DM + col), y);
            const f32x4 g0 = *(const f32x4*)(mv + 2 * 2048 + col), g1 = *(const f32x4*)(mv + 2 * 2048 + col + 4);
#pragma unroll
            for (int j = 0; j < 4; ++j) { x[c * 8 + j] = DN_ALPHA * h0[j] + g0[j] * y[j]; x[c * 8 + 4 + j] = DN_ALPHA * h1[j] + g1[j] * y[4 + j]; }
#pragma unroll
            for (int j = 0; j < 8; ++j) s += x[c * 8 + j];
        }
        const float mean = wave_sum(s) * (1.0f / DM);
        float q = 0.f;
#pragma unroll
        for (int j = 0; j < 32; ++j) { x[j] -= mean; q += x[j] * x[j]; }
        const float rstd = rsqrtf(wave_sum(q) * (1.0f / DM) + LN_EPS);
#pragma unroll
        for (int c = 0; c < 4; ++c) {
            const int col = c * 512 + lane * 8;
            float hn[8], xf[8];
#pragma unroll
            for (int j = 0; j < 8; ++j) {
                hn[j] = x[c * 8 + j] * rstd * lg[col + j] + lb[col + j];
                xf[j] = hn[j] * (1.0f + mv[4 * 2048 + col + j]) + mv[3 * 2048 + col + j];
            }
            *(f32x4*)(h + (size_t)r * DM + col) = (f32x4){hn[0], hn[1], hn[2], hn[3]};
            *(f32x4*)(h + (size_t)r * DM + col + 4) = (f32x4){hn[4], hn[5], hn[6], hn[7]};
            *(u32x4*)(xffn + (size_t)r * DM + col) = pack8(xf);
        }
    }
}

namespace att {
constexpr int QBLK = 32, KVBLK = 64;
constexpr int SHM_V = KVBLK * 128 * 2, SHM_KN = KVBLK * 128 * 2, SHM_KR = KVBLK * 64 * 2;
#ifndef ATT_NQL
#define ATT_NQL 8
#endif
constexpr int NQL = ATT_NQL;
constexpr int OFF_V = 0, OFF_KN = 2 * SHM_V, OFF_KR = OFF_KN + 2 * SHM_KN, OFF_WS = OFF_KR + 2 * SHM_KR, OFF_QS = OFF_WS + NWAVES * 64 * 4, SHM_ATTN = OFF_QS + NWAVES * NQL * 64 * 16;
#ifndef ATT_SDEPTH
#define ATT_SDEPTH 1
#endif
constexpr int SDEPTH = ATT_SDEPTH;
constexpr float THR = 8.f;
#define KSWZ(row, colB) ((row) * 256 + ((colB) ^ (((row) & 7) << 4)))
#define KRSWZ(row, colB) ((row) * 128 + ((colB) ^ ((((row) >> 1) & 7) << 4)))
#define SBAR() __builtin_amdgcn_sched_barrier(0)
__device__ __forceinline__ int crow(int r, int hi) { return (r & 3) + 8 * (r >> 2) + 4 * hi; }

__device__ __forceinline__ void partialSM(f32x16& p0, f32x16& p1, float& m_reg, float& mn, float& alpha) {
    constexpr float C = MLA_SCALE * 1.4426950408889634f;
    float pmax = p0[0];
#pragma unroll
    for (int r = 1; r < 16; ++r) pmax = fmaxf(pmax, p0[r]);
#pragma unroll
    for (int r = 0; r < 16; ++r) pmax = fmaxf(pmax, p1[r]);
    { auto rr = __builtin_amdgcn_permlane32_swap(__float_as_uint(pmax), __float_as_uint(pmax), false, false);
      pmax = fmaxf(__uint_as_float(rr[0]), __uint_as_float(rr[1])); }
    if (__builtin_expect(__all(pmax - m_reg <= THR / MLA_SCALE), 1)) { mn = m_reg; alpha = 1.f; }
    else { mn = fmaxf(m_reg, pmax); alpha = __builtin_amdgcn_exp2f((m_reg - mn) * C); m_reg = mn; }
    const float mnC = -mn * C;
#pragma unroll
    for (int r = 0; r < 16; ++r) p0[r] = fmaf(p0[r], C, mnC);
#pragma unroll
    for (int r = 0; r < 16; ++r) p1[r] = fmaf(p1[r], C, mnC);
#pragma unroll
    for (int r = 0; r < 16; ++r) p0[r] = __builtin_amdgcn_exp2f(p0[r]);
}
__device__ __forceinline__ void finishSM(f32x16& p0, f32x16& p1, float alpha, float& l_reg, bf16x8& pa0, bf16x8& pa1, bf16x8& pa2, bf16x8& pa3) {
#pragma unroll
    for (int r = 0; r < 16; ++r) p1[r] = __builtin_amdgcn_exp2f(p1[r]);
    float ps = 0;
#pragma unroll
    for (int r = 0; r < 16; ++r) ps += p0[r];
#pragma unroll
    for (int r = 0; r < 16; ++r) ps += p1[r];
    { auto rr = __builtin_amdgcn_permlane32_swap(__float_as_uint(ps), __float_as_uint(ps), false, false);
      ps = __uint_as_float(rr[0]) + __uint_as_float(rr[1]); }
    l_reg = l_reg * alpha + ps;
#define PK4(P, BASE, OUT) do { unsigned a0 = cvt_pk(P[BASE + 0], P[BASE + 1]), a1 = cvt_pk(P[BASE + 2], P[BASE + 3]);   \
    unsigned b0 = cvt_pk(P[BASE + 4], P[BASE + 5]), b1 = cvt_pk(P[BASE + 6], P[BASE + 7]);                              \
    auto r0 = __builtin_amdgcn_permlane32_swap(a0, b0, false, false); auto r1 = __builtin_amdgcn_permlane32_swap(a1, b1, false, false); \
    u32x4 w = {r0[0], r1[0], r0[1], r1[1]}; OUT = *reinterpret_cast<bf16x8*>(&w); } while (0)
    PK4(p0, 0, pa0); PK4(p0, 8, pa1); PK4(p1, 0, pa2); PK4(p1, 8, pa3);
#undef PK4
}
__device__ __forceinline__ void qkt(f32x16& p0, f32x16& p1, const char* Kn, const char* Kr, const bf16x8* qr, const char* qs, int r32, int hi) {
    p0 = f32x16{}; p1 = f32x16{};
#pragma unroll
    for (int d0 = 0; d0 < 8; ++d0) { const int cb = (d0 * 16 + hi * 8) * 2;
        const bf16x8 b0 = *reinterpret_cast<const bf16x8*>(Kn + KSWZ(r32, cb));
        const bf16x8 b1 = *reinterpret_cast<const bf16x8*>(Kn + KSWZ(32 + r32, cb));
        const bf16x8 qf = (d0 >= 12 - NQL) ? *reinterpret_cast<const bf16x8*>(qs + (d0 - (12 - NQL)) * 1024) : qr[d0];
        p0 = __builtin_amdgcn_mfma_f32_32x32x16_bf16(b0, qf, p0, 0, 0, 0);
        p1 = __builtin_amdgcn_mfma_f32_32x32x16_bf16(b1, qf, p1, 0, 0, 0);
        if (d0 == 3 || d0 == 7) SBAR(); }
#pragma unroll
    for (int d0 = 0; d0 < 4; ++d0) { const int cb = (d0 * 16 + hi * 8) * 2;
        const bf16x8 b0 = *reinterpret_cast<const bf16x8*>(Kr + KRSWZ(r32, cb));
        const bf16x8 b1 = *reinterpret_cast<const bf16x8*>(Kr + KRSWZ(32 + r32, cb));
        const bf16x8 qf = *reinterpret_cast<const bf16x8*>(qs + (8 + d0 - (12 - NQL)) * 1024);
        p0 = __builtin_amdgcn_mfma_f32_32x32x16_bf16(b0, qf, p0, 0, 0, 0);
        p1 = __builtin_amdgcn_mfma_f32_32x32x16_bf16(b1, qf, p1, 0, 0, 0); }
}
__device__ __forceinline__ int v_st(int k, int c) { const int kk = (k & ~0xC) | ((k & 4) << 1) | ((k & 8) >> 1); return ((kk >> 3) * 4 + (c >> 5)) * 512 + ((kk & 7) * 32 + (c & 31)) * 2; }
__device__ __forceinline__ int v_rd_base(int lane) { return ((lane & 3) << 3) | (((lane >> 2) & 3) << 6) | (((lane >> 4) & 1) << 5) | (((lane >> 5) & 1) << 8); }
constexpr int v_rd_off(int d0, int ks, int half) { return d0 * 512 + ks * 4096 + half * 2048; }
template <int OFF> __device__ __forceinline__ s16x4 tr_read(int vb) {
    s16x4 r; asm volatile("ds_read_b64_tr_b16 %0, %1 offset:%2" : "=&v"(r) : "v"(vb), "i"(OFF) : "memory"); return r;
}
template <int D0> __device__ __forceinline__ void pv_one(f32x16& od, int vb, bf16x8 pa0, bf16x8 pa1, bf16x8 pa2, bf16x8 pa3) {
    const s16x4 l0 = tr_read<v_rd_off(D0, 0, 0)>(vb), h0 = tr_read<v_rd_off(D0, 0, 1)>(vb), l1 = tr_read<v_rd_off(D0, 1, 0)>(vb), h1 = tr_read<v_rd_off(D0, 1, 1)>(vb);
    const s16x4 l2 = tr_read<v_rd_off(D0, 2, 0)>(vb), h2 = tr_read<v_rd_off(D0, 2, 1)>(vb), l3 = tr_read<v_rd_off(D0, 3, 0)>(vb), h3 = tr_read<v_rd_off(D0, 3, 1)>(vb);
    asm volatile("s_waitcnt lgkmcnt(0)" ::: "memory"); SBAR();
#define PK(L, H) (bf16x8){L[0], L[1], L[2], L[3], H[0], H[1], H[2], H[3]}
    od = __builtin_amdgcn_mfma_f32_32x32x16_bf16(pa0, PK(l0, h0), od, 0, 0, 0);
    od = __builtin_amdgcn_mfma_f32_32x32x16_bf16(pa1, PK(l1, h1), od, 0, 0, 0);
    od = __builtin_amdgcn_mfma_f32_32x32x16_bf16(pa2, PK(l2, h2), od, 0, 0, 0);
    od = __builtin_amdgcn_mfma_f32_32x32x16_bf16(pa3, PK(l3, h3), od, 0, 0, 0);
#undef PK
}
__device__ __forceinline__ void pv_d0(f32x16* o, int vb, bf16x8 pa0, bf16x8 pa1, bf16x8 pa2, bf16x8 pa3) {
    pv_one<0>(o[0], vb, pa0, pa1, pa2, pa3); pv_one<1>(o[1], vb, pa0, pa1, pa2, pa3); pv_one<2>(o[2], vb, pa0, pa1, pa2, pa3); pv_one<3>(o[3], vb, pa0, pa1, pa2, pa3);
}

__device__ __forceinline__ void attn_body(const bf16_t* __restrict__ Qb, const bf16_t* __restrict__ Kh, const bf16_t* __restrict__ Vh,
                                          bf16_t* __restrict__ Ob, int ldo, int seq, int rope_t0, char* lds) {
    const int tid = TID, wid = tid >> 6, lane = tid & 63, r32 = lane & 31, hi = lane >> 5;
    char* V_lds = lds + OFF_V; char* Kn_lds = lds + OFF_KN; char* Kr_lds = lds + OFF_KR;
    float* ws = (float*)(lds + OFF_WS) + wid * 64; float* li_l = ws; float* al_l = ws + 32;
    float m_reg = -1e30f, l_reg = 0; f32x16 o[4] = {}; bf16x8 qr[12];
    char* qs = lds + OFF_QS + (wid * NQL * 64 + lane) * 16;
    const bf16_t* Qw = Qb + (size_t)(wid * QBLK + r32) * DQK + hi * 8;
#pragma unroll
    for (int d0 = 0; d0 < 12; ++d0) qr[d0] = *reinterpret_cast<const bf16x8*>(Qw + d0 * 16);
    if (rope_t0 >= 0) {
        const int t = rope_t0 + wid * QBLK + r32;
        const float frow = (float)(t >> 6), fcol = (float)(t & 63);
#pragma unroll
        for (int ax = 0; ax < 2; ++ax) {
            u32x4 w0 = *reinterpret_cast<u32x4*>(&qr[8 + 2 * ax]), w1 = *reinterpret_cast<u32x4*>(&qr[9 + 2 * ax]);
            float x0[8], x1[8]; unpack8(w0, x0); unpack8(w1, x1);
#pragma unroll
            for (int j = 0; j < 8; ++j) {
                const float inv = exp2f(-(float)(hi * 8 + j) * (13.287712379549449f / 16.0f));
                const float ang = (ax ? fcol : frow) * inv;
                const float rev = ang * 0.15915494309189535f; const float fr_ = rev - floorf(rev); const float sn = __builtin_amdgcn_sinf(fr_), cs = __builtin_amdgcn_cosf(fr_);
                const float y0 = x0[j] * cs - x1[j] * sn, y1 = x1[j] * cs + x0[j] * sn;
                x0[j] = y0; x1[j] = y1;
            }
            w0 = pack8(x0); w1 = pack8(x1);
            qr[8 + 2 * ax] = *reinterpret_cast<bf16x8*>(&w0); qr[9 + 2 * ax] = *reinterpret_cast<bf16x8*>(&w1);
        }
    }
#pragma unroll
    for (int d0 = 12 - NQL; d0 < 12; ++d0) *reinterpret_cast<bf16x8*>(qs + (d0 - (12 - NQL)) * 1024) = qr[d0];
    const int sr = tid >> 4, sc = (tid & 15) * 8, vst0 = v_st(sr, sc), vst1 = v_st(32 + sr, sc);
    const int krr = tid >> 3, krc = (tid & 7) * 8;
    const int vb0 = (int)(uintptr_t)V_lds + v_rd_base(lane);
    struct { bf16x8 vs0, vs1, ks0, ks1, kr; } sr_[1];
#define SLOAD(i, k0) do { sr_[i].vs0 = *(const bf16x8*)(&Vh[(size_t)((k0) + sr) * DVH + sc]); sr_[i].vs1 = *(const bf16x8*)(&Vh[(size_t)((k0) + 32 + sr) * DVH + sc]); \
    sr_[i].ks0 = *(const bf16x8*)(&Kh[(size_t)((k0) + sr) * DQK + sc]); sr_[i].ks1 = *(const bf16x8*)(&Kh[(size_t)((k0) + 32 + sr) * DQK + sc]); \
    sr_[i].kr = *(const bf16x8*)(&Kh[(size_t)((k0) + krr) * DQK + 128 + krc]); } while (0)
#define SWRITE(b, i) do { *(bf16x8*)(V_lds + (b) * SHM_V + vst0) = sr_[i].vs0; *(bf16x8*)(V_lds + (b) * SHM_V + vst1) = sr_[i].vs1; const int kc = sc * 2; \
    *(bf16x8*)(Kn_lds + (b) * SHM_KN + KSWZ(sr, kc)) = sr_[i].ks0; *(bf16x8*)(Kn_lds + (b) * SHM_KN + KSWZ(32 + sr, kc)) = sr_[i].ks1; \
    *(bf16x8*)(Kr_lds + (b) * SHM_KR + KRSWZ(krr, krc * 2)) = sr_[i].kr; } while (0)
#define SWAIT() do { if constexpr (SDEPTH == 2) asm volatile("s_waitcnt vmcnt(5)" ::: "memory"); else asm volatile("s_waitcnt vmcnt(0)" ::: "memory"); } while (0)
#define RESC(a) do { if (__any((a) < 1.f)) { if (hi == 0) al_l[r32] = (a); asm volatile("s_waitcnt lgkmcnt(0)" ::: "memory"); \
    _Pragma("unroll") for (int d = 0; d < 4; ++d) _Pragma("unroll") for (int r = 0; r < 16; ++r) o[d][r] *= al_l[crow(r, hi)]; } } while (0)
    f32x16 p0, p1; float mn, al; bf16x8 pa0, pa1, pa2, pa3; const int NT = seq / KVBLK;
    SLOAD(0, 0); asm volatile("s_waitcnt vmcnt(0)" ::: "memory"); SWRITE(0, 0); __syncthreads();
    for (int j = 0; j < NT; ++j) {
        const int bsel = j & 1;
        if (j + 1 < NT) SLOAD(0, (j + 1) * KVBLK);
        SBAR();
        qkt(p0, p1, Kn_lds + bsel * SHM_KN, Kr_lds + bsel * SHM_KR, qr, qs, r32, hi);
        partialSM(p0, p1, m_reg, mn, al);
        RESC(al);
        finishSM(p0, p1, al, l_reg, pa0, pa1, pa2, pa3); SBAR();
        pv_d0(o, vb0 + bsel * SHM_V, pa0, pa1, pa2, pa3);
        if (j + 1 < NT) { asm volatile("s_waitcnt vmcnt(0)" ::: "memory"); if (bsel) { SWRITE(0, 0); } else { SWRITE(1, 0); } }
        __syncthreads();
    }
    if (hi == 0) li_l[r32] = l_reg; asm volatile("s_waitcnt lgkmcnt(0)" ::: "memory");
    float rli[16];
#pragma unroll
    for (int r = 0; r < 16; ++r) rli[r] = __builtin_amdgcn_rcpf(li_l[crow(r, hi)]);
    bf16_t* Ow = Ob + (size_t)(wid * QBLK) * ldo;
#pragma unroll
    for (int r = 0; r < 16; ++r) { const int orow = crow(r, hi);
#pragma unroll
        for (int d0 = 0; d0 < 4; ++d0) Ow[(size_t)orow * ldo + d0 * 32 + r32] = f2bf(o[d0][r] * rli[r]); }
#undef SLOAD
#undef SWRITE
#undef SWAIT
#undef RESC
}
}

PHASE_FN void ph_attention(KP p, LAS unsigned char* ldsl) {
    p = launder_kp(p);
    char* lds = (char*)ldsl;
    const bf16_t* Q = (const bf16_t*)(p->ws + WS_Q); const bf16_t* K = (const bf16_t*)(p->ws + WS_K); const bf16_t* V = (const bf16_t*)(p->ws + WS_V);
    bf16_t* cat = (bf16_t*)(p->ws + WS_CAT);
    for (int u = BID; u < 512 + 16; u += NBLK) {
        int b, h, q0, seq, rope;
        if (u < 512) { b = u >> 8; h = (u >> 5) & 7; const int qb = u & 31; q0 = CTXL + qb * 256; seq = TPB; rope = qb * 256; }
        else { const int v = u - 512; b = v >> 3; h = v & 7; q0 = 0; seq = CTXL; rope = -1; }
        const size_t hb = (size_t)(b * NH + h) * TPB;
        __syncthreads();
        att::attn_body(Q + (hb + q0) * DQK, K + hb * DQK, V + hb * DVH, cat + ((size_t)(b * TPB + q0)) * DM + 1024 + h * 128, DM, seq, rope, lds);
    }
    __syncthreads();
}

#define PADI(i) ((i) + (((i) >> 5) << 2))
namespace hy {
__device__ __forceinline__ cf2 cmul(cf2 a, cf2 b) { return mk2(a.x * b.x - a.y * b.y, a.x * b.y + a.y * b.x); }
__device__ __forceinline__ cf2 cmulc(cf2 a, cf2 b) { return mk2(a.x * b.x + a.y * b.y, a.y * b.x - a.x * b.y); }

template <int R, bool INV>
__device__ __forceinline__ void fft_pass(LAS cf2* X, int logN, int lm, const cf2* __restrict__ TW) {
    constexpr int G = 1 << R;
    const int lst = lm - R, st = 1 << lst, tws = 14 - lm;
    const int ngroups = 1 << (logN - R);
    for (int gi = TID; gi < ngroups; gi += NTHREADS) {
        const int blk = gi >> lst, j = gi & (st - 1), base = (blk << lm) + j;
        cf2 x[G];
#pragma unroll
        for (int q = 0; q < G; ++q) x[q] = X[PADI(base + (q << lst))];
        if (!INV) {
#pragma unroll
            for (int s = 0; s < R; ++s) {
                constexpr int dummy = 0; (void)dummy;
                const int half = G >> (s + 1);
#pragma unroll
                for (int q = 0; q < G; ++q) if ((q & half) == 0) {
                    const int e = j + ((q & (half - 1)) << lst);
                    const cf2 w = TW[e << (tws + s)];
                    const cf2 u = x[q], v = x[q + half];
                    x[q] = mk2(u.x + v.x, u.y + v.y);
                    x[q + half] = cmul(mk2(u.x - v.x, u.y - v.y), w);
                }
            }
        } else {
#pragma unroll
            for (int s = R - 1; s >= 0; --s) {
                const int half = G >> (s + 1);
#pragma unroll
                for (int q = 0; q < G; ++q) if ((q & half) == 0) {
                    const int e = j + ((q & (half - 1)) << lst);
                    const cf2 w = TW[e << (tws + s)];
                    const cf2 u = x[q], v = cmulc(x[q + half], w);
                    x[q] = mk2(u.x + v.x, u.y + v.y);
                    x[q + half] = mk2(u.x - v.x, u.y - v.y);
                }
            }
        }
#pragma unroll
        for (int q = 0; q < G; ++q) X[PADI(base + (q << lst))] = x[q];
    }
    __syncthreads();
}
__device__ __forceinline__ void fft_fwd(LAS cf2* X, int logN, const cf2* TW) {
    int lm = logN;
    while (lm - 5 >= 3) { fft_pass<3, false>(X, logN, lm, TW); lm -= 3; }
    if (lm - 5 == 2) { fft_pass<2, false>(X, logN, lm, TW); lm -= 2; }
    else if (lm - 5 == 1) { fft_pass<1, false>(X, logN, lm, TW); lm -= 1; }
    fft_pass<5, false>(X, logN, 5, TW);
}
__device__ __forceinline__ void fft_inv(LAS cf2* X, int logN, const cf2* TW) {
    fft_pass<5, true>(X, logN, 5, TW);
    int lm = 5; const int rem = (logN - 5) % 3;
    if (rem == 2) { lm += 2; fft_pass<2, true>(X, logN, lm, TW); }
    else if (rem == 1) { lm += 1; fft_pass<1, true>(X, logN, lm, TW); }
    while (lm < logN) { lm += 3; fft_pass<3, true>(X, logN, lm, TW); }
}
__device__ __forceinline__ float block_sum(float v, LAS float* red) {
    v = wave_sum(v);
    __syncthreads();
    if ((TID & 63) == 0) red[TID >> 6] = v;
    __syncthreads();
    float s = 0.f;
#pragma unroll
    for (int w = 0; w < NWAVES; ++w) s += red[w];
    return s;
}
}

PHASE_FN void ph_hyena(KP p, int e, LAS unsigned char* lds) {
    p = launder_kp(p);
    LAS cf2* X = (LAS cf2*)lds;
    LAS float* red = (LAS float*)(lds + 147456);
    const int tid = TID;
    const cf2* TW = (const cf2*)(p->ws + WS_TW);
    const bf16_t* zct = (const bf16_t*)(p->ws + WS_ZCT);
    bf16_t* yt = (bf16_t*)(p->ws + WS_YT);
    cf2* scr = (cf2*)(p->ws + WS_Z + (size_t)BID * FFT_SCR_PER_BLOCK);
    const float* hkb = (const float*)(p->ws + WS_HK) + (size_t)e * (HK_LAT + HK_CTX);
    for (int u = BID; u < 2048; u += NBLK) {
        const bool lat = u < 1024; const int c = u & 1023;
        const int L = lat ? 8192 : 256, N = 2 * L, logN = lat ? 14 : 9, pos0 = lat ? CTXL : 0;
        const float* hk = hkb + (lat ? 0 : HK_LAT);
        cf2* KS0 = scr; cf2* KS1 = scr + 16384; cf2* Y1 = scr + 32768;
        float rnorm[2];
        for (int o = 0; o < 2; ++o) {
            const float* hf = hk + ((size_t)(o * 1024 + c) * 2 + 0) * L; const float* hb = hk + ((size_t)(o * 1024 + c) * 2 + 1) * L;
            float asum = 0.f;
            for (int i = tid; i < L; i += NTHREADS) {
                const float f = hf[i], bk = hb[i];
                asum += fabsf(f) + fabsf(bk);
                X[PADI(i)] = mk2(f, 0.f);
                if (i == 0) X[PADI(L)] = mk2(0.f, 0.f); else X[PADI(N - i)] = mk2(bk, 0.f);
            }
            const float nrm = hy::block_sum(asum, red);
            rnorm[o] = 1.0f / (nrm * (float)N);
            hy::fft_fwd(X, logN, TW);
            cf2* KS = o ? KS1 : KS0;
            for (int i = tid; i < N; i += NTHREADS) KS[i] = X[PADI(i)];
            __syncthreads();
        }
        const bf16_t* x1p = zct + ((size_t)(c) * NB) * TPB + pos0;
        const bf16_t* x2p = zct + ((size_t)(1024 + c) * NB) * TPB + pos0;
        const bf16_t* vp = zct + ((size_t)(2048 + c) * NB) * TPB + pos0;
        for (int i = tid; i < L; i += NTHREADS) { X[PADI(i)] = mk2(bf2f(vp[i]), bf2f(vp[TPB + i])); X[PADI(L + i)] = mk2(0.f, 0.f); }
        __syncthreads();
        const float bias0 = p->in[21][(size_t)e * 2048 + c], bias1 = p->in[21][(size_t)e * 2048 + 1024 + c];
        for (int o = 0; o < 2; ++o) {
            hy::fft_fwd(X, logN, TW);
            const cf2* KS = o ? KS1 : KS0; const float rn = rnorm[o];
            for (int i = tid; i < N; i += NTHREADS) { const cf2 k = KS[i]; const cf2 d = X[PADI(i)]; const cf2 r = hy::cmul(d, k); X[PADI(i)] = mk2(r.x * rn, r.y * rn); }
            __syncthreads();
            hy::fft_inv(X, logN, TW);
            if (o == 0) {
                for (int i = tid; i < L; i += NTHREADS) {
                    const cf2 cv = X[PADI(i)];
                    const float v0 = bf2f(vp[i]), v1 = bf2f(vp[TPB + i]);
                    const float y0 = bf2f(x1p[i]) * (cv.x + v0 * bias0), y1 = bf2f(x1p[TPB + i]) * (cv.y + v1 * bias0);
                    Y1[i] = mk2(y0, y1);
                    X[PADI(i)] = mk2(y0, y1); X[PADI(L + i)] = mk2(0.f, 0.f);
                }
                __syncthreads();
            } else {
                for (int i = tid; i < L; i += NTHREADS) {
                    const cf2 cv = X[PADI(i)]; const cf2 y1v = Y1[i];
                    const float y0 = bf2f(x2p[i]) * (cv.x + y1v.x * bias1), y1 = bf2f(x2p[TPB + i]) * (cv.y + y1v.y * bias1);
                    yt[((size_t)c * NB + 0) * TPB + pos0 + i] = f2bf(y0);
                    yt[((size_t)c * NB + 1) * TPB + pos0 + i] = f2bf(y1);
                }
                __syncthreads();
            }
        }
    }
}

__device__ __forceinline__ int s5_pos(int d, int pi) { return d == 0 ? pi : (pi < CTXL ? CTXL - 1 - pi : (TPB + CTXL - 1) - pi); }

__device__ __forceinline__ void s5_bu(const bf16x8 ua, const bf16x8 (&bf)[4], float (&bre)[32], float (&bim)[32]) {
    const f32x16 z = {};
    f32x16 t0 = __builtin_amdgcn_mfma_f32_32x32x16_bf16(ua, bf[0], z, 0, 0, 0);
    f32x16 t1 = __builtin_amdgcn_mfma_f32_32x32x16_bf16(ua, bf[1], z, 0, 0, 0);
    f32x16 t2 = __builtin_amdgcn_mfma_f32_32x32x16_bf16(ua, bf[2], z, 0, 0, 0);
    f32x16 t3 = __builtin_amdgcn_mfma_f32_32x32x16_bf16(ua, bf[3], z, 0, 0, 0);
#pragma unroll
    for (int r = 0; r < 16; ++r) {
        const auto sr = __builtin_amdgcn_permlane32_swap(__float_as_uint(t0[r]), __float_as_uint(t1[r]), false, false);
        const auto si = __builtin_amdgcn_permlane32_swap(__float_as_uint(t2[r]), __float_as_uint(t3[r]), false, false);
        const int m0 = (r & 3) + 8 * (r >> 2);
        bre[m0] = __uint_as_float(sr[0]); bre[m0 + 4] = __uint_as_float(sr[1]);
        bim[m0] = __uint_as_float(si[0]); bim[m0 + 4] = __uint_as_float(si[1]);
    }
}

PHASE_FN void ph_s5_pass1(KP p, int il) {
    p = launder_kp(p);
    const int lane = TID & 63, wid = TID >> 6;
    const bf16_t* xin = (const bf16_t*)(p->ws + WS_XIN);
    const cf2* abar = (const cf2*)(p->ws + WS_ABAR); const bf16_t* bfrag = (const bf16_t*)(p->ws + WS_BFRAG);
    cf2* est = (cf2*)(p->ws + WS_EST);
    constexpr int NQ = S5NCH - 1, NU = NB * 128 * 2 * NQ;
    for (int u = BID * NWAVES + wid; u < NU; u += NBLK * NWAVES) {
        const int q = u % NQ, d = (u / NQ) & 1, g = (u / (NQ * 2)) & 127, b = u / (NQ * 2 * 128);
        const int gi = (il * 2 + d) * 128 + g;
        const cf2 a = abar[(size_t)gi * 64 + lane];
        bf16x8 bf[4];
#pragma unroll
        for (int t = 0; t < 4; ++t) bf[t] = *(const bf16x8*)(bfrag + (((size_t)gi * 4 + t) * 64 + lane) * 8);
        float sre = 0.f, sim = 0.f;
        for (int st = 0; st < S5T / 32; ++st) {
            const int pos = s5_pos(d, q * S5T + st * 32 + (lane & 31));
            const bf16x8 ua = *(const bf16x8*)(xin + ((size_t)(b * TPB + pos)) * DM + g * 16 + (lane >> 5) * 8);
            float bre[32], bim[32];
            s5_bu(ua, bf, bre, bim);
#pragma unroll
            for (int m = 0; m < 32; ++m) {
                const float nre = a.x * sre - a.y * sim + bre[m], nim = a.x * sim + a.y * sre + bim[m];
                sre = nre; sim = nim;
            }
        }
        est[(((size_t)(b * 128 + g) * 2 + d) * S5NCH + q) * 64 + lane] = mk2(sre, sim);
    }
}

PHASE_FN void ph_s5_pass2(KP p, int il, LAS unsigned char* lds) {
    p = launder_kp(p);
    const int lane = TID & 63, wid = TID >> 6;
    constexpr int SP = 272;
    LAS unsigned char* Sl = lds + wid * (32 * SP + S5T * 16 * 4);
    LAS float* Yl = (LAS float*)(Sl + 32 * SP);
    const bf16_t* xin = (const bf16_t*)(p->ws + WS_XIN);
    const cf2* abar = (const cf2*)(p->ws + WS_ABAR); const cf2* aTt = (const cf2*)(p->ws + WS_AT);
    const bf16_t* bfrag = (const bf16_t*)(p->ws + WS_BFRAG); const bf16_t* cfrag = (const bf16_t*)(p->ws + WS_CFRAG);
    const cf2* est = (const cf2*)(p->ws + WS_EST);
    bf16_t* gout = (bf16_t*)(p->ws + WS_CAT);
    const float* dsk = p->in[34] + (size_t)il * DM;
    constexpr int NU = NB * 128 * S5NCH;
    for (int u = BID * NWAVES + wid; u < NU; u += NBLK * NWAVES) {
        const int j = u % S5NCH, g = (u / S5NCH) & 127, b = u / (S5NCH * 128);
        const int pos0 = j * S5T;
#pragma unroll 1
        for (int d = 0; d < 2; ++d) {
            const int q = d == 0 ? j : (j < 2 ? 1 - j : (S5NCH + 1) - j);
            const int gi = (il * 2 + d) * 128 + g;
            const cf2 a = abar[(size_t)gi * 64 + lane], aT = aTt[(size_t)gi * 64 + lane];
            bf16x8 bf[4], cf[4];
#pragma unroll
            for (int t = 0; t < 4; ++t) { bf[t] = *(const bf16x8*)(bfrag + (((size_t)gi * 4 + t) * 64 + lane) * 8); cf[t] = *(const bf16x8*)(cfrag + (((size_t)gi * 4 + t) * 64 + lane) * 8); }
            float sre = 0.f, sim = 0.f;
            const cf2* ep = est + (((size_t)(b * 128 + g) * 2 + d) * S5NCH) * 64 + lane;
            for (int i0 = 0; i0 < q; i0 += 8) {
                cf2 ev[8];
#pragma unroll
                for (int k = 0; k < 8; ++k) ev[k] = (i0 + k < q) ? ep[(size_t)(i0 + k) * 64] : mk2(0.f, 0.f);
#pragma unroll
                for (int k = 0; k < 8; ++k) if (i0 + k < q) {
                    const float nre = aT.x * sre - aT.y * sim + ev[k].x, nim = aT.x * sim + aT.y * sre + ev[k].y;
                    sre = nre; sim = nim;
                }
            }
            for (int st = 0; st < S5T / 32; ++st) {
                const int pi0 = q * S5T + st * 32;
                const int pos = s5_pos(d, pi0 + (lane & 31));
                const bf16x8 ua = *(const bf16x8*)(xin + ((size_t)(b * TPB + pos)) * DM + g * 16 + (lane >> 5) * 8);
                float bre[32], bim[32];
                s5_bu(ua, bf, bre, bim);
#pragma unroll
                for (int m = 0; m < 32; ++m) {
                    const float nre = a.x * sre - a.y * sim + bre[m], nim = a.x * sim + a.y * sre + bim[m];
                    sre = nre; sim = nim;
                    *(LAS unsigned*)(Sl + m * SP + lane * 4) = cvt_pk(sre, sim);
                }
#pragma unroll
                for (int mt = 0; mt < 2; ++mt) {
                    f32x4 acc = {0.f, 0.f, 0.f, 0.f};
#pragma unroll
                    for (int ks = 0; ks < 4; ++ks) {
                        const bf16x8 sb = *(const LAS bf16x8*)(Sl + (mt * 16 + (lane & 15)) * SP + ks * 64 + (lane >> 4) * 16);
                        acc = __builtin_amdgcn_mfma_f32_16x16x32_bf16(cf[ks], sb, acc, 0, 0, 0);
                    }
                    const int tl = s5_pos(d, pi0 + mt * 16 + (lane & 15)) - pos0;
                    LAS f32x4* yp = (LAS f32x4*)(Yl + tl * 16 + 4 * (lane >> 4));
                    if (d == 0) *yp = acc; else { const f32x4 o = *yp; *yp = o + acc; }
                }
            }
        }
#pragma unroll
        for (int hrow = 0; hrow < 2; ++hrow) {
            const int tl = lane + 64 * hrow;
            const size_t ro = ((size_t)(b * TPB + pos0 + tl)) * DM + g * 16;
            float uu[16];
            { float f[8]; unpack8(*(const u32x4*)(xin + ro), f); for (int k = 0; k < 8; ++k) uu[k] = f[k]; unpack8(*(const u32x4*)(xin + ro + 8), f); for (int k = 0; k < 8; ++k) uu[8 + k] = f[k]; }
            float o[16];
#pragma unroll
            for (int c4 = 0; c4 < 4; ++c4) {
                const f32x4 yv = *(const LAS f32x4*)(Yl + tl * 16 + c4 * 4);
#pragma unroll
                for (int k = 0; k < 4; ++k) o[c4 * 4 + k] = gelu_tanh(yv[k] + dsk[g * 16 + c4 * 4 + k] * uu[c4 * 4 + k]);
            }
            float o0[8], o1[8];
#pragma unroll
            for (int k = 0; k < 8; ++k) { o0[k] = o[k]; o1[k] = o[8 + k]; }
            *(u32x4*)(gout + ro) = pack8(o0); *(u32x4*)(gout + ro + 8) = pack8(o1);
        }
    }
}

PHASE_FN void ph_peer_topk(KP p, int layer, LAS unsigned char* lds) {
    p = launder_kp(p);
    constexpr int PITCH = 257;
    LAS float* Sc = (LAS float*)lds;
    const int tid = TID, lane = tid & 63, wid = tid >> 6;
    const bf16_t* pq = (const bf16_t*)(p->ws + WS_PQ);
    const bf16_t* keys = (const bf16_t*)(p->ws + WS_KEYS) + (size_t)layer * 8 * 2 * 128 * 128;
    int* pidx = (int*)(p->ws + WS_PIDX); float* pgate = (float*)(p->ws + WS_PGATE);
    for (int u = BID; u < MROWS / 16; u += NBLK) {
        const int t0 = u * 16;
        {
            const int h = wid;
#pragma unroll 1
            for (int s = 0; s < 2; ++s) {
                bf16x8 af[4];
#pragma unroll
                for (int ks = 0; ks < 4; ++ks) af[ks] = *(const bf16x8*)(pq + (size_t)(t0 + (lane & 15)) * DM + h * 256 + s * 128 + ks * 32 + (lane >> 4) * 8);
                const bf16_t* kb = keys + ((size_t)(h * 2 + s) * 128) * 128;
#pragma unroll 2
                for (int nt = 0; nt < 8; ++nt) {
                    f32x4 acc = {0.f, 0.f, 0.f, 0.f};
#pragma unroll
                    for (int ks = 0; ks < 4; ++ks) {
                        const bf16x8 bfv = *(const bf16x8*)(kb + (size_t)(nt * 16 + (lane & 15)) * 128 + ks * 32 + (lane >> 4) * 8);
                        acc = __builtin_amdgcn_mfma_f32_16x16x32_bf16(af[ks], bfv, acc, 0, 0, 0);
                    }
#pragma unroll
                    for (int r = 0; r < 4; ++r) Sc[(h * 16 + 4 * (lane >> 4) + r) * PITCH + s * 128 + nt * 16 + (lane & 15)] = acc[r];
                }
            }
        }
        __syncthreads();
        float val[16]; int idx[16];
        if (tid < 256) {
            const int t = tid & 15, h = (tid >> 4) & 7, s = tid >> 7;
            const LAS float* sp = Sc + (h * 16 + t) * PITCH + s * 128;
#pragma unroll
            for (int k = 0; k < 16; ++k) { val[k] = -3.0e38f; idx[k] = 0; }
            for (int n = 0; n < 128; ++n) {
                float v = sp[n]; int iv = n;
#pragma unroll
                for (int k = 0; k < 16; ++k) {
                    const bool gt = v > val[k];
                    const float tv = gt ? val[k] : v; const int ti = gt ? idx[k] : iv;
                    val[k] = gt ? v : val[k]; idx[k] = gt ? iv : idx[k];
                    v = tv; iv = ti;
                }
            }
        }
        __syncthreads();
        LAS float* Lv = Sc; LAS int* Li = (LAS int*)(Sc + 4096);
        if (tid < 256) {
            const int t = tid & 15, h = (tid >> 4) & 7, s = tid >> 7, base = ((h * 16 + t) * 2 + s) * 16;
#pragma unroll
            for (int k = 0; k < 16; ++k) { Lv[base + k] = val[k]; Li[base + k] = idx[k]; }
        }
        __syncthreads();
        if (tid < 128) {
            const int t = tid & 15, h = tid >> 4, base = ((h * 16 + t) * 2) * 16;
            float va[16], vb[16]; int ia[16], ib[16];
#pragma unroll
            for (int k = 0; k < 16; ++k) { va[k] = Lv[base + k]; ia[k] = Li[base + k]; vb[k] = Lv[base + 16 + k]; ib[k] = Li[base + 16 + k]; }
            float cv[16]; int ci[16];
#pragma unroll
            for (int k = 0; k < 16; ++k) { cv[k] = -3.0e38f; ci[k] = 0; }
#pragma unroll
            for (int i = 0; i < 16; ++i)
#pragma unroll
                for (int j = 0; j < 16; ++j) if ((i + 1) * (j + 1) <= 16) {
                    float v = va[i] + vb[j]; int iv = ia[i] * 128 + ib[j];
#pragma unroll
                    for (int k = 0; k < 16; ++k) {
                        const bool gt = v > cv[k];
                        const float tv = gt ? cv[k] : v; const int ti = gt ? ci[k] : iv;
                        cv[k] = gt ? v : cv[k]; ci[k] = gt ? iv : ci[k];
                        v = tv; iv = ti;
                    }
                }
            const float mx = cv[0];
            float ev[16], ssum = 0.f;
#pragma unroll
            for (int k = 0; k < 16; ++k) { ev[k] = __expf(cv[k] - mx); ssum += ev[k]; }
            const float rs = 1.0f / ssum;
            const size_t ob = (size_t)(t0 + t) * 128 + h * 16;
#pragma unroll
            for (int k4 = 0; k4 < 4; ++k4) {
                *(int4*)(pidx + ob + k4 * 4) = make_int4(ci[k4 * 4], ci[k4 * 4 + 1], ci[k4 * 4 + 2], ci[k4 * 4 + 3]);
                *(f32x4*)(pgate + ob + k4 * 4) = (f32x4){ev[k4 * 4] * rs, ev[k4 * 4 + 1] * rs, ev[k4 * 4 + 2] * rs, ev[k4 * 4 + 3] * rs};
            }
        }
        __syncthreads();
    }
}

PHASE_FN void ph_peer_gather(KP p, int layer) {
    p = launder_kp(p);
    const int lane = TID & 63, wid = TID >> 6;
    float* h = (float*)(p->ws + WS_H); bf16_t* xin = (bf16_t*)(p->ws + WS_XIN);
    const bf16_t* pu = (const bf16_t*)(p->ws + WS_PU) + (size_t)layer * 16384 * 2048;
    const bf16_t* pv = (const bf16_t*)(p->ws + WS_PV) + (size_t)layer * 16384 * 2048;
    const int* pidx = (const int*)(p->ws + WS_PIDX); const float* pgate = (const float*)(p->ws + WS_PGATE);
    const float* mvl = (const float*)(p->ws + WS_MVEC) + (size_t)layer * 3 * 12288;
    const float* mvn = (const float*)(p->ws + WS_MVEC) + (size_t)(layer < 3 ? layer + 1 : 3) * 3 * 12288;
    const float* lg = p->in[8] + (size_t)layer * DM; const float* lb = p->in[9] + (size_t)layer * DM;
    for (int tok = BID * NWAVES + wid; tok < MROWS; tok += NBLK * NWAVES) {
        const int b = tok / TPB, pos = tok - b * TPB, kind = pos < CTXL ? 2 : b;
        const float* mv = mvl + (size_t)kind * 12288;
        float x[32];
#pragma unroll
        for (int c = 0; c < 4; ++c) {
            const int col = c * 512 + lane * 8;
            const f32x4 h0 = *(const f32x4*)(h + (size_t)tok * DM + col), h1 = *(const f32x4*)(h + (size_t)tok * DM + col + 4);
#pragma unroll
            for (int j = 0; j < 4; ++j) { x[c * 8 + j] = h0[j] * (1.0f + mv[4 * 2048 + col + j]) + mv[3 * 2048 + col + j]; x[c * 8 + 4 + j] = h1[j] * (1.0f + mv[4 * 2048 + col + 4 + j]) + mv[3 * 2048 + col + 4 + j]; }
        }
        const int id0 = pidx[(size_t)tok * 128 + lane], id1 = pidx[(size_t)tok * 128 + 64 + lane];
        const float g0 = pgate[(size_t)tok * 128 + lane], g1 = pgate[(size_t)tok * 128 + 64 + lane];
        float act0 = 0.f, act1 = 0.f;
#pragma unroll 1
        for (int eg = 0; eg < 32; ++eg) {
            u32x4 rw[4][4];
#pragma unroll
            for (int k = 0; k < 4; ++k) {
                const int e = eg * 4 + k;
                const int id = __builtin_amdgcn_readlane(eg < 16 ? id0 : id1, e & 63);
                const bf16_t* row = pu + (size_t)id * DM + lane * 8;
#pragma unroll
                for (int c = 0; c < 4; ++c) rw[k][c] = *(const u32x4*)(row + c * 512);
            }
            float dk[4];
#pragma unroll
            for (int k = 0; k < 4; ++k) {
                float d = 0.f;
#pragma unroll
                for (int c = 0; c < 4; ++c) { float f[8]; unpack8(rw[k][c], f);
#pragma unroll
                    for (int j = 0; j < 8; ++j) d += f[j] * x[c * 8 + j]; }
                dk[k] = d;
            }
#pragma unroll
            for (int o = 32; o >= 1; o >>= 1) {
#pragma unroll
                for (int k = 0; k < 4; ++k) dk[k] += __shfl_xor(dk[k], o);
            }
#pragma unroll
            for (int k = 0; k < 4; ++k) {
                const int e = eg * 4 + k; const float a = gelu_tanh(dk[k]);
                if (eg < 16) act0 = (lane == (e & 63)) ? a : act0; else act1 = (lane == (e & 63)) ? a : act1;
            }
        }
        const float cf0 = g0 * act0, cf1 = g1 * act1;
        float out[32];
#pragma unroll
        for (int j = 0; j < 32; ++j) out[j] = 0.f;
#pragma unroll 1
        for (int eg = 0; eg < 32; ++eg) {
            u32x4 rw[4][4]; float cfk[4];
#pragma unroll
            for (int k = 0; k < 4; ++k) {
                const int e = eg * 4 + k;
                const int id = __builtin_amdgcn_readlane(eg < 16 ? id0 : id1, e & 63);
                cfk[k] = __builtin_bit_cast(float, __builtin_amdgcn_readlane(__builtin_bit_cast(int, eg < 16 ? cf0 : cf1), e & 63));
                const bf16_t* row = pv + (size_t)id * DM + lane * 8;
#pragma unroll
                for (int c = 0; c < 4; ++c) rw[k][c] = *(const u32x4*)(row + c * 512);
            }
#pragma unroll
            for (int k = 0; k < 4; ++k)
#pragma unroll
                for (int c = 0; c < 4; ++c) { float f[8]; unpack8(rw[k][c], f);
#pragma unroll
                    for (int j = 0; j < 8; ++j) out[c * 8 + j] += cfk[k] * f[j]; }
        }
        float s = 0.f;
#pragma unroll
        for (int c = 0; c < 4; ++c) {
            const int col = c * 512 + lane * 8;
            const f32x4 h0 = *(const f32x4*)(h + (size_t)tok * DM + col), h1 = *(const f32x4*)(h + (size_t)tok * DM + col + 4);
#pragma unroll
            for (int j = 0; j < 4; ++j) { out[c * 8 + j] = DN_ALPHA * h0[j] + mv[5 * 2048 + col + j] * out[c * 8 + j]; out[c * 8 + 4 + j] = DN_ALPHA * h1[j] + mv[5 * 2048 + col + 4 + j] * out[c * 8 + 4 + j]; }
#pragma unroll
            for (int j = 0; j < 8; ++j) s += out[c * 8 + j];
        }
        const float mean = wave_sum(s) * (1.0f / DM);
        float q = 0.f;
#pragma unroll
        for (int j = 0; j < 32; ++j) { out[j] -= mean; q += out[j] * out[j]; }
        const float rstd = rsqrtf(wave_sum(q) * (1.0f / DM) + LN_EPS);
        const float* mn = mvn + (size_t)kind * 12288;
#pragma unroll
        for (int c = 0; c < 4; ++c) {
            const int col = c * 512 + lane * 8;
            float hn[8], xf[8];
#pragma unroll
            for (int j = 0; j < 8; ++j) { hn[j] = out[c * 8 + j] * rstd * lg[col + j] + lb[col + j]; xf[j] = hn[j] * (1.0f + mn[2048 + col + j]) + mn[col + j]; }
            if (layer < 3) {
                *(f32x4*)(h + (size_t)tok * DM + col) = (f32x4){hn[0], hn[1], hn[2], hn[3]};
                *(f32x4*)(h + (size_t)tok * DM + col + 4) = (f32x4){hn[4], hn[5], hn[6], hn[7]};
                *(u32x4*)(xin + (size_t)tok * DM + col) = pack8(xf);
            } else if (pos >= CTXL) {
                float* o = p->out + ((size_t)b * SEQ + (pos - CTXL)) * DM + col;
                *(f32x4*)o = (f32x4){hn[0], hn[1], hn[2], hn[3]}; *(f32x4*)(o + 4) = (f32x4){hn[4], hn[5], hn[6], hn[7]};
            }
        }
    }
}

constexpr int PH_PER_PAIR = 17, N_PHASES = 2 + 2 * PH_PER_PAIR;

PHASE_FN void ph_p0_convert(KP p, LAS unsigned char* lds) {
    p = launder_kp(p);
    for (int e = 0; e < 2; ++e) {
        transpose_cvt(p->in[10] + (size_t)e * 2048 * INW, 2048, INW, (bf16_t*)(p->ws + WS_WIN) + (size_t)e * 4096 * 2048, 4096, lds);
        transpose_cvt(p->in[23] + (size_t)e * 512 * 1536, 512, 1536, (bf16_t*)(p->ws + WS_WUQ) + (size_t)e * 1536 * 512, 1536, lds);
        transpose_cvt(p->in[25] + (size_t)e * 256 * 2048, 256, 2048, (bf16_t*)(p->ws + WS_WUKV) + (size_t)e * 2048 * 256, 2048, lds);
        transpose_cvt(p->in[26] + (size_t)e * 2048 * 2048, 2048, 2048, (bf16_t*)(p->ws + WS_WO) + (size_t)e * 2048 * 2048, 2048, lds);
        transpose_cvt(p->in[35] + (size_t)e * 2048 * 2048, 2048, 2048, (bf16_t*)(p->ws + WS_OD) + (size_t)e * 4096 * 2048, 2048, lds);
        transpose_cvt(p->in[36] + (size_t)e * 2048 * 2048, 2048, 2048, (bf16_t*)(p->ws + WS_OD) + (size_t)e * 4096 * 2048 + (size_t)2048 * 2048, 2048, lds);
    }
    for (int l = 0; l < 4; ++l)
        transpose_cvt(p->in[37] + (size_t)l * 2048 * 2048, 2048, 2048, (bf16_t*)(p->ws + WS_WQ) + (size_t)l * 2048 * 2048, 2048, lds);
    cvt_bf16(p->in[38], (bf16_t*)(p->ws + WS_KEYS), (size_t)4 * 8 * 2 * 128 * 128);
    cvt_bf16(p->in[39], (bf16_t*)(p->ws + WS_PU), (size_t)4 * 16384 * 2048);
    cvt_bf16(p->in[40], (bf16_t*)(p->ws + WS_PV), (size_t)4 * 16384 * 2048);
}
PHASE_FN void ph_gemm_plain(LAS unsigned char* lds, const bf16_t* A, const bf16_t* Bt, bf16_t* C, int N, int K, int ldc) {
    EpiBf16G<AddrPlain> E{{C, ldc}};
    run_gemm(lds, A, Bt, MROWS, N, K, E);
}
PHASE_FN void ph_gemm_q(LAS unsigned char* lds, const bf16_t* A, const bf16_t* Bt, bf16_t* Q) {
    EpiBf16G<AddrQ> E{{Q}};
    run_gemm(lds, A, Bt, MROWS, 1536, QRANK, E);
}
PHASE_FN void ph_gemm_kv(LAS unsigned char* lds, const bf16_t* A, const bf16_t* Bt, bf16_t* K, bf16_t* V) {
    EpiBf16G<AddrKV> E{{K, V}};
    run_gemm(lds, A, Bt, MROWS, 2048, KVRANK, E);
}

__global__ void __launch_bounds__(NTHREADS, 2) hybrid_fwd(Params pv) {
    extern __shared__ __attribute__((aligned(16))) unsigned char lds_raw[];
    LAS unsigned char* lds = (LAS unsigned char*)lds_raw;
    KP p = (KP)__builtin_amdgcn_kernarg_segment_ptr();
    volatile LAS unsigned* xbw = (volatile LAS unsigned*)(lds + LDS_BYTES - 64);
    if (threadIdx.x < 4) xbw[threadIdx.x] = 0u;
    __syncthreads();
    const int lo = pv.ph_lo, hi = pv.ph_hi;
    unsigned char* ws = pv.ws;
    XcdBarrier bar; bar.bar = (unsigned*)(ws + WS_CTL); bar.x = 0; bar.st = xbw;
    if (hi - lo > 1) bar = xcd_barrier_post((unsigned*)(ws + WS_CTL), xbw);
#define IN(k) (lo <= (k) && (k) < hi)
#define SEAM(k) do { if (IN(k) && IN((k) + 1)) xcd_barrier(bar); } while (0)

    if (IN(0)) { ph_mod(p, lds); ph_p0_convert(p, lds); ph_hdn3(p); ph_s5par(p); ph_tw(p); }
    SEAM(0);
    if (IN(1)) { ph_hinit(p); ph_hk(p, lds); }
    SEAM(1);

#pragma unroll 1
    for (int pair = 0; pair < 2; ++pair) {
        const int pb = 2 + pair * PH_PER_PAIR;
        const int le = 2 * pair, lod = 2 * pair + 1;
        if (IN(pb + 0)) ph_gemm_plain(lds, (const bf16_t*)(ws + WS_XIN), (const bf16_t*)(ws + WS_WIN) + (size_t)pair * 4096 * 2048, (bf16_t*)(ws + WS_Z), INWP, DM, INWP);
        SEAM(pb + 0);
        if (IN(pb + 1)) { ph_e2a_rows(p, pair); ph_e2a_conv(p, pair, lds); }
        SEAM(pb + 1);
        if (IN(pb + 2)) {
            ph_gemm_q(lds, (const bf16_t*)(ws + WS_QN), (const bf16_t*)(ws + WS_WUQ) + (size_t)pair * 1536 * 512, (bf16_t*)(ws + WS_Q));
            ph_gemm_kv(lds, (const bf16_t*)(ws + WS_KVN), (const bf16_t*)(ws + WS_WUKV) + (size_t)pair * 2048 * 256, (bf16_t*)(ws + WS_K), (bf16_t*)(ws + WS_V));
        }
        SEAM(pb + 2);
        if (IN(pb + 3)) { ph_attention(p, lds); ph_hyena(p, pair, lds); }
        SEAM(pb + 3);
        if (IN(pb + 4)) ph_e4_transpose(p, lds);
        SEAM(pb + 4);
        if (IN(pb + 5)) ph_gemm_plain(lds, (const bf16_t*)(ws + WS_CAT), (const bf16_t*)(ws + WS_WO) + (size_t)pair * 2048 * 2048, (bf16_t*)(ws + WS_YMIX), DM, DM, DM);
        SEAM(pb + 5);
        if (IN(pb + 6)) ph_ln_mix<false>(p, le);
        SEAM(pb + 6);
        if (IN(pb + 7)) ph_gemm_plain(lds, (const bf16_t*)(ws + WS_XFFN), (const bf16_t*)(ws + WS_WQ) + (size_t)le * 2048 * 2048, (bf16_t*)(ws + WS_PQ), DM, DM, DM);
        SEAM(pb + 7);
        if (IN(pb + 8)) ph_peer_topk(p, le, lds);
        SEAM(pb + 8);
        if (IN(pb + 9)) ph_peer_gather(p, le);
        SEAM(pb + 9);
        if (IN(pb + 10)) ph_s5_pass1(p, pair);
        SEAM(pb + 10);
        if (IN(pb + 11)) ph_s5_pass2(p, pair, lds);
        SEAM(pb + 11);
        if (IN(pb + 12)) ph_gemm_plain(lds, (const bf16_t*)(ws + WS_CAT), (const bf16_t*)(ws + WS_OD) + (size_t)pair * 4096 * 2048, (bf16_t*)(ws + WS_Z), 4096, DM, 4096);
        SEAM(pb + 12);
        if (IN(pb + 13)) ph_ln_mix<true>(p, lod);
        SEAM(pb + 13);
        if (IN(pb + 14)) ph_gemm_plain(lds, (const bf16_t*)(ws + WS_XFFN), (const bf16_t*)(ws + WS_WQ) + (size_t)lod * 2048 * 2048, (bf16_t*)(ws + WS_PQ), DM, DM, DM);
        SEAM(pb + 14);
        if (IN(pb + 15)) ph_peer_topk(p, lod, lds);
        SEAM(pb + 15);
        if (IN(pb + 16)) ph_peer_gather(p, lod);
        SEAM(pb + 16);
    }
#undef IN
#undef SEAM
}

extern "C" void kernel_launch(void* const* d_in, const int* in_sizes, int n_in, void* d_out, int out_size, void* d_ws, size_t ws_size, hipStream_t stream) {
    static int grid = 0;
    if (grid == 0) {
        if (n_in != 41 || out_size != NB * SEQ * DM || ws_size < WS_END) {
            fprintf(stderr, "kernel_launch: built for 41 inputs, out %d, ws >= %zu; got n_in %d out %d ws %zu\n", NB * SEQ * DM, (size_t)WS_END, n_in, out_size, ws_size);
            grid = -1; return;
        }
        int dev = 0, cus = 0, per_cu = 0;
        if (hipGetDevice(&dev) != hipSuccess || hipDeviceGetAttribute(&cus, hipDeviceAttributeMultiprocessorCount, dev) != hipSuccess) { grid = -1; return; }
        if (hipFuncSetAttribute((const void*)hybrid_fwd, hipFuncAttributeMaxDynamicSharedMemorySize, LDS_BYTES) != hipSuccess) { fprintf(stderr, "kernel_launch: hipFuncSetAttribute failed\n"); grid = -1; return; }
        if (hipOccupancyMaxActiveBlocksPerMultiprocessor(&per_cu, (const void*)hybrid_fwd, NTHREADS, LDS_BYTES) != hipSuccess || per_cu < 1) {
            fprintf(stderr, "kernel_launch: occupancy query reports %d blocks per CU\n", per_cu); (void)hipGetLastError();
        }
        grid = cus;
    }
    if (grid < 0) return;
    (void)hipMemsetAsync((char*)d_ws + WS_CTL, 0, 16384, stream);
    Params a{};
    for (int i = 0; i < 41; ++i) a.in[i] = (const float*)d_in[i];
    a.out = (float*)d_out; a.ws = (unsigned char*)d_ws;
#if NLAUNCH == 1
    a.ph_lo = 0; a.ph_hi = N_PHASES;
    hipLaunchKernelGGL(hybrid_fwd, dim3(grid), dim3(NTHREADS), LDS_BYTES, stream, a);
#else
    for (int ph = 0; ph < N_PHASES; ++ph) {
        a.ph_lo = ph; a.ph_hi = ph + 1;
        hipLaunchKernelGGL(hybrid_fwd, dim3(grid), dim3(NTHREADS), LDS_BYTES, stream, a);
    }
#endif
    const hipError_t le = hipPeekAtLastError();
    if (le != hipSuccess) fprintf(stderr, "kernel_launch: launch failed: %s\n", hipGetErrorName(le));
}
```

```cpp
#include <hip/hip_runtime.h>
#include <cstdio>
#include <cstdint>
#include <cstddef>

#ifndef REP_MASK
#define REP_MASK 0
#endif
#ifndef NLAUNCH
#define NLAUNCH 1
#endif

typedef unsigned short bf16_t;
typedef short bf16x8 __attribute__((ext_vector_type(8)));
typedef short s16x4 __attribute__((ext_vector_type(4)));
typedef float f32x4 __attribute__((ext_vector_type(4)));
typedef float f32x16 __attribute__((ext_vector_type(16)));
typedef unsigned u32x4 __attribute__((ext_vector_type(4)));
typedef unsigned u32x2 __attribute__((ext_vector_type(2)));
typedef float cf2 __attribute__((ext_vector_type(2)));

constexpr int DM = 2048, NB = 2, SEQ = 8192, CTXL = 256, TPB = SEQ + CTXL, MROWS = NB * TPB;
constexpr int NTHREADS = 512, NWAVES = 8;
constexpr int HYW = 1024, OHY = 3072, OQ = 3584, OKV = 3840, INW = 3904, INWP = 4096;
constexpr int NH = 8, DQK = 192, DVH = 128, QRANK = 512, KVRANK = 256;
constexpr float DN_ALPHA = 1.6817928305074290f;
constexpr float LN_EPS = 1e-5f, RMS_EPS = 1e-6f;
constexpr float MLA_SCALE = 0.07216878364870322f;
constexpr int S5T = 128, S5NCH = TPB / S5T;
constexpr int LDS_BYTES = 163840;

constexpr size_t al256(size_t x) { return (x + 255) & ~(size_t)255; }
constexpr size_t WS_CTL   = 0;
constexpr size_t WS_MVEC  = 16384;
constexpr size_t WS_H     = al256(WS_MVEC + (size_t)4 * 3 * 12288 * 4);
constexpr size_t WS_XIN   = al256(WS_H + (size_t)MROWS * DM * 4);
constexpr size_t WS_XFFN  = al256(WS_XIN + (size_t)MROWS * DM * 2);
constexpr size_t WS_Z     = al256(WS_XFFN + (size_t)MROWS * DM * 2);
constexpr size_t WS_QN    = al256(WS_Z + (size_t)MROWS * 4096 * 2);
constexpr size_t WS_KVN   = al256(WS_QN + (size_t)MROWS * 512 * 2);
constexpr size_t WS_Q     = al256(WS_KVN + (size_t)MROWS * 256 * 2);
constexpr size_t WS_K     = al256(WS_Q + (size_t)NB * NH * TPB * DQK * 2);
constexpr size_t WS_V     = al256(WS_K + (size_t)NB * NH * TPB * DQK * 2);
constexpr size_t WS_CAT   = al256(WS_V + (size_t)NB * NH * TPB * DVH * 2);
constexpr size_t WS_ZCT   = al256(WS_CAT + (size_t)MROWS * DM * 2);
constexpr size_t WS_YT    = al256(WS_ZCT + (size_t)3072 * MROWS * 2);
constexpr size_t WS_YMIX  = al256(WS_YT + (size_t)1024 * MROWS * 2);
constexpr size_t WS_PQ    = al256(WS_YMIX + (size_t)MROWS * DM * 2);
constexpr size_t WS_PIDX  = al256(WS_PQ + (size_t)MROWS * DM * 2);
constexpr size_t WS_PGATE = al256(WS_PIDX + (size_t)MROWS * 128 * 4);
constexpr size_t WS_PCOEF = al256(WS_PGATE + (size_t)MROWS * 128 * 4);
constexpr size_t WS_WIN   = al256(WS_PCOEF + (size_t)MROWS * 128 * 4);
constexpr size_t WS_WUQ   = al256(WS_WIN + (size_t)2 * 4096 * 2048 * 2);
constexpr size_t WS_WUKV  = al256(WS_WUQ + (size_t)2 * 1536 * 512 * 2);
constexpr size_t WS_WO    = al256(WS_WUKV + (size_t)2 * 2048 * 256 * 2);
constexpr size_t WS_OD    = al256(WS_WO + (size_t)2 * 2048 * 2048 * 2);
constexpr size_t WS_WQ    = al256(WS_OD + (size_t)2 * 4096 * 2048 * 2);
constexpr size_t WS_KEYS  = al256(WS_WQ + (size_t)4 * 2048 * 2048 * 2);
constexpr size_t WS_PU    = al256(WS_KEYS + (size_t)4 * 8 * 2 * 128 * 128 * 2);
constexpr size_t WS_PV    = al256(WS_PU + (size_t)4 * 16384 * 2048);
constexpr size_t WS_PUS   = al256(WS_PV + (size_t)4 * 16384 * 2048);
constexpr size_t WS_PVS   = al256(WS_PUS + (size_t)4 * 16384 * 4);
constexpr size_t WS_HDN3  = al256(WS_PVS + (size_t)4 * 16384 * 4);
constexpr size_t HK_LAT   = (size_t)2 * 1024 * 2 * 8192;
constexpr size_t HK_CTX   = (size_t)2 * 1024 * 2 * 256;
constexpr size_t WS_HK    = al256(WS_HDN3 + (size_t)2 * 8448 * 64 * 4);
constexpr size_t WS_ABAR  = al256(WS_HK + 2 * (HK_LAT + HK_CTX) * 4);
constexpr size_t WS_AT    = al256(WS_ABAR + (size_t)2 * 2 * 128 * 64 * 8);
constexpr size_t WS_BFRAG = al256(WS_AT + (size_t)2 * 2 * 128 * 64 * 8);
constexpr size_t WS_CFRAG = al256(WS_BFRAG + (size_t)2 * 2 * 128 * 4 * 64 * 16);
constexpr size_t WS_EST   = al256(WS_CFRAG + (size_t)2 * 2 * 128 * 4 * 64 * 16);
constexpr size_t WS_SIN   = al256(WS_EST + (size_t)2 * 128 * 2 * S5NCH * 64 * 8);
constexpr size_t WS_TW    = al256(WS_SIN + (size_t)2 * 128 * 2 * S5NCH * 64 * 8);
constexpr size_t WS_W4T   = al256(WS_TW + (size_t)8192 * 8);
constexpr size_t WS_XQ8   = al256(WS_W4T + (size_t)2 * 4096 * 64 * 2);
constexpr size_t WS_XS    = al256(WS_XQ8 + (size_t)MROWS * DM);
constexpr size_t WS_END   = al256(WS_XS + (size_t)MROWS * 4);
constexpr size_t FFT_SCR_PER_BLOCK = 512 * 1024;
static_assert(256 * FFT_SCR_PER_BLOCK <= (size_t)MROWS * 4096 * 2, "fft scratch must fit the z region");
static_assert((size_t)16 * MROWS * 128 * 4 <= (size_t)MROWS * 4096 * 2, "peer partial dots must fit the z region");

struct Params {
    const float* in[41];
    float* out;
    unsigned char* ws;
    int ph_lo, ph_hi;
};

#define LAS __attribute__((address_space(3)))
typedef const __attribute__((address_space(4))) Params* KP;
#ifndef PHASE_FN
#define PHASE_FN __device__ __forceinline__
#endif

__device__ __forceinline__ int opaque_tid() { int t = (int)threadIdx.x; asm volatile("" : "+v"(t)); return t; }
__device__ __forceinline__ KP launder_kp(KP p) { unsigned long long v = (unsigned long long)p; asm volatile("" : "+s"(v)); return (KP)v; }
__device__ __forceinline__ int opaque_bid() { int t = (int)blockIdx.x; asm volatile("" : "+s"(t)); return t; }
#define TID  (opaque_tid())

__device__ __forceinline__ cf2 mk2(float a, float b) { cf2 r; r.x = a; r.y = b; return r; }
__device__ __forceinline__ float bf2f(bf16_t b) { return __uint_as_float(((unsigned)b) << 16); }
__device__ __forceinline__ float bflo(unsigned w) { return __uint_as_float(w << 16); }
__device__ __forceinline__ float bfhi(unsigned w) { return __uint_as_float(w & 0xffff0000u); }
__device__ __forceinline__ unsigned cvt_pk(float lo, float hi) { unsigned r; asm volatile("v_cvt_pk_bf16_f32 %0, %1, %2" : "=v"(r) : "v"(lo), "v"(hi)); return r; }
__device__ __forceinline__ bf16_t f2bf(float f) { return (bf16_t)(cvt_pk(f, 0.f) & 0xffffu); }
template <int CTRL> __device__ __forceinline__ float dppf(float v) { return __builtin_bit_cast(float, __builtin_amdgcn_update_dpp(0, __builtin_bit_cast(int, v), CTRL, 0xF, 0xF, true)); }
__device__ __forceinline__ float rdlane(float v, int l) { return __builtin_bit_cast(float, __builtin_amdgcn_readlane(__builtin_bit_cast(int, v), l)); }
__device__ __forceinline__ float wave_sum(float v) {
    v += dppf<0xB1>(v); v += dppf<0x4E>(v); v += dppf<0x141>(v); v += dppf<0x140>(v);
    return (rdlane(v, 0) + rdlane(v, 16)) + (rdlane(v, 32) + rdlane(v, 48));
}
__device__ __forceinline__ float wave_max(float v) {
    v = fmaxf(v, dppf<0xB1>(v)); v = fmaxf(v, dppf<0x4E>(v)); v = fmaxf(v, dppf<0x141>(v)); v = fmaxf(v, dppf<0x140>(v));
    return fmaxf(fmaxf(rdlane(v, 0), rdlane(v, 16)), fmaxf(rdlane(v, 32), rdlane(v, 48)));
}
typedef int i32x2v __attribute__((ext_vector_type(2)));
typedef float f32x2v __attribute__((ext_vector_type(2)));
__device__ __forceinline__ void dec16(const u32x4 w, float (&f)[16]) {
#pragma unroll
    for (int d = 0; d < 4; ++d) {
        const f32x2v lo = __builtin_amdgcn_cvt_pk_f32_fp8((int)w[d], false), hi = __builtin_amdgcn_cvt_pk_f32_fp8((int)w[d], true);
        f[4 * d] = lo.x; f[4 * d + 1] = lo.y; f[4 * d + 2] = hi.x; f[4 * d + 3] = hi.y;
    }
}
__device__ __forceinline__ float gelu_tanh(float x) {
    const float z = 0.7978845608028654f * (x + 0.044715f * x * x * x);
    const float e = __expf(2.0f * z);
    const float t = 1.0f - 2.0f / (e + 1.0f);
    return 0.5f * x * (1.0f + t);
}
__device__ __forceinline__ void unpack8(const u32x4 w, float (&f)[8]) {
    f[0] = bflo(w.x); f[1] = bfhi(w.x); f[2] = bflo(w.y); f[3] = bfhi(w.y); f[4] = bflo(w.z); f[5] = bfhi(w.z); f[6] = bflo(w.w); f[7] = bfhi(w.w);
}
__device__ __forceinline__ u32x4 pack8(const float (&f)[8]) {
    u32x4 w; w.x = cvt_pk(f[0], f[1]); w.y = cvt_pk(f[2], f[3]); w.z = cvt_pk(f[4], f[5]); w.w = cvt_pk(f[6], f[7]); return w;
}

namespace pg8 {
#define PG8_LAS __attribute__((address_space(3)))
typedef unsigned short bf16_t;
typedef short bf16x8 __attribute__((ext_vector_type(8)));
typedef float f32x4 __attribute__((ext_vector_type(4)));
typedef unsigned u32x4 __attribute__((ext_vector_type(4)));
constexpr int BM = 256, BK = 64, HALF = 128, HTB = HALF * BK * 2  , STAGE_BYTES = 8 * HTB, NXCD = 8, WGM = 8;

__host__ __device__ __forceinline__ int lds_byte(int r, int c) { const int st = (r >> 4) * 2 + (c >> 5), rr = r & 15, cc = c & 31, ob = rr * 64 + cc * 2; return st * 1024 + (ob ^ (((ob >> 9) & 1) << 5)); }
__host__ __device__ __forceinline__ void stage_rc(int b, int& R, int& C) { const int st = b / 1024, sb = b % 1024, swz = sb ^ (((sb >> 9) & 1) << 5); R = (st >> 1) * 16 + swz / 64; C = (st & 1) * 32 + (swz % 64) / 2; }
__host__ __device__ __forceinline__ int perm32(int rho) { const int n = rho >> 4, i = rho & 15; return 8 * (i >> 2) + 4 * n + (i & 3); }

struct Unit { int pm, pn; };
struct Gemm { const bf16_t* A; const bf16_t* Bt; int M, N, K; };

struct StaticOrder {
    int nM, nN, nwg, G, c;
    __host__ __device__ void init(int M, int N, int G_, int c_) { nM = M / BM; nN = N / BM; nwg = nM * nN; G = G_; c = c_; }
    __host__ __device__ bool next(int i, Unit& u) const {
        const long L = (long)i * G + c; if (L >= nwg) return false;
        int wgid = (int)L; { const int q = nwg / NXCD, r = nwg % NXCD, xcd = wgid % NXCD, off = wgid / NXCD; wgid = (xcd < r ? xcd * (q + 1) : r * (q + 1) + (xcd - r) * q) + off; }
        const int nig = WGM * nN, gid = wgid / nig, fm = gid * WGM, gsz = (nM - fm) < WGM ? (nM - fm) : WGM;
        u.pm = fm + ((wgid % nig) % gsz); u.pn = (wgid % nig) / gsz; return true;
    }
    __device__ __forceinline__ void a_ready(const Unit&) const {}
    __device__ __forceinline__ void done(const Unit&) const {}
};
__device__ __forceinline__ unsigned cvt_pk_bf16(float lo, float hi) { unsigned r; asm volatile("v_cvt_pk_bf16_f32 %0, %1, %2" : "=v"(r) : "v"(lo), "v"(hi)); return r; }
typedef float f32x2 __attribute__((ext_vector_type(2)));
__device__ __forceinline__ f32x2 gelu_pk(f32x2 v) {
    const f32x2 av = __builtin_elementwise_abs(v), d = av * 0.2316418882f + 1.0f;
    f32x2 t; t.x = __builtin_amdgcn_rcpf(d.x); t.y = __builtin_amdgcn_rcpf(d.y);
    f32x2 q = t * 0.5307027145f + (-0.7265760135f); q = q * t + 0.7107068705f; q = q * t + (-0.142248368f); q = q * t + 0.127414796f; q = q * t;
    const f32x2 s = (v * v) * (-0.72134752044f);
    f32x2 e; e.x = __builtin_amdgcn_exp2f(s.x); e.y = __builtin_amdgcn_exp2f(s.y);
    const f32x2 m = v * (q * e), r = v - m;
    f32x2 o; o.x = v.x < 0.f ? m.x : r.x; o.y = v.y < 0.f ? m.y : r.y; return o;
}

template <class Epi, class Sched, bool STAMP = false>
__device__ __forceinline__ void gemm_phase(PG8_LAS unsigned char* lds, const Gemm g, const Sched& S, const Epi& E, unsigned long long* stamps) {
    const int tid = TID, wid = __builtin_amdgcn_readfirstlane(tid >> 6), lane = tid & 63, wr = wid >> 2, wc = wid & 3, fr = lane & 15, fq = lane >> 4;
    const int K = g.K, nt = K / BK;
    int ts_lo = 0, ts_hi = 0, nts = 0; const unsigned long long rt_entry = STAMP ? (unsigned long long)wall_clock64() : 0ull;
#define PG8_STAMP() do { if (STAMP && wid == 0 && nts < 64) { const unsigned long long _c = (unsigned long long)clock64(); \
        ts_lo = (lane == nts) ? (int)(unsigned)_c : ts_lo; ts_hi = (lane == nts) ? (int)(unsigned)(_c >> 32) : ts_hi; ++nts; } } while (0)
    PG8_STAMP();
    unsigned voffA[2], voffB[2];
#pragma unroll
    for (int i = 0; i < 2; ++i) { int R, C; stage_rc(tid * 16 + i * 8192, R, C); const int Rb = Epi::PERM ? ((R & ~31) + perm32(R & 31)) : R;
        voffA[i] = (unsigned)(R * K + C) * 2u; voffB[i] = (unsigned)(Rb * K + C) * 2u; }
    const size_t kstep = (size_t)(BK * 2);
    const size_t hstep = (size_t)HALF * K * 2;
    const size_t tstep = 2 * hstep;
    const unsigned ldsw = (unsigned)wid * 1024u;
    const int aoff = lds_byte(wr * 64 + fr, fq * 8), boff = lds_byte(wc * 32 + fr, fq * 8);
#define PG8_SA(b, h) (((b) * 2 + (h)) * HTB)
#define PG8_SB(b, h) ((4 + (b) * 2 + (h)) * HTB)
#define PG8_STAGE(bufoff, gbase, voff) do { _Pragma("unroll") for (int _i = 0; _i < 2; ++_i) \
        __builtin_amdgcn_global_load_lds((const unsigned*)((const char*)(gbase) + (voff)[_i]), (PG8_LAS unsigned*)(lds + (bufoff) + ldsw + _i * 8192), 16, 0, 0); } while (0)
#define PG8_LDA(dst, b, h) do { _Pragma("unroll") for (int m = 0; m < 4; ++m) _Pragma("unroll") for (int k = 0; k < 2; ++k) dst[m][k] = *(const PG8_LAS bf16x8*)(lds + PG8_SA(b, h) + aoff + m * 2048 + k * 1024); } while (0)
#define PG8_LDB(dst, b, h) do { _Pragma("unroll") for (int n = 0; n < 2; ++n) _Pragma("unroll") for (int k = 0; k < 2; ++k) dst[n][k] = *(const PG8_LAS bf16x8*)(lds + PG8_SB(b, h) + boff + n * 2048 + k * 1024); } while (0)
#define PG8_MMA(ai, bj, At, Bt) do { __builtin_amdgcn_s_setprio(1); _Pragma("unroll") for (int m = 0; m < 4; ++m) _Pragma("unroll") for (int n = 0; n < 2; ++n) _Pragma("unroll") for (int k = 0; k < 2; ++k) \
        acc[ai][bj][m][n] = __builtin_amdgcn_mfma_f32_16x16x32_bf16(Bt[n][k], At[m][k], acc[ai][bj][m][n], 0, 0, 0); __builtin_amdgcn_s_setprio(0); } while (0)
#define PG8_WAIT_V(n) asm volatile("s_waitcnt vmcnt(" #n ")" ::: "memory")
#define PG8_WAIT_L(n) asm volatile("s_waitcnt lgkmcnt(" #n ")" ::: "memory")
#define PG8_BAR __builtin_amdgcn_s_barrier()
#define PG8_SCHED __builtin_amdgcn_sched_barrier(0)
    Unit cur, nxt; int ui = 0;
    if (!S.next(0, cur)) return;
    f32x4 acc[2][2][4][2];
#pragma unroll
    for (int a = 0; a < 2; ++a)
#pragma unroll
        for (int b = 0; b < 2; ++b)
#pragma unroll
            for (int m = 0; m < 4; ++m)
#pragma unroll
                for (int n = 0; n < 2; ++n) acc[a][b][m][n] = (f32x4){0.f, 0.f, 0.f, 0.f};
    bf16x8 At[4][2], B0[2][2], B1[2][2];
    const char* cA = (const char*)g.A + (size_t)cur.pm * tstep; const char* cB = (const char*)g.Bt + (size_t)cur.pn * tstep;
    S.a_ready(cur);
    PG8_STAGE(PG8_SB(0, 0), cB, voffB); PG8_STAGE(PG8_SA(0, 0), cA, voffA); PG8_STAGE(PG8_SB(0, 1), cB + hstep, voffB); PG8_STAGE(PG8_SA(0, 1), cA + hstep, voffA);
    if (wr == 1) PG8_BAR;
    PG8_WAIT_V(4); PG8_BAR;
    PG8_STAGE(PG8_SB(1, 0), cB + kstep, voffB); PG8_STAGE(PG8_SA(1, 0), cA + kstep, voffA); PG8_STAGE(PG8_SB(1, 1), cB + hstep + kstep, voffB);
    PG8_WAIT_V(6); PG8_BAR;
    PG8_STAMP();
    for (;;) {
        const bool has_next = S.next(ui + 1, nxt);
        const char* nA = has_next ? (const char*)g.A + (size_t)nxt.pm * tstep : cA; const char* nB = has_next ? (const char*)g.Bt + (size_t)nxt.pn * tstep : cB;
        for (int t = 0; t < nt; t += 2) {
            const bool last = (t == nt - 2);
            const char* a1 = cA + (size_t)(t + 1) * kstep;
            const char* a2 = last ? nA : cA + (size_t)(t + 2) * kstep; const char* b2 = last ? nB : cB + (size_t)(t + 2) * kstep;
            const char* a3 = a2 + kstep; const char* b3 = b2 + kstep;
            if (last && has_next) S.a_ready(nxt);
            PG8_LDB(B0, 0, 0); PG8_SCHED; PG8_LDA(At, 0, 0); PG8_STAGE(PG8_SA(1, 1), a1 + hstep, voffA);
            PG8_WAIT_L(8); PG8_BAR; PG8_WAIT_L(0); PG8_MMA(0, 0, At, B0); PG8_BAR; PG8_SCHED;
            PG8_LDB(B1, 0, 1); PG8_STAGE(PG8_SB(0, 0), b2, voffB);
            PG8_BAR; PG8_WAIT_L(0); PG8_MMA(0, 1, At, B1); PG8_BAR;
            PG8_LDA(At, 0, 1); PG8_STAGE(PG8_SA(0, 0), a2, voffA);
            PG8_BAR; PG8_WAIT_L(0); PG8_MMA(1, 0, At, B0); PG8_BAR; PG8_SCHED;
            PG8_STAGE(PG8_SB(0, 1), b2 + hstep, voffB);
            PG8_WAIT_V(6); PG8_BAR; PG8_MMA(1, 1, At, B1); PG8_BAR;
            PG8_LDB(B0, 1, 0); PG8_SCHED; PG8_LDA(At, 1, 0); PG8_STAGE(PG8_SA(0, 1), a2 + hstep, voffA);
            PG8_WAIT_L(8); PG8_BAR; PG8_WAIT_L(0); PG8_MMA(0, 0, At, B0); PG8_BAR; PG8_SCHED;
            PG8_LDB(B1, 1, 1); PG8_STAGE(PG8_SB(1, 0), b3, voffB);
            PG8_BAR; PG8_WAIT_L(0); PG8_MMA(0, 1, At, B1); PG8_BAR;
            PG8_LDA(At, 1, 1); PG8_STAGE(PG8_SA(1, 0), a3, voffA);
            PG8_BAR; PG8_WAIT_L(0); PG8_MMA(1, 0, At, B0); PG8_BAR; PG8_SCHED;
            PG8_STAGE(PG8_SB(1, 1), b3 + hstep, voffB);
            PG8_WAIT_V(6); PG8_BAR; PG8_MMA(1, 1, At, B1); PG8_BAR;
        }
        PG8_STAMP();
        if constexpr (!Epi::AFTER_DRAIN) { E(acc, cur, wr, wc, fr, fq); S.done(cur); }
        PG8_STAMP();
        if (!has_next) break;
#pragma unroll
        for (int a = 0; a < 2; ++a)
#pragma unroll
            for (int b = 0; b < 2; ++b)
#pragma unroll
                for (int m = 0; m < 4; ++m)
#pragma unroll
                    for (int n = 0; n < 2; ++n) acc[a][b][m][n] = (f32x4){0.f, 0.f, 0.f, 0.f};
        cur = nxt; cA = nA; cB = nB; ++ui;
    }
    PG8_WAIT_V(0);
    if (wr == 0) PG8_BAR;
    PG8_BAR;
    if constexpr (Epi::AFTER_DRAIN) { E.fused(acc, cur, wr, wc, fr, fq, lds, wid, lane); S.done(cur); }
    PG8_STAMP();
    if (STAMP && wid == 0) { stamps[lane] = lane < nts ? (((unsigned long long)(unsigned)ts_hi << 32) | (unsigned)ts_lo) : 0ull;
        if (lane == 62) stamps[62] = rt_entry; if (lane == 63) stamps[63] = (unsigned long long)wall_clock64(); }
#undef PG8_STAMP
#undef PG8_SA
#undef PG8_SB
#undef PG8_STAGE
#undef PG8_LDA
#undef PG8_LDB
#undef PG8_MMA
#undef PG8_WAIT_V
#undef PG8_WAIT_L
#undef PG8_BAR
#undef PG8_SCHED
}
}

#define XB_TMO      128
#define XB_XCNT(j)  (256  + 64 * (j))
#define XB_XSUB(j)  (1280 + 64 * (j))
#define XB_XGEN(j)  (2304 + 64 * (j))
#define XB_TOP      3328
#define XB_TOPGEN   3392
#define XCD_BAR_WORDS 3456
#define XB_SPIN_CAP (1u << 22)
#define LAS __attribute__((address_space(3)))

__device__ __forceinline__ unsigned xb_ld(unsigned* p)              { return __hip_atomic_load(p, __ATOMIC_RELAXED, __HIP_MEMORY_SCOPE_AGENT); }
__device__ __forceinline__ unsigned xb_add(unsigned* p, unsigned v) { return __hip_atomic_fetch_add(p, v, __ATOMIC_RELAXED, __HIP_MEMORY_SCOPE_AGENT); }
__device__ __forceinline__ unsigned xb_xcc_id() { return (unsigned)__builtin_amdgcn_s_getreg((3 << 11) | 20) & 0xFu; }
#define XB_SPIN(cond, bar) do { unsigned _sp = 0; while (cond) { __builtin_amdgcn_s_sleep(1); \
    if ((++_sp & 255u) == 0u) { if (xb_ld(&(bar)[XB_TMO])) break; if (_sp > XB_SPIN_CAP) { atomicAdd(&(bar)[XB_TMO], 1u); break; } } } } while (0)

struct XcdBarrier {
    unsigned* bar; unsigned x;
    volatile LAS unsigned* st;
};

__device__ __forceinline__ XcdBarrier xcd_barrier_post(unsigned* bar, volatile LAS unsigned* st) {
    XcdBarrier b; b.bar = bar; b.x = xb_xcc_id(); b.st = st;
    if (threadIdx.x == 0) (void)xb_add(&bar[XB_XCNT(b.x)], 1u);
    return b;
}
__device__ __forceinline__ void xcd_barrier_complete(unsigned* bar, unsigned x, unsigned& nloc, unsigned& nx) {
    const unsigned G = gridDim.x * gridDim.y * gridDim.z;
    unsigned sum, cnt, mine, sp = 0u;
    for (;;) {
        sum = 0u; cnt = 0u; mine = 0u;
#pragma unroll
        for (unsigned j = 0; j < 16; ++j) { const unsigned c = xb_ld(&bar[XB_XCNT(j)]); sum += c; cnt += (c > 0u) ? 1u : 0u; mine = (j == x) ? c : mine; }
        if (sum == G) break;
        __builtin_amdgcn_s_sleep(1);
        if ((++sp & 255u) == 0u) { if (xb_ld(&bar[XB_TMO])) break; if (sp > XB_SPIN_CAP) { atomicAdd(&bar[XB_TMO], 1u); break; } }
    }
    nloc = mine > 0u ? mine : 1u; nx = cnt > 0u ? cnt : 1u;
}

__device__ __forceinline__ void xcd_barrier(const XcdBarrier& b) {
    asm volatile("s_waitcnt vmcnt(0)" ::: "memory");
    __syncthreads();
    if (threadIdx.x == 0) {
        unsigned* bar = b.bar;
        __builtin_amdgcn_s_waitcnt(0);
        unsigned nloc = b.st[0], nx = b.st[1];
        if (nloc == 0u) { xcd_barrier_complete(bar, b.x, nloc, nx); b.st[0] = nloc; b.st[1] = nx; }
        const unsigned old = xb_add(&bar[XB_XSUB(b.x)], 1u);
        const unsigned gen = old / nloc;
        if (old + 1u == (gen + 1u) * nloc) {
            __builtin_amdgcn_fence(__ATOMIC_RELEASE, "agent");
            asm volatile("s_waitcnt vmcnt(0)" ::: "memory");
            const unsigned og = xb_add(&bar[XB_TOP], 1u);
            const unsigned tg = og / nx;
            if (og + 1u == (tg + 1u) * nx) xb_add(&bar[XB_TOPGEN], 1u);
            else XB_SPIN(xb_ld(&bar[XB_TOPGEN]) == tg, bar);
            __builtin_amdgcn_fence(__ATOMIC_ACQUIRE, "agent");
            xb_add(&bar[XB_XGEN(b.x)], 1u);
            asm volatile("s_waitcnt vmcnt(0)" ::: "memory");
        } else {
            XB_SPIN(xb_ld(&bar[XB_XGEN(b.x)]) == gen, bar);
            __builtin_amdgcn_fence(__ATOMIC_ACQUIRE, "agent");
            asm volatile("s_waitcnt vmcnt(0)" ::: "memory");
        }
    }
    __syncthreads();
}


#define BID  (opaque_bid())
#define NBLK ((int)gridDim.x)

PHASE_FN void ph_mod(KP p, LAS unsigned char* lds) {
    p = launder_kp(p);
    LAS float* act = (LAS float*)lds;
    LAS float* red = act + 3 * 2048;
    const int tid = TID;
    for (int i = tid; i < 3 * 2048; i += NTHREADS) {
        const int kind = i >> 11, k = i & 2047;
        const float c = kind < 2 ? p->in[1][kind * 2048 + k] : p->in[3][k];
        act[i] = c / (1.0f + expf(-c));
    }
    __syncthreads();
    float* mvec = (float*)(p->ws + WS_MVEC);
    const int cg = tid % 48, kg = tid / 48;
    for (int unit = BID; unit < 256; unit += NBLK) {
        const int col4 = unit * 48 + cg, layer = col4 / 3072, n4 = col4 % 3072;
        f32x4 a0 = {0.f, 0.f, 0.f, 0.f}, a1 = a0, a2 = a0;
        if (kg < 10) {
            const f32x4* w = (const f32x4*)(p->in[4] + (size_t)layer * 2048 * 12288) + n4;
            int k = kg;
            for (; k + 70 < 2048; k += 80) {
                f32x4 wv[8];
#pragma unroll
                for (int q = 0; q < 8; ++q) wv[q] = __builtin_nontemporal_load(w + (size_t)(k + 10 * q) * 3072);
#pragma unroll
                for (int q = 0; q < 8; ++q) { a0 += act[k + 10 * q] * wv[q]; a1 += act[2048 + k + 10 * q] * wv[q]; a2 += act[4096 + k + 10 * q] * wv[q]; }
            }
            for (; k < 2048; k += 10) {
                const f32x4 wv = w[(size_t)k * 3072];
                a0 += act[k] * wv; a1 += act[2048 + k] * wv; a2 += act[4096 + k] * wv;
            }
            LAS float* r = red + (kg * 48 + cg) * 12;
#pragma unroll
            for (int j = 0; j < 4; ++j) { r[j] = a0[j]; r[4 + j] = a1[j]; r[8 + j] = a2[j]; }
        }
        __syncthreads();
        for (int o = tid; o < 48 * 12; o += NTHREADS) {
            const int c2 = o / 12, q = o % 12, kind = q >> 2, j = q & 3;
            float s = 0.f;
#pragma unroll
            for (int g = 0; g < 10; ++g) s += red[(g * 48 + c2) * 12 + q];
            const int cc4 = unit * 48 + c2, ly = cc4 / 3072, n = (cc4 % 3072) * 4 + j;
            mvec[((size_t)ly * 3 + kind) * 12288 + n] = s + p->in[5][(size_t)ly * 12288 + n];
        }
        __syncthreads();
    }
}

__device__ __forceinline__ void transpose_cvt(const float* __restrict__ src, int K, int N, bf16_t* __restrict__ dst, int Npad, LAS unsigned char* lds) {
    LAS float* t = (LAS float*)lds;
    const int tid = TID, tk = K / 64, tn = Npad / 64, ntile = tk * tn;
    for (int u0 = BID * 4; u0 < ntile; u0 += NBLK * 4) {
        f32x4 v[4][2];
#pragma unroll
        for (int q = 0; q < 4; ++q) {
            const int u = u0 + q, k0 = (u % tk) * 64, n0 = (u / tk) * 64;
#pragma unroll
            for (int h = 0; h < 2; ++h) {
                const int r = (tid >> 4) + 32 * h, c4 = (tid & 15) * 4;
                v[q][h] = (f32x4){0.f, 0.f, 0.f, 0.f};
                if (u < ntile && n0 + c4 < N) v[q][h] = __builtin_nontemporal_load((const f32x4*)(src + (size_t)(k0 + r) * N + n0 + c4));
            }
        }
#pragma unroll
        for (int q = 0; q < 4; ++q)
#pragma unroll
            for (int h = 0; h < 2; ++h) {
                const int r = (tid >> 4) + 32 * h, c4 = (tid & 15) * 4;
#pragma unroll
                for (int j = 0; j < 4; ++j) t[(q * 64 + r) * 65 + c4 + j] = v[q][h][j];
            }
        __syncthreads();
#pragma unroll
        for (int q = 0; q < 4; ++q) {
            const int u = u0 + q, k0 = (u % tk) * 64, n0 = (u / tk) * 64;
            if (u < ntile) {
                const int n = tid >> 3, kc = (tid & 7) * 8;
                float f[8];
#pragma unroll
                for (int j = 0; j < 8; ++j) f[j] = t[(q * 64 + kc + j) * 65 + n];
                *(u32x4*)(dst + (size_t)(n0 + n) * K + k0 + kc) = pack8(f);
            }
        }
        __syncthreads();
    }
}

__device__ __forceinline__ void cvt_bf16(const float* __restrict__ src, bf16_t* __restrict__ dst, size_t n) {
    const size_t n8 = n / 8, stride = (size_t)NBLK * NTHREADS;
    for (size_t i = (size_t)BID * NTHREADS + TID; i < n8; i += stride) {
        const f32x4 a = *(const f32x4*)(src + i * 8), b = *(const f32x4*)(src + i * 8 + 4);
        u32x4 w; w.x = cvt_pk(a[0], a[1]); w.y = cvt_pk(a[2], a[3]); w.z = cvt_pk(b[0], b[1]); w.w = cvt_pk(b[2], b[3]);
        *(u32x4*)(dst + i * 8) = w;
    }
}

__device__ __forceinline__ void cvt_fp8_rows(const float* __restrict__ src, unsigned char* __restrict__ dst, float* __restrict__ scales, int nrows, int wkr, int nwkr) {
    const int lane = TID & 63, wid = TID >> 6;
    for (int r0 = (wkr * NWAVES + wid) * 2; r0 < nrows; r0 += nwkr * NWAVES * 2) {
        f32x4 v[2][2][4];
#pragma unroll
        for (int rr = 0; rr < 2; ++rr)
#pragma unroll
            for (int c = 0; c < 2; ++c)
#pragma unroll
                for (int q = 0; q < 4; ++q) v[rr][c][q] = __builtin_nontemporal_load((const f32x4*)(src + (size_t)(r0 + rr) * DM + lane * 16 + c * 1024 + q * 4));
#pragma unroll
        for (int rr = 0; rr < 2; ++rr) {
            float am = 0.f;
#pragma unroll
            for (int c = 0; c < 2; ++c)
#pragma unroll
                for (int q = 0; q < 4; ++q)
#pragma unroll
                    for (int k = 0; k < 4; ++k) am = fmaxf(am, fabsf(v[rr][c][q][k]));
            am = wave_max(am);
            const float sc = am > 0.f ? am * (1.0f / 224.0f) : 1.0f, inv = 1.0f / sc;
#pragma unroll
            for (int c = 0; c < 2; ++c) {
                u32x4 w;
#pragma unroll
                for (int q = 0; q < 4; ++q) {
                    int x = __builtin_amdgcn_cvt_pk_fp8_f32(v[rr][c][q][0] * inv, v[rr][c][q][1] * inv, 0, false);
                    x = __builtin_amdgcn_cvt_pk_fp8_f32(v[rr][c][q][2] * inv, v[rr][c][q][3] * inv, x, true);
                    w[q] = (unsigned)x;
                }
                __builtin_nontemporal_store(w, (u32x4*)(dst + ((size_t)(c * 8 + (lane >> 3)) * 16384 + (r0 + rr)) * 128 + (lane & 7) * 16));
            }
            if (lane == 0) scales[r0 + rr] = sc;
        }
    }
}

PHASE_FN void ph_hdn3(KP p) {
    p = launder_kp(p);
    const int lane = TID & 63, wid = TID >> 6;
    float* hdn3 = (float*)(p->ws + WS_HDN3);
    for (int pp = BID * NWAVES + wid; pp < 2 * 8448; pp += NBLK * NWAVES) {
        const int e = pp / 8448, pos = pp % 8448;
        const int L = pos < 8192 ? 8192 : 256, i = pos < 8192 ? pos : pos - 8192;
        const float* w1 = p->in[13] + (size_t)e * 33 * 64; const float* b1 = p->in[14] + e * 64;
        const float* w2 = p->in[15] + (size_t)e * 64 * 64; const float* b2 = p->in[16] + e * 64;
        const float* w3 = p->in[17] + (size_t)e * 64 * 64; const float* b3 = p->in[18] + e * 64;
        const float fr = p->in[20][e * 64 + lane];
        const float t = (float)i / (float)(L - 1);
        const float w = (float)(6.283185307179586 / (double)L) * (float)i;
        float feat = 0.f;
        if (lane == 0) feat = t;
        else if (lane < 33) {
            const int k = (lane - 1) & 15;
            const float fk = 1e-4f + (float)k * ((15.0f - 1e-4f) / 15.0f);
            feat = lane < 17 ? cosf(fk * w) : -sinf(fk * w);
        }
        float acc = b1[lane];
#pragma unroll
        for (int f = 0; f < 33; ++f) acc += __builtin_bit_cast(float, __builtin_amdgcn_readlane(__builtin_bit_cast(int, feat), f)) * w1[f * 64 + lane];
        float hcur = sinf(fr * acc);
        acc = b2[lane];
#pragma unroll
        for (int f = 0; f < 64; ++f) acc += __builtin_bit_cast(float, __builtin_amdgcn_readlane(__builtin_bit_cast(int, hcur), f)) * w2[f * 64 + lane];
        hcur = sinf(fr * acc);
        acc = b3[lane];
#pragma unroll
        for (int f = 0; f < 64; ++f) acc += __builtin_bit_cast(float, __builtin_amdgcn_readlane(__builtin_bit_cast(int, hcur), f)) * w3[f * 64 + lane];
        hcur = sinf(fr * acc);
        hdn3[((size_t)e * 8448 + pos) * 64 + lane] = hcur;
    }
}

PHASE_FN void ph_hk(KP p) {
    p = launder_kp(p);
    const int lane = TID & 63, wid = TID >> 6, n = lane & 15, kg = lane >> 4;
    for (int u = BID * NWAVES + wid; u < 2 * 132 * 64; u += NBLK * NWAVES) {
        const int cg = u & 63, pt = (u >> 6) % 132, e = u / (132 * 64), pos0 = pt * 64;
        const float* hdn3 = (const float*)(p->ws + WS_HDN3) + (size_t)e * 8448 * 64;
        const bf16_t* w4t = (const bf16_t*)(p->ws + WS_W4T) + (size_t)e * 4096 * 64;
        bf16_t* hk = (bf16_t*)(p->ws + WS_HK) + (size_t)e * (HK_LAT + HK_CTX);
        bf16x8 af[4][2];
#pragma unroll
        for (int mt = 0; mt < 4; ++mt)
#pragma unroll
            for (int ks = 0; ks < 2; ++ks) {
                const float* hp = hdn3 + (size_t)(pos0 + mt * 16 + n) * 64 + ks * 32 + kg * 8;
                const f32x4 a = *(const f32x4*)hp, b = *(const f32x4*)(hp + 4);
                u32x4 w; w.x = cvt_pk(a[0], a[1]); w.y = cvt_pk(a[2], a[3]); w.z = cvt_pk(b[0], b[1]); w.w = cvt_pk(b[2], b[3]);
                af[mt][ks] = *reinterpret_cast<bf16x8*>(&w);
            }
        const bool lat = pos0 < 8192;
        const int L = lat ? 8192 : 256, ib = (lat ? pos0 : pos0 - 8192) + 4 * kg;
        bf16_t* base = hk + (lat ? 0 : HK_LAT);
        const float rl = 1.0f / (float)(L - 1);
#pragma unroll 2
        for (int ct = 0; ct < 4; ++ct) {
            const int col = cg * 64 + ct * 16 + n;
            const bf16x8 b0 = *(const bf16x8*)(w4t + (size_t)col * 64 + kg * 8), b1 = *(const bf16x8*)(w4t + (size_t)col * 64 + 32 + kg * 8);
            const int dir = col >> 11, o = (col >> 10) & 1, c = col & 1023;
            const float a0 = -3.0701134573253944f, a1 = -15.350567286626973f;
            const float delta = fabsf(a0 + (float)(o * 1024 + c) * ((a1 - a0) / 2047.0f));
            bf16_t* row = base + ((size_t)(o * 1024 + c) * 2 + dir) * L + ib;
#pragma unroll
            for (int mt = 0; mt < 4; ++mt) {
                f32x4 acc = {0.f, 0.f, 0.f, 0.f};
                acc = __builtin_amdgcn_mfma_f32_16x16x32_bf16(af[mt][0], b0, acc, 0, 0, 0);
                acc = __builtin_amdgcn_mfma_f32_16x16x32_bf16(af[mt][1], b1, acc, 0, 0, 0);
                float ov[4];
#pragma unroll
                for (int r = 0; r < 4; ++r) ov[r] = acc[r] * __expf(-((float)(ib + mt * 16 + r) * rl) * delta);
                u32x2 w; w.x = cvt_pk(ov[0], ov[1]); w.y = cvt_pk(ov[2], ov[3]);
                __builtin_nontemporal_store(w, (u32x2*)(row + mt * 16));
            }
        }
    }
}

PHASE_FN void ph_s5par(KP p) {
    p = launder_kp(p);
    cf2* abar = (cf2*)(p->ws + WS_ABAR); cf2* aT = (cf2*)(p->ws + WS_AT);
    bf16_t* bfrag = (bf16_t*)(p->ws + WS_BFRAG); bf16_t* cfrag = (bf16_t*)(p->ws + WS_CFRAG);
    for (int i = (NBLK - 1 - BID) * NTHREADS + TID; i < 2 * 2 * 128 * 64; i += NBLK * NTHREADS) {
        const int pp = i & 63, g = (i >> 6) & 127, d = (i >> 13) & 1, il = i >> 14;
        const int gi = (il * 2 + d) * 128 + g;
        const double lre = p->in[27][(size_t)gi * 64 + pp], lim = p->in[28][(size_t)gi * 64 + pp];
        const double dt = exp((double)p->in[29][gi]);
        const double zr = lre * dt, zi = lim * dt;
        const double er = exp(zr), ar = er * cos(zi), ai = er * sin(zi);
        abar[i] = mk2((float)ar, (float)ai);
        const double eT = exp(zr * S5T);
        aT[i] = mk2((float)(eT * cos(zi * S5T)), (float)(eT * sin(zi * S5T)));
        const double nr = ar - 1.0, ni = ai, den = lre * lre + lim * lim;
        const double qr = (nr * lre + ni * lim) / den, qi = (ni * lre - nr * lim) / den;
        const size_t fb = (size_t)gi * 4 * 64 * 8;
#pragma unroll
        for (int c = 0; c < 16; ++c) {
            const double br = p->in[30][((size_t)gi * 64 + pp) * 16 + c], bi = p->in[31][((size_t)gi * 64 + pp) * 16 + c];
            const double rr = qr * br - qi * bi, ri = qr * bi + qi * br;
            const int ln = (pp & 31) + 32 * (c >> 3), j = c & 7;
            bfrag[fb + ((size_t)(0 + (pp >> 5)) * 64 + ln) * 8 + j] = f2bf((float)rr);
            bfrag[fb + ((size_t)(2 + (pp >> 5)) * 64 + ln) * 8 + j] = f2bf((float)ri);
            const float cr = p->in[32][((size_t)gi * 16 + c) * 64 + pp], ci = p->in[33][((size_t)gi * 16 + c) * 64 + pp];
#pragma unroll
            for (int ri2 = 0; ri2 < 2; ++ri2) {
                const int k = 2 * pp + ri2, ks = k >> 5, kgq = (k & 31) >> 3, jj = k & 7;
                cfrag[fb + ((size_t)ks * 64 + c + 16 * kgq) * 8 + jj] = f2bf(ri2 ? -ci : cr);
            }
        }
    }
}

PHASE_FN void ph_tw(KP p) {
    p = launder_kp(p);
    cf2* tw = (cf2*)(p->ws + WS_TW);
    for (int i = BID * NTHREADS + TID; i < 8192; i += NBLK * NTHREADS) {
        const double a = -6.283185307179586476925 * (double)i / 16384.0;
        tw[i] = mk2((float)cos(a), (float)sin(a));
    }
}

PHASE_FN void ph_hinit(KP p) {
    p = launder_kp(p);
    bf16_t* xin = (bf16_t*)(p->ws + WS_XIN);
    const float* mvec = (const float*)(p->ws + WS_MVEC);
    const size_t n8 = (size_t)MROWS * DM / 8;
    for (size_t i = (size_t)BID * NTHREADS + TID; i < n8; i += (size_t)NBLK * NTHREADS) {
        const int r = (int)(i / 256), col = (int)(i % 256) * 8, b = r / TPB, pos = r % TPB;
        const float* src = pos < CTXL ? p->in[2] + ((size_t)b * CTXL + pos) * DM + col : p->in[0] + ((size_t)b * SEQ + (pos - CTXL)) * DM + col;
        const float* mv = mvec + (size_t)(pos < CTXL ? 2 : b) * 12288;
        const f32x4 a = __builtin_nontemporal_load((const f32x4*)src), c = __builtin_nontemporal_load((const f32x4*)(src + 4));
        float f[8];
#pragma unroll
        for (int j = 0; j < 4; ++j) { f[j] = a[j] * (1.0f + mv[2048 + col + j]) + mv[col + j]; f[4 + j] = c[j] * (1.0f + mv[2048 + col + 4 + j]) + mv[col + 4 + j]; }
        *(u32x4*)(xin + (size_t)r * DM + col) = pack8(f);
    }
}

template <class AddrF> struct EpiBf16G {
    static constexpr bool PERM = true, AFTER_DRAIN = false;
    AddrF F;
    __device__ __forceinline__ void operator()(const pg8::f32x4 (&acc)[2][2][4][2], const pg8::Unit& u, int wr, int wc, int fr, int fq) const {
        int pm_ = u.pm; asm volatile("" : "+s"(pm_));
        int cw = wc * 32 + 8 * fq; asm volatile("" : "+v"(cw));
        const int row0 = pm_ * 256 + wr * 64 + fr, col0 = u.pn * 256 + cw;
#pragma unroll
        for (int ai = 0; ai < 2; ++ai)
#pragma unroll
            for (int m = 0; m < 4; ++m)
#pragma unroll
                for (int bj = 0; bj < 2; ++bj) {
                    const pg8::f32x4 v0 = acc[ai][bj][m][0], v1 = acc[ai][bj][m][1];
                    u32x4 w; w.x = cvt_pk(v0[0], v0[1]); w.y = cvt_pk(v0[2], v0[3]); w.z = cvt_pk(v1[0], v1[1]); w.w = cvt_pk(v1[2], v1[3]);
                    *(u32x4*)F(row0 + ai * 128 + m * 16, col0 + bj * 128) = w;
                }
    }
};
struct AddrPlain { bf16_t* base; int ld; __device__ __forceinline__ bf16_t* operator()(int row, int col) const { return base + (size_t)row * ld + col; } };
struct EpiKV {
    static constexpr bool PERM = true, AFTER_DRAIN = false;
    bf16_t* k; bf16_t* v;
    __device__ __forceinline__ void operator()(const pg8::f32x4 (&acc)[2][2][4][2], const pg8::Unit& u, int wr, int wc, int fr, int fq) const {
        int pm_ = u.pm; asm volatile("" : "+s"(pm_));
        int cw = wc * 32 + 8 * fq; asm volatile("" : "+v"(cw));
        const int b = pm_ / 33, posb = (pm_ - b * 33) * 256 + wr * 64 + fr;
        const size_t rb = (size_t)(b * NH + u.pn) * TPB + posb;
        bf16_t* kp = k + rb * DQK + cw; bf16_t* vp = v + rb * DVH + cw;
#pragma unroll
        for (int ai = 0; ai < 2; ++ai)
#pragma unroll
            for (int m = 0; m < 4; ++m)
#pragma unroll
                for (int bj = 0; bj < 2; ++bj) {
                    const pg8::f32x4 v0 = acc[ai][bj][m][0], v1 = acc[ai][bj][m][1];
                    u32x4 w; w.x = cvt_pk(v0[0], v0[1]); w.y = cvt_pk(v0[2], v0[3]); w.z = cvt_pk(v1[0], v1[1]); w.w = cvt_pk(v1[2], v1[3]);
                    *(u32x4*)(bj == 0 ? kp + (size_t)(ai * 128 + m * 16) * DQK : vp + (size_t)(ai * 128 + m * 16) * DVH) = w;
                }
    }
};
struct EpiQ {
    static constexpr bool PERM = true, AFTER_DRAIN = false;
    bf16_t* q;
    __device__ __forceinline__ void operator()(const pg8::f32x4 (&acc)[2][2][4][2], const pg8::Unit& u, int wr, int wc, int fr, int fq) const {
        int pm_ = u.pm; asm volatile("" : "+s"(pm_));
        int cw = wc * 32 + 8 * fq; asm volatile("" : "+v"(cw));
        const int b = pm_ / 33, posb = (pm_ - b * 33) * 256 + wr * 64 + fr;
#pragma unroll
        for (int bj = 0; bj < 2; ++bj) {
            const int col = u.pn * 256 + bj * 128 + cw, h = col / DQK, d = col - h * DQK;
            bf16_t* qp = q + ((size_t)(b * NH + h) * TPB + posb) * DQK + d;
#pragma unroll
            for (int ai = 0; ai < 2; ++ai)
#pragma unroll
                for (int m = 0; m < 4; ++m) {
                    const pg8::f32x4 v0 = acc[ai][bj][m][0], v1 = acc[ai][bj][m][1];
                    u32x4 w; w.x = cvt_pk(v0[0], v0[1]); w.y = cvt_pk(v0[2], v0[3]); w.z = cvt_pk(v1[0], v1[1]); w.w = cvt_pk(v1[2], v1[3]);
                    *(u32x4*)(qp + (size_t)(ai * 128 + m * 16) * DQK) = w;
                }
        }
    }
};

struct PanelOrder : pg8::StaticOrder {
    int skip;
    __device__ __forceinline__ bool next(int i, pg8::Unit& u) const {
        const bool ok = pg8::StaticOrder::next(i, u);
        if (skip) u.pm = u.pm < 32 ? u.pm + 1 : u.pm + 2;
        return ok;
    }
};
template <class Epi> __device__ __forceinline__ void run_gemm(LAS unsigned char* lds, const bf16_t* A, const bf16_t* Bt, int M, int N, int K, const Epi& E, int skip_ctx = 0) {
    pg8::Gemm g{A, Bt, M, N, K}; PanelOrder S; S.init(skip_ctx ? M - 2 * CTXL : M, N, NBLK, BID); S.skip = skip_ctx;
    pg8::gemm_phase<Epi, PanelOrder, false>((PG8_LAS unsigned char*)lds, g, S, E, nullptr);
}

PHASE_FN void ph_e2a_rows(KP p, int e) {
    p = launder_kp(p);
    const int lane = TID & 63, wid = TID >> 6;
    const bf16_t* z = (const bf16_t*)(p->ws + WS_Z);
    bf16_t* qn = (bf16_t*)(p->ws + WS_QN); bf16_t* kvn = (bf16_t*)(p->ws + WS_KVN); bf16_t* Kb = (bf16_t*)(p->ws + WS_K);
    const float* qg = p->in[22] + e * QRANK; const float* kg = p->in[24] + e * KVRANK;
    float qgv[8], kgv[4];
#pragma unroll
    for (int j = 0; j < 8; ++j) qgv[j] = qg[lane * 8 + j];
#pragma unroll
    for (int j = 0; j < 4; ++j) kgv[j] = kg[lane * 4 + j];
    const int f16i = lane & 15;
    const float inv = exp2f(-(float)f16i * (13.287712379549449f / 16.0f));
    constexpr int RB = 4;
    for (int r0 = BID * NWAVES + wid; r0 < MROWS; r0 += RB * NBLK * NWAVES) {
        u32x4 wq[RB]; u32x2 wk[RB]; float xr[RB];
#pragma unroll
        for (int u = 0; u < RB; ++u) {
            const bf16_t* zr = z + (size_t)min(r0 + u * NBLK * NWAVES, MROWS - 1) * INWP;
            wq[u] = *(const u32x4*)(zr + OHY + lane * 8); wk[u] = *(const u32x2*)(zr + OQ + lane * 4); xr[u] = bf2f(zr[OKV + lane]);
        }
#pragma unroll
        for (int u = 0; u < RB; ++u) {
            const int r = r0 + u * NBLK * NWAVES;
            if (r >= MROWS) break;
            const int b = r / TPB, pos = r - b * TPB;
            {
                float f[8]; unpack8(wq[u], f);
                float ss = 0.f;
#pragma unroll
                for (int j = 0; j < 8; ++j) ss += f[j] * f[j];
                ss = wave_sum(ss);
                const float rs = rsqrtf(ss * (1.0f / QRANK) + RMS_EPS);
#pragma unroll
                for (int j = 0; j < 8; ++j) f[j] = f[j] * rs * qgv[j];
                *(u32x4*)(qn + (size_t)r * QRANK + lane * 8) = pack8(f);
            }
            {
                const u32x2 w = wk[u];
                float f0 = bflo(w.x), f1 = bfhi(w.x), f2 = bflo(w.y), f3 = bfhi(w.y);
                float ss = wave_sum(f0 * f0 + f1 * f1 + f2 * f2 + f3 * f3);
                const float rs = rsqrtf(ss * (1.0f / KVRANK) + RMS_EPS);
                u32x2 o; o.x = cvt_pk(f0 * rs * kgv[0], f1 * rs * kgv[1]); o.y = cvt_pk(f2 * rs * kgv[2], f3 * rs * kgv[3]);
                *(u32x2*)(kvn + (size_t)r * KVRANK + lane * 4) = o;
            }
            {
                const float x = xr[u];
                const float xp = __builtin_bit_cast(float, __builtin_amdgcn_ds_bpermute((lane ^ 16) << 2, __builtin_bit_cast(int, x)));
                float o = x;
                if (pos >= CTXL) {
                    const int t = pos - CTXL;
                    const float ang = (float)((lane & 32) ? (t & 63) : (t >> 6)) * inv;
                    const float rev = ang * 0.15915494309189535f; const float fr_ = rev - floorf(rev); const float sn = __builtin_amdgcn_sinf(fr_), cs = __builtin_amdgcn_cosf(fr_);
                    o = (lane & 16) ? x * cs + xp * sn : x * cs - xp * sn;
                }
                const bf16_t ob = f2bf(o);
#pragma unroll
                for (int h = 0; h < NH; ++h) Kb[((size_t)(b * NH + h) * TPB + pos) * DQK + 128 + lane] = ob;
            }
        }
    }
}

PHASE_FN void ph_e2a_conv(KP p, int e, LAS unsigned char* lds) {
    p = launder_kp(p);
    LAS bf16_t* T = (LAS bf16_t*)lds;
    const int tid = TID;
    const bf16_t* z = (const bf16_t*)(p->ws + WS_Z);
    bf16_t* zct = (bf16_t*)(p->ws + WS_ZCT);
    const float* cw = p->in[11] + (size_t)e * 3 * OHY; const float* cb = p->in[12] + (size_t)e * OHY;
    const int row = tid >> 3, chunk = tid & 7;
    u32x4 cur[2], prv[2], nxt[2];
#define CV_LOAD(u) do { const int ct_ = (u) % 24, rt_ = (u) / 24, b_ = rt_ / 132, tt_ = rt_ % 132; \
        const int pos_ = tt_ * 64 + row, lo_ = tt_ < 4 ? 0 : CTXL, hi_ = tt_ < 4 ? CTXL : TPB; \
        const bf16_t* zc_ = z + ((size_t)(b_ * TPB + pos_)) * INWP + ct_ * 128 + chunk * 16; const u32x4 zero_ = {0u, 0u, 0u, 0u}; \
        cur[0] = *(const u32x4*)zc_; cur[1] = *(const u32x4*)(zc_ + 8); \
        if (pos_ - 1 >= lo_) { prv[0] = *(const u32x4*)(zc_ - INWP); prv[1] = *(const u32x4*)(zc_ - INWP + 8); } else { prv[0] = zero_; prv[1] = zero_; } \
        if (pos_ + 1 < hi_) { nxt[0] = *(const u32x4*)(zc_ + INWP); nxt[1] = *(const u32x4*)(zc_ + INWP + 8); } else { nxt[0] = zero_; nxt[1] = zero_; } } while (0)
    int u = BID;
    if (u < 264 * 24) CV_LOAD(u);
    for (; u < 264 * 24; u += NBLK) {
        const int ct = u % 24, rt = u / 24, b = rt / 132, tt = rt % 132, pos0 = tt * 64, ch0 = ct * 128 + chunk * 16;
#pragma unroll
        for (int hh = 0; hh < 2; ++hh) {
            float fc[8], fp[8], fn[8]; unpack8(cur[hh], fc); unpack8(prv[hh], fp); unpack8(nxt[hh], fn);
#pragma unroll
            for (int j = 0; j < 8; ++j) {
                const int ch = ch0 + hh * 8 + j;
                const float o = fp[j] * cw[ch] + fc[j] * cw[OHY + ch] + fn[j] * cw[2 * OHY + ch] + cb[ch];
                T[(chunk * 16 + hh * 8 + j) * 72 + row] = f2bf(o);
            }
        }
        if (u + NBLK < 264 * 24) CV_LOAD(u + NBLK);
        __syncthreads();
#pragma unroll
        for (int k = 0; k < 2; ++k) {
            const int q = tid + k * NTHREADS, ch = q >> 3, pc = q & 7;
            const u32x4 w = *(const LAS u32x4*)(T + ch * 72 + pc * 8);
            __builtin_nontemporal_store(w, (u32x4*)(zct + ((size_t)(ct * 128 + ch) * NB + b) * TPB + pos0 + pc * 8));
        }
        __syncthreads();
    }
#undef CV_LOAD
}

PHASE_FN void ph_e4_transpose(KP p, LAS unsigned char* lds) {
    p = launder_kp(p);
    LAS bf16_t* T = (LAS bf16_t*)lds;
    const int tid = TID;
    const bf16_t* yt = (const bf16_t*)(p->ws + WS_YT);
    bf16_t* cat = (bf16_t*)(p->ws + WS_CAT);
    constexpr int NU = NB * 66 * 16;
    u32x4 ld[2];
#define E4_LOAD(u) do { const int ct_ = (u) % 16, tt_ = ((u) / 16) % 66, b_ = (u) / (16 * 66); \
        const bf16_t* s_ = yt + ((size_t)(ct_ * 64 + (tid >> 3)) * NB + b_) * TPB + tt_ * 128 + (tid & 7) * 8; ld[0] = __builtin_nontemporal_load((const u32x4*)s_); ld[1] = __builtin_nontemporal_load((const u32x4*)(s_ + 64)); } while (0)
    int u = BID;
    if (u < NU) E4_LOAD(u);
    for (; u < NU; u += NBLK) {
        const int ct = u % 16, tt = (u / 16) % 66, b = u / (16 * 66);
        const int pos0 = tt * 128, c0 = ct * 64;
        *(LAS u32x4*)(T + (tid >> 3) * 136 + (tid & 7) * 8) = ld[0]; *(LAS u32x4*)(T + (tid >> 3) * 136 + 64 + (tid & 7) * 8) = ld[1];
        if (u + NBLK < NU) E4_LOAD(u + NBLK);
        __syncthreads();
#pragma unroll
        for (int hp = 0; hp < 2; ++hp) {
            const int pos = hp * 64 + (tid >> 3), cc = tid & 7;
            unsigned short s[8];
#pragma unroll
            for (int j = 0; j < 8; ++j) s[j] = T[(cc * 8 + j) * 136 + pos];
            u32x4 w; w.x = s[0] | ((unsigned)s[1] << 16); w.y = s[2] | ((unsigned)s[3] << 16); w.z = s[4] | ((unsigned)s[5] << 16); w.w = s[6] | ((unsigned)s[7] << 16);
            *(u32x4*)(cat + ((size_t)(b * TPB + pos0 + pos)) * DM + c0 + cc * 8) = w;
        }
        __syncthreads();
    }
#undef E4_LOAD
}

template <bool GATED> PHASE_FN void ph_ln_mix(KP p, int layer) {
    p = launder_kp(p);
    const int lane = TID & 63, wid = TID >> 6;
    float* h = (float*)(p->ws + WS_H); bf16_t* xffn = (bf16_t*)(p->ws + WS_XFFN);
    unsigned char* xq8 = p->ws + WS_XQ8; float* xs = (float*)(p->ws + WS_XS);
    const bf16_t* ysrc = (const bf16_t*)(p->ws + (GATED ? WS_Z : WS_YMIX));
    const float* mvec = (const float*)(p->ws + WS_MVEC) + (size_t)layer * 3 * 12288;
    const float* lg = p->in[6] + (size_t)layer * DM; const float* lb = p->in[7] + (size_t)layer * DM;
    for (int r = BID * NWAVES + wid; r < MROWS; r += NBLK * NWAVES) {
        const int b = r / TPB, pos = r - b * TPB;
        if (layer == 3 && pos < CTXL) continue;
        const float* mv = mvec + (size_t)(pos < CTXL ? 2 : b) * 12288;
        const float* hrow = layer == 0 ? (pos < CTXL ? p->in[2] + ((size_t)b * CTXL + pos) * DM : p->in[0] + ((size_t)b * SEQ + (pos - CTXL)) * DM) : h + (size_t)r * DM;
        float x[32];
        float s = 0.f;
#pragma unroll
        for (int c = 0; c < 4; ++c) {
            const int col = c * 512 + lane * 8;
            const f32x4 h0 = __builtin_nontemporal_load((const f32x4*)(hrow + col)), h1 = __builtin_nontemporal_load((const f32x4*)(hrow + col + 4));
            float y[8];
            if (GATED) {
                float o[8], g[8];
                unpack8(__builtin_nontemporal_load((const u32x4*)(ysrc + (size_t)r * 4096 + col)), o); unpack8(__builtin_nontemporal_load((const u32x4*)(ysrc + (size_t)r * 4096 + 2048 + col)), g);
#pragma unroll
                for (int j = 0; j < 8; ++j) y[j] = o[j] / (1.0f + __expf(-g[j]));
            } else unpack8(__builtin_nontemporal_load((const u32x4*)(ysrc + (size_t)r * DM + col)), y);
            const f32x4 g0 = *(const f32x4*)(mv + 2 * 2048 + col), g1 = *(const f32x4*)(mv + 2 * 2048 + col + 4);
#pragma unroll
            for (int j = 0; j < 4; ++j) { x[c * 8 + j] = DN_ALPHA * h0[j] + g0[j] * y[j]; x[c * 8 + 4 + j] = DN_ALPHA * h1[j] + g1[j] * y[4 + j]; }
#pragma unroll
            for (int j = 0; j < 8; ++j) s += x[c * 8 + j];
        }
        const float mean = wave_sum(s) * (1.0f / DM);
        float q = 0.f;
#pragma unroll
        for (int j = 0; j < 32; ++j) { x[j] -= mean; q += x[j] * x[j]; }
        const float rstd = rsqrtf(wave_sum(q) * (1.0f / DM) + LN_EPS);
        float am = 0.f;
#pragma unroll
        for (int c = 0; c < 4; ++c) {
            const int col = c * 512 + lane * 8;
            float hn[8], xf[8];
#pragma unroll
            for (int j = 0; j < 8; ++j) {
                hn[j] = x[c * 8 + j] * rstd * lg[col + j] + lb[col + j];
                xf[j] = hn[j] * (1.0f + mv[4 * 2048 + col + j]) + mv[3 * 2048 + col + j];
                x[c * 8 + j] = xf[j]; am = fmaxf(am, fabsf(xf[j]));
            }
            __builtin_nontemporal_store((f32x4){hn[0], hn[1], hn[2], hn[3]}, (f32x4*)(h + (size_t)r * DM + col));
            __builtin_nontemporal_store((f32x4){hn[4], hn[5], hn[6], hn[7]}, (f32x4*)(h + (size_t)r * DM + col + 4));
            *(u32x4*)(xffn + (size_t)r * DM + col) = pack8(xf);
        }
        am = wave_max(am);
        const float sc = am > 0.f ? am * (1.0f / 224.0f) : 1.0f, inv = 1.0f / sc;
#pragma unroll
        for (int c = 0; c < 4; ++c) {
            u32x2 w;
            int t0 = __builtin_amdgcn_cvt_pk_fp8_f32(x[c * 8 + 0] * inv, x[c * 8 + 1] * inv, 0, false); t0 = __builtin_amdgcn_cvt_pk_fp8_f32(x[c * 8 + 2] * inv, x[c * 8 + 3] * inv, t0, true);
            int t1 = __builtin_amdgcn_cvt_pk_fp8_f32(x[c * 8 + 4] * inv, x[c * 8 + 5] * inv, 0, false); t1 = __builtin_amdgcn_cvt_pk_fp8_f32(x[c * 8 + 6] * inv, x[c * 8 + 7] * inv, t1, true);
            w.x = (unsigned)t0; w.y = (unsigned)t1;
            *(u32x2*)(xq8 + (size_t)r * DM + c * 512 + lane * 8) = w;
        }
        if (lane == 0) xs[r] = sc;
    }
}

namespace att {
constexpr int QBLK = 32, KVBLK = 64;
constexpr int SHM_V = KVBLK * 128 * 2, SHM_KN = KVBLK * 128 * 2, SHM_KR = KVBLK * 64 * 2;
#ifndef ATT_NQL
#define ATT_NQL 4
#endif
constexpr int NQL = ATT_NQL;
constexpr int NSLOT = 3;
constexpr int OFF_V = 0, OFF_KN = NSLOT * SHM_V, OFF_KR = OFF_KN + NSLOT * SHM_KN, OFF_WS = OFF_KR + NSLOT * SHM_KR, OFF_QS = OFF_WS + NWAVES * 64 * 4, SHM_ATTN = OFF_QS + NWAVES * NQL * 64 * 16;
#ifndef ATT_TWO_TILE
#define ATT_TWO_TILE 1
#endif
static_assert(SHM_ATTN <= LDS_BYTES - 64, "attention LDS map");
#ifndef ATT_SDEPTH
#define ATT_SDEPTH 1
#endif
constexpr int SDEPTH = ATT_SDEPTH;
constexpr float THR = 8.f;
#define KSWZ(row, colB) ((row) * 256 + ((colB) ^ (((row) & 7) << 4)))
#define KRSWZ(row, colB) ((row) * 128 + ((colB) ^ ((((row) >> 1) & 7) << 4)))
#define SBAR() __builtin_amdgcn_sched_barrier(0)
__device__ __forceinline__ int crow(int r, int hi) { return (r & 3) + 8 * (r >> 2) + 4 * hi; }

__device__ __forceinline__ void partialSM(f32x16& p0, f32x16& p1, float& m_reg, float& mn, float& alpha) {
    constexpr float C = MLA_SCALE * 1.4426950408889634f;
    float pmax = p0[0];
#pragma unroll
    for (int r = 1; r < 16; ++r) pmax = fmaxf(pmax, p0[r]);
#pragma unroll
    for (int r = 0; r < 16; ++r) pmax = fmaxf(pmax, p1[r]);
    { auto rr = __builtin_amdgcn_permlane32_swap(__float_as_uint(pmax), __float_as_uint(pmax), false, false);
      pmax = fmaxf(__uint_as_float(rr[0]), __uint_as_float(rr[1])); }
    if (__builtin_expect(__all(pmax - m_reg <= THR / MLA_SCALE), 1)) { mn = m_reg; alpha = 1.f; }
    else { mn = fmaxf(m_reg, pmax); alpha = __builtin_amdgcn_exp2f((m_reg - mn) * C); m_reg = mn; }
    const float mnC = -mn * C;
#pragma unroll
    for (int r = 0; r < 16; ++r) p0[r] = fmaf(p0[r], C, mnC);
#pragma unroll
    for (int r = 0; r < 16; ++r) p1[r] = fmaf(p1[r], C, mnC);
#pragma unroll
    for (int r = 0; r < 16; ++r) p0[r] = __builtin_amdgcn_exp2f(p0[r]);
}
__device__ __forceinline__ void finishSM(f32x16& p0, f32x16& p1, float alpha, float& l_reg, bf16x8& pa0, bf16x8& pa1, bf16x8& pa2, bf16x8& pa3) {
#pragma unroll
    for (int r = 0; r < 16; ++r) p1[r] = __builtin_amdgcn_exp2f(p1[r]);
    float ps = 0;
#pragma unroll
    for (int r = 0; r < 16; ++r) ps += p0[r];
#pragma unroll
    for (int r = 0; r < 16; ++r) ps += p1[r];
    { auto rr = __builtin_amdgcn_permlane32_swap(__float_as_uint(ps), __float_as_uint(ps), false, false);
      ps = __uint_as_float(rr[0]) + __uint_as_float(rr[1]); }
    l_reg = l_reg * alpha + ps;
#define PK4(P, BASE, OUT) do { unsigned a0 = cvt_pk(P[BASE + 0], P[BASE + 1]), a1 = cvt_pk(P[BASE + 2], P[BASE + 3]);   \
    unsigned b0 = cvt_pk(P[BASE + 4], P[BASE + 5]), b1 = cvt_pk(P[BASE + 6], P[BASE + 7]);                              \
    auto r0 = __builtin_amdgcn_permlane32_swap(a0, b0, false, false); auto r1 = __builtin_amdgcn_permlane32_swap(a1, b1, false, false); \
    u32x4 w = {r0[0], r1[0], r0[1], r1[1]}; OUT = *reinterpret_cast<bf16x8*>(&w); } while (0)
    PK4(p0, 0, pa0); PK4(p0, 8, pa1); PK4(p1, 0, pa2); PK4(p1, 8, pa3);
#undef PK4
}
__device__ __forceinline__ void qkt(f32x16& p0, f32x16& p1, const char* Kn, const char* Kr, const bf16x8* qr, const char* qs, int r32, int hi) {
    p0 = f32x16{}; p1 = f32x16{};
#pragma unroll
    for (int d0 = 0; d0 < 8; ++d0) { const int cb = (d0 * 16 + hi * 8) * 2;
        const bf16x8 b0 = *reinterpret_cast<const bf16x8*>(Kn + KSWZ(r32, cb));
        const bf16x8 b1 = *reinterpret_cast<const bf16x8*>(Kn + KSWZ(32 + r32, cb));
        const bf16x8 qf = (d0 >= 12 - NQL) ? *reinterpret_cast<const bf16x8*>(qs + (d0 - (12 - NQL)) * 1024) : qr[d0];
        p0 = __builtin_amdgcn_mfma_f32_32x32x16_bf16(b0, qf, p0, 0, 0, 0);
        p1 = __builtin_amdgcn_mfma_f32_32x32x16_bf16(b1, qf, p1, 0, 0, 0);
        if (d0 == 3 || d0 == 7) SBAR(); }
#pragma unroll
    for (int d0 = 0; d0 < 4; ++d0) { const int cb = (d0 * 16 + hi * 8) * 2;
        const bf16x8 b0 = *reinterpret_cast<const bf16x8*>(Kr + KRSWZ(r32, cb));
        const bf16x8 b1 = *reinterpret_cast<const bf16x8*>(Kr + KRSWZ(32 + r32, cb));
        const bf16x8 qf = (8 + d0 >= 12 - NQL) ? *reinterpret_cast<const bf16x8*>(qs + (8 + d0 - (12 - NQL)) * 1024) : qr[8 + d0];
        p0 = __builtin_amdgcn_mfma_f32_32x32x16_bf16(b0, qf, p0, 0, 0, 0);
        p1 = __builtin_amdgcn_mfma_f32_32x32x16_bf16(b1, qf, p1, 0, 0, 0); }
}
__device__ __forceinline__ int v_st(int k, int c) { const int kk = (k & ~0xC) | ((k & 4) << 1) | ((k & 8) >> 1); return ((kk >> 3) * 4 + (c >> 5)) * 512 + ((kk & 7) * 32 + (c & 31)) * 2; }
__device__ __forceinline__ int v_rd_base(int lane) { return ((lane & 3) << 3) | (((lane >> 2) & 3) << 6) | (((lane >> 4) & 1) << 5) | (((lane >> 5) & 1) << 8); }
constexpr int v_rd_off(int d0, int ks, int half) { return d0 * 512 + ks * 4096 + half * 2048; }
template <int OFF> __device__ __forceinline__ s16x4 tr_read(int vb) {
    s16x4 r; asm volatile("ds_read_b64_tr_b16 %0, %1 offset:%2" : "=&v"(r) : "v"(vb), "i"(OFF) : "memory"); return r;
}
template <int D0> __device__ __forceinline__ void pv_one(f32x16& od, int vb, bf16x8 pa0, bf16x8 pa1, bf16x8 pa2, bf16x8 pa3) {
    const s16x4 l0 = tr_read<v_rd_off(D0, 0, 0)>(vb), h0 = tr_read<v_rd_off(D0, 0, 1)>(vb), l1 = tr_read<v_rd_off(D0, 1, 0)>(vb), h1 = tr_read<v_rd_off(D0, 1, 1)>(vb);
    const s16x4 l2 = tr_read<v_rd_off(D0, 2, 0)>(vb), h2 = tr_read<v_rd_off(D0, 2, 1)>(vb), l3 = tr_read<v_rd_off(D0, 3, 0)>(vb), h3 = tr_read<v_rd_off(D0, 3, 1)>(vb);
    asm volatile("s_waitcnt lgkmcnt(0)" ::: "memory"); SBAR();
#define PK(L, H) (bf16x8){L[0], L[1], L[2], L[3], H[0], H[1], H[2], H[3]}
    od = __builtin_amdgcn_mfma_f32_32x32x16_bf16(pa0, PK(l0, h0), od, 0, 0, 0);
    od = __builtin_amdgcn_mfma_f32_32x32x16_bf16(pa1, PK(l1, h1), od, 0, 0, 0);
    od = __builtin_amdgcn_mfma_f32_32x32x16_bf16(pa2, PK(l2, h2), od, 0, 0, 0);
    od = __builtin_amdgcn_mfma_f32_32x32x16_bf16(pa3, PK(l3, h3), od, 0, 0, 0);
#undef PK
}
__device__ __forceinline__ void pv_d0(f32x16* o, int vb, bf16x8 pa0, bf16x8 pa1, bf16x8 pa2, bf16x8 pa3) {
    pv_one<0>(o[0], vb, pa0, pa1, pa2, pa3); pv_one<1>(o[1], vb, pa0, pa1, pa2, pa3); pv_one<2>(o[2], vb, pa0, pa1, pa2, pa3); pv_one<3>(o[3], vb, pa0, pa1, pa2, pa3);
}

__device__ __forceinline__ void attn_body(const bf16_t* __restrict__ Qb, const bf16_t* __restrict__ Kh, const bf16_t* __restrict__ Vh,
                                          bf16_t* __restrict__ Ob, int ldo, int seq, int rope_t0, char* lds) {
    const int tid = TID, wid = tid >> 6, lane = tid & 63, r32 = lane & 31, hi = lane >> 5;
    char* V_lds = lds + OFF_V; char* Kn_lds = lds + OFF_KN; char* Kr_lds = lds + OFF_KR;
    float* ws = (float*)(lds + OFF_WS) + wid * 64; float* li_l = ws; float* al_l = ws + 32;
    float m_reg = -1e30f, l_reg = 0; f32x16 o[4] = {}; bf16x8 qr[12];
    char* qs = lds + OFF_QS + (wid * NQL * 64 + lane) * 16;
    const bf16_t* Qw = Qb + (size_t)(wid * QBLK + r32) * DQK + hi * 8;
#pragma unroll
    for (int d0 = 0; d0 < 12; ++d0) qr[d0] = *reinterpret_cast<const bf16x8*>(Qw + d0 * 16);
    if (rope_t0 >= 0) {
        const int t = rope_t0 + wid * QBLK + r32;
        const float frow = (float)(t >> 6), fcol = (float)(t & 63);
#pragma unroll
        for (int ax = 0; ax < 2; ++ax) {
            u32x4 w0 = *reinterpret_cast<u32x4*>(&qr[8 + 2 * ax]), w1 = *reinterpret_cast<u32x4*>(&qr[9 + 2 * ax]);
            float x0[8], x1[8]; unpack8(w0, x0); unpack8(w1, x1);
#pragma unroll
            for (int j = 0; j < 8; ++j) {
                const float inv = exp2f(-(float)(hi * 8 + j) * (13.287712379549449f / 16.0f));
                const float ang = (ax ? fcol : frow) * inv;
                const float rev = ang * 0.15915494309189535f; const float fr_ = rev - floorf(rev); const float sn = __builtin_amdgcn_sinf(fr_), cs = __builtin_amdgcn_cosf(fr_);
                const float y0 = x0[j] * cs - x1[j] * sn, y1 = x1[j] * cs + x0[j] * sn;
                x0[j] = y0; x1[j] = y1;
            }
            w0 = pack8(x0); w1 = pack8(x1);
            qr[8 + 2 * ax] = *reinterpret_cast<bf16x8*>(&w0); qr[9 + 2 * ax] = *reinterpret_cast<bf16x8*>(&w1);
        }
    }
#pragma unroll
    for (int d0 = 12 - NQL; d0 < 12; ++d0) *reinterpret_cast<bf16x8*>(qs + (d0 - (12 - NQL)) * 1024) = qr[d0];
    const int sr = tid >> 4, sc = (tid & 15) * 8, vst0 = v_st(sr, sc), vst1 = v_st(32 + sr, sc);
    const int krr = tid >> 3, krc = (tid & 7) * 8;
    const int vb0 = (int)(uintptr_t)V_lds + v_rd_base(lane);
    struct { bf16x8 vs0, vs1, ks0, ks1, kr; } sr_[1];
    const unsigned ovs0 = (unsigned)((sr * DVH + sc) * 2), ovs1 = (unsigned)(((32 + sr) * DVH + sc) * 2), oks0 = (unsigned)((sr * DQK + sc) * 2), oks1 = (unsigned)(((32 + sr) * DQK + sc) * 2),
                   okr = (unsigned)((krr * DQK + 128 + krc) * 2);
    const __amdgpu_buffer_rsrc_t rK_ = __builtin_amdgcn_make_buffer_rsrc((void*)Kh, 0, seq * DQK * 2, 0x00020000);
    const __amdgpu_buffer_rsrc_t rV_ = __builtin_amdgcn_make_buffer_rsrc((void*)Vh, 0, seq * DVH * 2, 0x00020000);
#define BLD_(r, vo, so) __builtin_bit_cast(bf16x8, __builtin_amdgcn_raw_buffer_load_b128((r), (int)(vo), (so), 0))
#define SLOAD(i, k0) do { const int sk_ = (k0) * (DQK * 2), sv_ = (k0) * (DVH * 2); \
    sr_[i].vs0 = BLD_(rV_, ovs0, sv_); sr_[i].vs1 = BLD_(rV_, ovs1, sv_); \
    sr_[i].ks0 = BLD_(rK_, oks0, sk_); sr_[i].ks1 = BLD_(rK_, oks1, sk_); sr_[i].kr = BLD_(rK_, okr, sk_); } while (0)
#define SWRITE(b, i) do { *(bf16x8*)(V_lds + (b) * SHM_V + vst0) = sr_[i].vs0; *(bf16x8*)(V_lds + (b) * SHM_V + vst1) = sr_[i].vs1; const int kc = sc * 2; \
    *(bf16x8*)(Kn_lds + (b) * SHM_KN + KSWZ(sr, kc)) = sr_[i].ks0; *(bf16x8*)(Kn_lds + (b) * SHM_KN + KSWZ(32 + sr, kc)) = sr_[i].ks1; \
    *(bf16x8*)(Kr_lds + (b) * SHM_KR + KRSWZ(krr, krc * 2)) = sr_[i].kr; } while (0)
#define SWAIT() do { if constexpr (SDEPTH == 2) asm volatile("s_waitcnt vmcnt(5)" ::: "memory"); else asm volatile("s_waitcnt vmcnt(0)" ::: "memory"); } while (0)
#define RESC(a) do { if (__any((a) < 1.f)) { if (hi == 0) al_l[r32] = (a); asm volatile("s_waitcnt lgkmcnt(0)" ::: "memory"); \
    _Pragma("unroll") for (int d = 0; d < 4; ++d) _Pragma("unroll") for (int r = 0; r < 16; ++r) o[d][r] *= al_l[crow(r, hi)]; } } while (0)
    const int NT = seq / KVBLK;
#if ATT_TWO_TILE
    f32x16 pA0, pA1, pB0, pB1; float mnA, mnB, alA, alB; bf16x8 pa0, pa1, pa2, pa3;
    SLOAD(0, 0); asm volatile("s_waitcnt vmcnt(0)" ::: "memory"); SWRITE(0, 0); __syncthreads();
    qkt(pA0, pA1, Kn_lds, Kr_lds, qr, qs, r32, hi); partialSM(pA0, pA1, m_reg, mnA, alA);
    SLOAD(0, KVBLK); asm volatile("s_waitcnt vmcnt(0)" ::: "memory"); SWRITE(1, 0); __syncthreads();
    int sp = 0, sj = 1, sn = 2;
    for (int j = 1; j + 1 < NT; j += 2) {
        SBAR(); qkt(pB0, pB1, Kn_lds + sj * SHM_KN, Kr_lds + sj * SHM_KR, qr, qs, r32, hi);
        finishSM(pA0, pA1, alA, l_reg, pa0, pa1, pa2, pa3); SBAR();
        SLOAD(0, (j + 1) * KVBLK); SBAR();
        pv_d0(o, vb0 + sp * SHM_V, pa0, pa1, pa2, pa3); partialSM(pB0, pB1, m_reg, mnB, alB);
        asm volatile("s_waitcnt vmcnt(0)" ::: "memory"); SWRITE(sn, 0);
        RESC(alB); __syncthreads();
        SBAR(); qkt(pA0, pA1, Kn_lds + sn * SHM_KN, Kr_lds + sn * SHM_KR, qr, qs, r32, hi);
        finishSM(pB0, pB1, alB, l_reg, pa0, pa1, pa2, pa3); SBAR();
        SLOAD(0, (j + 2) * KVBLK); SBAR();
        pv_d0(o, vb0 + sj * SHM_V, pa0, pa1, pa2, pa3); partialSM(pA0, pA1, m_reg, mnA, alA);
        asm volatile("s_waitcnt vmcnt(0)" ::: "memory"); SWRITE(sp, 0);
        RESC(alA); __syncthreads();
        { const int t0_ = sp; sp = sn; sn = sj; sj = t0_; }
    }
    SBAR(); qkt(pB0, pB1, Kn_lds + sj * SHM_KN, Kr_lds + sj * SHM_KR, qr, qs, r32, hi);
    finishSM(pA0, pA1, alA, l_reg, pa0, pa1, pa2, pa3); SBAR();
    pv_d0(o, vb0 + sp * SHM_V, pa0, pa1, pa2, pa3); partialSM(pB0, pB1, m_reg, mnB, alB);
    RESC(alB);
    finishSM(pB0, pB1, alB, l_reg, pa0, pa1, pa2, pa3); SBAR();
    pv_d0(o, vb0 + sj * SHM_V, pa0, pa1, pa2, pa3);
    __syncthreads();
#else
    f32x16 p0, p1; float mn, al; bf16x8 pa0, pa1, pa2, pa3;
    SLOAD(0, 0); asm volatile("s_waitcnt vmcnt(0)" ::: "memory"); SWRITE(0, 0); __syncthreads();
    for (int j = 0; j < NT; ++j) {
        const int bsel = j & 1;
        if (j + 1 < NT) SLOAD(0, (j + 1) * KVBLK);
        SBAR();
        qkt(p0, p1, Kn_lds + bsel * SHM_KN, Kr_lds + bsel * SHM_KR, qr, qs, r32, hi);
        partialSM(p0, p1, m_reg, mn, al);
        RESC(al);
        finishSM(p0, p1, al, l_reg, pa0, pa1, pa2, pa3); SBAR();
        pv_d0(o, vb0 + bsel * SHM_V, pa0, pa1, pa2, pa3);
        if (j + 1 < NT) { asm volatile("s_waitcnt vmcnt(0)" ::: "memory"); if (bsel) { SWRITE(0, 0); } else { SWRITE(1, 0); } }
        __syncthreads();
    }
#endif
    if (hi == 0) li_l[r32] = l_reg; asm volatile("s_waitcnt lgkmcnt(0)" ::: "memory");
    float rli[16];
#pragma unroll
    for (int r = 0; r < 16; ++r) rli[r] = __builtin_amdgcn_rcpf(li_l[crow(r, hi)]);
    bf16_t* Ow = Ob + (size_t)(wid * QBLK) * ldo;
#pragma unroll
    for (int r = 0; r < 16; ++r) { const int orow = crow(r, hi);
#pragma unroll
        for (int d0 = 0; d0 < 4; ++d0) Ow[(size_t)orow * ldo + d0 * 32 + r32] = f2bf(o[d0][r] * rli[r]); }
#undef SLOAD
#undef BLD_
#undef SWRITE
#undef SWAIT
#undef RESC
}
}

PHASE_FN void ph_attention(KP p, LAS unsigned char* ldsl) {
    p = launder_kp(p);
    char* lds = (char*)ldsl;
    const bf16_t* Q = (const bf16_t*)(p->ws + WS_Q); const bf16_t* K = (const bf16_t*)(p->ws + WS_K); const bf16_t* V = (const bf16_t*)(p->ws + WS_V);
    bf16_t* cat = (bf16_t*)(p->ws + WS_CAT);
    for (int u = BID; u < 512 + 16; u += NBLK) {
        int b, h, q0, seq, rope;
        if (u < 512) { const int bh = 2 * (u & 7) + (u >> 8); b = bh >> 3; h = bh & 7; const int qb = (u >> 3) & 31; q0 = CTXL + qb * 256; seq = TPB; rope = qb * 256; }
        else { const int v = u - 512; b = v >> 3; h = v & 7; q0 = 0; seq = CTXL; rope = -1; }
        const size_t hb = (size_t)(b * NH + h) * TPB;
        __syncthreads();
        att::attn_body(Q + (hb + q0) * DQK, K + hb * DQK, V + hb * DVH, cat + ((size_t)(b * TPB + q0)) * DM + 1024 + h * 128, DM, seq, rope, lds);
    }
    __syncthreads();
}

#define PADI(i) ((i) + ((i) >> 5))
namespace hy {
__device__ __forceinline__ cf2 cmul(cf2 a, cf2 w) { const cf2 wr = {-w.y, w.x}; const cf2 r = (cf2){a.x, a.x} * w; return __builtin_elementwise_fma((cf2){a.y, a.y}, wr, r); }
__device__ __forceinline__ cf2 cmulc(cf2 a, cf2 w) { const cf2 wc = {w.x, -w.y}, wr = {w.y, w.x}; const cf2 r = (cf2){a.x, a.x} * wc; return __builtin_elementwise_fma((cf2){a.y, a.y}, wr, r); }
template <int D, int K> __device__ __forceinline__ cf2 rotc(cf2 w) {
    constexpr float c = 0.70710678118654752f;
    if constexpr (K == 0) return w;
    else if constexpr (D == 4 && K == 1) return mk2(w.y, -w.x);
    else if constexpr (D == 8 && K == 2) return mk2(w.y, -w.x);
    else if constexpr (D == 8 && K == 1) return mk2(c * (w.x + w.y), c * (w.y - w.x));
    else { static_assert(D == 8 && K == 3, "rotc"); return mk2(c * (w.y - w.x), -c * (w.x + w.y)); }
}
__device__ __forceinline__ constexpr float w32c(int k) { constexpr float c[16] = {1.0f, 0.98078528040323043f, 0.92387953251128674f, 0.83146961230254524f, 0.70710678118654752f, 0.55557023301960222f, 0.38268343236508977f, 0.19509032201612827f,
    0.0f, -0.19509032201612827f, -0.38268343236508977f, -0.55557023301960222f, -0.70710678118654752f, -0.83146961230254524f, -0.92387953251128674f, -0.98078528040323043f}; return c[k]; }
__device__ __forceinline__ constexpr float w32s(int k) { constexpr float s[16] = {0.0f, -0.19509032201612827f, -0.38268343236508977f, -0.55557023301960222f, -0.70710678118654752f, -0.83146961230254524f, -0.92387953251128674f, -0.98078528040323043f,
    -1.0f, -0.98078528040323043f, -0.92387953251128674f, -0.83146961230254524f, -0.70710678118654752f, -0.55557023301960222f, -0.38268343236508977f, -0.19509032201612827f}; return s[k]; }

template <bool INV> __device__ __forceinline__ void bfly(cf2& a, cf2& b, cf2 w) {
    if (!INV) { const cf2 u = a, v = b; a = u + v; b = cmul(u - v, w); }
    else { const cf2 u = a, v = cmulc(b, w); a = u + v; b = u - v; }
}
template <bool INV> __device__ __forceinline__ void r5_regs(cf2 (&x)[32]) {
#pragma unroll
    for (int ss = 0; ss < 5; ++ss) {
        const int s = INV ? 4 - ss : ss, half = 32 >> (s + 1);
#pragma unroll
        for (int q = 0; q < 32; ++q) if ((q & half) == 0) bfly<INV>(x[q], x[q + half], mk2(w32c((q & (half - 1)) << s), w32s((q & (half - 1)) << s)));
    }
}
template <int R, bool INV, int LM, int LOGTOT>
__device__ __forceinline__ void fft_pass(LAS cf2* X) {
    constexpr int G = 1 << R, lm = LM;
    constexpr int lst = lm - R, st = 1 << lst;
    static_assert(st >= 32, "padded stride must be linear in q");
    constexpr int pst = st + (st >> 5);
    constexpr int ngroups = 1 << (LOGTOT - R), NIT = ngroups / NTHREADS;
    static_assert(NIT >= 1 && NIT * NTHREADS == ngroups, "groups per thread");
    const float rs0 = __uint_as_float((unsigned)(127 - lm) << 23);
    cf2 xb[2][G];
    auto xaddr = [&](int it) -> LAS cf2* { const int gi = TID + it * NTHREADS; const int blk = gi >> lst, j = gi & (st - 1); return X + PADI((blk << lm) + j); };
    { LAS cf2* p0 = xaddr(0);
#pragma unroll
      for (int q = 0; q < G; ++q) xb[0][q] = ((volatile LAS cf2*)p0)[q * pst];       }
#pragma unroll
    for (int it = 0; it < NIT; ++it) {
        cf2 (&x)[G] = xb[it & 1];
        if (it + 1 < NIT) { LAS cf2* pn = xaddr(it + 1);
#pragma unroll
            for (int q = 0; q < G; ++q) xb[(it + 1) & 1][q] = ((volatile LAS cf2*)pn)[q * pst]; }
        const int gi = TID + it * NTHREADS, j = gi & (st - 1);
        cf2 wp[R];
        { const float rev = (float)j * rs0; wp[0] = mk2(__builtin_amdgcn_cosf(rev), -__builtin_amdgcn_sinf(rev)); }
#pragma unroll
        for (int s = 1; s < R; ++s) wp[s] = cmul(wp[s - 1], wp[s - 1]);
#pragma unroll
        for (int ss = 0; ss < R; ++ss) {
            const int s = INV ? R - 1 - ss : ss;
            if (s == 0) {
                if constexpr (R == 3) { bfly<INV>(x[0], x[4], wp[0]); bfly<INV>(x[1], x[5], rotc<8, 1>(wp[0])); bfly<INV>(x[2], x[6], rotc<8, 2>(wp[0])); bfly<INV>(x[3], x[7], rotc<8, 3>(wp[0])); }
                else if constexpr (R == 2) { bfly<INV>(x[0], x[2], wp[0]); bfly<INV>(x[1], x[3], rotc<4, 1>(wp[0])); }
                else { bfly<INV>(x[0], x[1], wp[0]); }
            } else if (s == 1) {
                if constexpr (R == 3) { bfly<INV>(x[0], x[2], wp[1]); bfly<INV>(x[1], x[3], rotc<4, 1>(wp[1])); bfly<INV>(x[4], x[6], wp[1]); bfly<INV>(x[5], x[7], rotc<4, 1>(wp[1])); }
                else if constexpr (R == 2) { bfly<INV>(x[0], x[1], wp[1]); bfly<INV>(x[2], x[3], wp[1]); }
            } else {
                if constexpr (R == 3) { bfly<INV>(x[0], x[1], wp[2]); bfly<INV>(x[2], x[3], wp[2]); bfly<INV>(x[4], x[5], wp[2]); bfly<INV>(x[6], x[7], wp[2]); }
            }
        }
        LAS cf2* pc = xaddr(it);
#pragma unroll
        for (int q = 0; q < G; ++q) pc[q * pst] = x[q];
    }
    __syncthreads();
}
template <int LOGN, int LT> __device__ __forceinline__ void fft_fwd_upper(LAS cf2* X) {
    static_assert(LOGN == 14 || LOGN == 9, "pass plan");
    if constexpr (LOGN == 14) { fft_pass<3, false, 14, LT>(X); fft_pass<3, false, 11, LT>(X); fft_pass<3, false, 8, LT>(X); }
    else { fft_pass<3, false, 9, LT>(X); fft_pass<1, false, 6, LT>(X); }
}
template <int LOGN, int LT> __device__ __forceinline__ void fft_inv_upper(LAS cf2* X) {
    if constexpr (LOGN == 14) { fft_pass<3, true, 8, LT>(X); fft_pass<3, true, 11, LT>(X); fft_pass<3, true, 14, LT>(X); }
    else { fft_pass<1, true, 6, LT>(X); fft_pass<3, true, 9, LT>(X); }
}
}

template <int NCH, int LOGL>
__device__ __forceinline__ void hyena_unit(KP p, int e, int c0, LAS unsigned char* lds, cf2* scr) {
    constexpr int L = 1 << LOGL, N = 2 * L, LOGN = LOGL + 1, TOT = NCH * N;
    constexpr int LOGTOT = LOGN + (NCH == 8 ? 3 : 0), NGR = TOT / 32;
    constexpr bool lat = (NCH == 1);
    constexpr int pos0 = lat ? CTXL : 0;
    LAS cf2* X = (LAS cf2*)lds;
    LAS float* red = (LAS float*)(lds + 147456);
    const int tid = TID, lane = tid & 63, wid = tid >> 6;
    const bf16_t* zct = (const bf16_t*)(p->ws + WS_ZCT);
    bf16_t* yt = (bf16_t*)(p->ws + WS_YT);
    const bf16_t* hk = (const bf16_t*)(p->ws + WS_HK) + (size_t)e * (HK_LAT + HK_CTX) + (lat ? 0 : HK_LAT);
    cf2* KS0 = scr; cf2* KS1 = scr + 16384; cf2* Y1 = scr + 32768;
#pragma unroll 1
    for (int rep_ = 0; rep_ < ((REP_MASK & 2048) ? 2 : 1); ++rep_) {
    {
        float as0 = 0.f, as1 = 0.f;
        if constexpr (lat) {
            const bf16_t* h0 = hk + ((size_t)c0 * 2) * L; const bf16_t* h1 = hk + ((size_t)(1024 + c0) * 2) * L;
            u32x4 f0[2], b0[2], f1[2], b1[2];
#pragma unroll
            for (int kk = 0; kk < 2; ++kk) { const int i = 8 * tid + 4096 * kk; f0[kk] = *(const u32x4*)(h0 + i); b0[kk] = *(const u32x4*)(h0 + L + i); f1[kk] = *(const u32x4*)(h1 + i); b1[kk] = *(const u32x4*)(h1 + L + i); }
#pragma unroll
            for (int kk = 0; kk < 2; ++kk) {
                float vf0[8], vb0[8], vf1[8], vb1[8]; unpack8(f0[kk], vf0); unpack8(b0[kk], vb0); unpack8(f1[kk], vf1); unpack8(b1[kk], vb1);
#pragma unroll
                for (int e8 = 0; e8 < 8; ++e8) {
                    const int i = 8 * tid + 4096 * kk + e8;
                    as0 += fabsf(vf0[e8]) + fabsf(vb0[e8]); as1 += fabsf(vf1[e8]) + fabsf(vb1[e8]);
                    X[PADI(i)] = mk2(vf0[e8], vf1[e8]);
                    if (i == 0) X[PADI(L)] = mk2(0.f, 0.f); else X[PADI(N - i)] = mk2(vb0[e8], vb1[e8]);
                }
            }
        } else
        for (int k = 0; k < NCH * L / NTHREADS; ++k) {
            const int ch = wid, i = lane + 64 * k;
            const bf16_t* h0 = hk + ((size_t)(c0 + ch) * 2) * L; const bf16_t* h1 = hk + ((size_t)(1024 + c0 + ch) * 2) * L;
            const float f0 = bf2f(h0[i]), b0 = bf2f(h0[L + i]), f1 = bf2f(h1[i]), b1 = bf2f(h1[L + i]);
            as0 += fabsf(f0) + fabsf(b0); as1 += fabsf(f1) + fabsf(b1);
            X[PADI(ch * N + i)] = mk2(f0, f1);
            if (i == 0) X[PADI(ch * N + L)] = mk2(0.f, 0.f); else X[PADI(ch * N + N - i)] = mk2(b0, b1);
        }
        as0 = wave_sum(as0); as1 = wave_sum(as1);
        __syncthreads();
        if (lane == 0) { red[wid] = as0; red[8 + wid] = as1; }
        __syncthreads();
    }
    hy::fft_fwd_upper<LOGN, LOGTOT>(X);
    for (int gi = tid; gi < NGR; gi += NTHREADS) {
        cf2 x[32];
#pragma unroll
        for (int k = 0; k < 32; ++k) x[k] = ((volatile LAS cf2*)X)[PADI(gi * 32 + k)];
        hy::r5_regs<false>(x);
#pragma unroll
        for (int k = 0; k < 32; ++k) X[PADI(gi * 32 + k)] = x[k];
    }
    __syncthreads();
    for (int gi = tid; gi < NGR; gi += NTHREADS) {
        const int ch = (gi * 32) >> LOGN;
        float n0, n1;
        if constexpr (lat) { n0 = 0.f; n1 = 0.f;
#pragma unroll
            for (int w = 0; w < NWAVES; ++w) { n0 += red[w]; n1 += red[8 + w]; } }
        else { n0 = red[ch]; n1 = red[8 + ch]; }
        const float r0 = 0.5f / (n0 * (float)N), r1 = 0.5f / (n1 * (float)N);
#pragma unroll 8
        for (int k = 0; k < 32; ++k) {
            const int q = gi * 32 + k, ql = q & (N - 1);
            const int f = (int)(__brev((unsigned)ql) >> (32 - LOGN));
            const int qp = (q - ql) + (int)(__brev((unsigned)((N - f) & (N - 1))) >> (32 - LOGN));
            const cf2 a = X[PADI(q)], b = X[PADI(qp)];
            KS0[k * NGR + gi] = mk2((a.x + b.x) * r0, (a.y - b.y) * r0);
            KS1[k * NGR + gi] = mk2((a.y + b.y) * r1, (b.x - a.x) * r1);
        }
    }
    __syncthreads();
    }
    if constexpr (lat) {
        const bf16_t* vp = zct + ((size_t)(2048 + c0) * NB) * TPB + pos0;
        u32x4 r0[2], r1[2];
#pragma unroll
        for (int kk = 0; kk < 2; ++kk) { const int i = 8 * tid + 4096 * kk; r0[kk] = *(const u32x4*)(vp + i); r1[kk] = *(const u32x4*)(vp + TPB + i); }
#pragma unroll
        for (int kk = 0; kk < 2; ++kk) {
            const int i = 8 * tid + 4096 * kk; float a[8], b[8]; unpack8(r0[kk], a); unpack8(r1[kk], b);
#pragma unroll
            for (int e = 0; e < 8; ++e) { X[PADI(i + e)] = mk2(a[e], b[e]); X[PADI(L + i + e)] = mk2(0.f, 0.f); }
        }
    } else
    for (int g = tid; g < NCH * L; g += NTHREADS) {
        const int ch = g >> LOGL, i = g & (L - 1);
        const bf16_t* vp = zct + ((size_t)(2048 + c0 + ch) * NB) * TPB + pos0;
        X[PADI(ch * N + i)] = mk2(bf2f(vp[i]), bf2f(vp[TPB + i])); X[PADI(ch * N + L + i)] = mk2(0.f, 0.f);
    }
    __syncthreads();
#pragma unroll 1
    for (int o = 0; o < 2; ++o) {
        hy::fft_fwd_upper<LOGN, LOGTOT>(X);
        const cf2* KS = o ? KS1 : KS0;
        for (int gi = tid; gi < NGR; gi += NTHREADS) {
            cf2 x[32];
#pragma unroll
            for (int k = 0; k < 32; ++k) x[k] = ((volatile LAS cf2*)X)[PADI(gi * 32 + k)];
            hy::r5_regs<false>(x);
#pragma unroll
            for (int k = 0; k < 32; ++k) x[k] = hy::cmul(x[k], KS[k * NGR + gi]);
            hy::r5_regs<true>(x);
#pragma unroll
            for (int k = 0; k < 32; ++k) X[PADI(gi * 32 + k)] = x[k];
        }
        __syncthreads();
        hy::fft_inv_upper<LOGN, LOGTOT>(X);
        if constexpr (lat) {
            const int c = c0;
#pragma unroll
            for (int kk = 0; kk < 2; ++kk) {
                const int i = 8 * tid + 4096 * kk;
                if (o == 0) {
                    const bf16_t* vp = zct + ((size_t)(2048 + c) * NB) * TPB + pos0; const bf16_t* x1p = zct + ((size_t)c * NB) * TPB + pos0;
                    const float bias0 = p->in[21][(size_t)e * 2048 + c];
                    float v0[8], v1[8], g0[8], g1[8];
                    unpack8(*(const u32x4*)(vp + i), v0); unpack8(*(const u32x4*)(vp + TPB + i), v1); unpack8(*(const u32x4*)(x1p + i), g0); unpack8(*(const u32x4*)(x1p + TPB + i), g1);
#pragma unroll
                    for (int q = 0; q < 8; ++q) {
                        const cf2 cv = X[PADI(i + q)];
                        const float y0 = g0[q] * (cv.x + v0[q] * bias0), y1 = g1[q] * (cv.y + v1[q] * bias0);
                        Y1[i + q] = mk2(y0, y1);
                        X[PADI(i + q)] = mk2(y0, y1); X[PADI(L + i + q)] = mk2(0.f, 0.f);
                    }
                } else {
                    const bf16_t* x2p = zct + ((size_t)(1024 + c) * NB) * TPB + pos0;
                    const float bias1 = p->in[21][(size_t)e * 2048 + 1024 + c];
                    float g0[8], g1[8], o0[8], o1[8];
                    unpack8(*(const u32x4*)(x2p + i), g0); unpack8(*(const u32x4*)(x2p + TPB + i), g1);
                    f32x4 yv[4];
#pragma unroll
                    for (int q = 0; q < 4; ++q) yv[q] = *(const f32x4*)(Y1 + i + 2 * q);
#pragma unroll
                    for (int q = 0; q < 8; ++q) {
                        const cf2 cv = X[PADI(i + q)];
                        o0[q] = g0[q] * (cv.x + yv[q >> 1][(q & 1) * 2] * bias1); o1[q] = g1[q] * (cv.y + yv[q >> 1][(q & 1) * 2 + 1] * bias1);
                    }
                    __builtin_nontemporal_store(pack8(o0), (u32x4*)(yt + ((size_t)c * NB + 0) * TPB + pos0 + i));
                    __builtin_nontemporal_store(pack8(o1), (u32x4*)(yt + ((size_t)c * NB + 1) * TPB + pos0 + i));
                }
            }
        } else
        for (int g = tid; g < NCH * L; g += NTHREADS) {
            const int ch = g >> LOGL, i = g & (L - 1), c = c0 + ch;
            const cf2 cv = X[PADI(ch * N + i)];
            if (o == 0) {
                const bf16_t* vp = zct + ((size_t)(2048 + c) * NB) * TPB + pos0; const bf16_t* x1p = zct + ((size_t)c * NB) * TPB + pos0;
                const float bias0 = p->in[21][(size_t)e * 2048 + c];
                const float y0 = bf2f(x1p[i]) * (cv.x + bf2f(vp[i]) * bias0), y1 = bf2f(x1p[TPB + i]) * (cv.y + bf2f(vp[TPB + i]) * bias0);
                Y1[g] = mk2(y0, y1);
                X[PADI(ch * N + i)] = mk2(y0, y1); X[PADI(ch * N + L + i)] = mk2(0.f, 0.f);
            } else {
                const bf16_t* x2p = zct + ((size_t)(1024 + c) * NB) * TPB + pos0;
                const float bias1 = p->in[21][(size_t)e * 2048 + 1024 + c];
                const cf2 y1v = Y1[g];
                const float y0 = bf2f(x2p[i]) * (cv.x + y1v.x * bias1), y1 = bf2f(x2p[TPB + i]) * (cv.y + y1v.y * bias1);
                yt[((size_t)c * NB + 0) * TPB + pos0 + i] = f2bf(y0);
                yt[((size_t)c * NB + 1) * TPB + pos0 + i] = f2bf(y1);
            }
        }
        __syncthreads();
    }
}

PHASE_FN void ph_hyena(KP p, int e, LAS unsigned char* lds) {
    p = launder_kp(p);
    cf2* scr = (cf2*)(p->ws + WS_Z + (size_t)BID * FFT_SCR_PER_BLOCK);
    for (int u = BID; u < 1024 + 128; u += NBLK) {
        if (u < 1024) hyena_unit<1, 13>(p, e, u, lds, scr);
        else hyena_unit<8, 8>(p, e, (u - 1024) * 8, lds, scr);
    }
}

__device__ __forceinline__ int s5_pos(int d, int pi) { return d == 0 ? pi : (pi < CTXL ? CTXL - 1 - pi : (TPB + CTXL - 1) - pi); }

__device__ __forceinline__ void s5_bu(const bf16x8 ua, const bf16x8 (&bf)[4], float (&bre)[32], float (&bim)[32]) {
    const f32x16 z = {};
    f32x16 t0 = __builtin_amdgcn_mfma_f32_32x32x16_bf16(ua, bf[0], z, 0, 0, 0);
    f32x16 t1 = __builtin_amdgcn_mfma_f32_32x32x16_bf16(ua, bf[1], z, 0, 0, 0);
    f32x16 t2 = __builtin_amdgcn_mfma_f32_32x32x16_bf16(ua, bf[2], z, 0, 0, 0);
    f32x16 t3 = __builtin_amdgcn_mfma_f32_32x32x16_bf16(ua, bf[3], z, 0, 0, 0);
#pragma unroll
    for (int r = 0; r < 16; ++r) {
        const auto sr = __builtin_amdgcn_permlane32_swap(__float_as_uint(t0[r]), __float_as_uint(t1[r]), false, false);
        const auto si = __builtin_amdgcn_permlane32_swap(__float_as_uint(t2[r]), __float_as_uint(t3[r]), false, false);
        const int m0 = (r & 3) + 8 * (r >> 2);
        bre[m0] = __uint_as_float(sr[0]); bre[m0 + 4] = __uint_as_float(sr[1]);
        bim[m0] = __uint_as_float(si[0]); bim[m0 + 4] = __uint_as_float(si[1]);
    }
}

PHASE_FN void ph_s5_pass1(KP p, int il) {
    p = launder_kp(p);
    const int lane = TID & 63, wid = TID >> 6;
    const bf16_t* xin = (const bf16_t*)(p->ws + WS_XIN);
    const cf2* abar = (const cf2*)(p->ws + WS_ABAR); const bf16_t* bfrag = (const bf16_t*)(p->ws + WS_BFRAG);
    cf2* est = (cf2*)(p->ws + WS_EST);
    constexpr int NQ = S5NCH - 1, NU = NB * 128 * 2 * NQ;
    for (int u = BID * NWAVES + wid; u < NU; u += NBLK * NWAVES) {
        const int q = u % NQ, d = (u / NQ) & 1, g = (u / (NQ * 2)) & 127, b = u / (NQ * 2 * 128);
        const int gi = (il * 2 + d) * 128 + g;
        const cf2 a = abar[(size_t)gi * 64 + lane];
        bf16x8 bf[4];
#pragma unroll
        for (int t = 0; t < 4; ++t) bf[t] = *(const bf16x8*)(bfrag + (((size_t)gi * 4 + t) * 64 + lane) * 8);
        float sre = 0.f, sim = 0.f;
        bf16x8 uav[S5T / 32];
#pragma unroll
        for (int st = 0; st < S5T / 32; ++st) {
            const int pos = s5_pos(d, q * S5T + st * 32 + (lane & 31));
            uav[st] = *(const bf16x8*)(xin + ((size_t)g * MROWS + b * TPB + pos) * 16 + (lane >> 5) * 8);
        }
#pragma unroll
        for (int st = 0; st < S5T / 32; ++st) {
            float bre[32], bim[32];
            s5_bu(uav[st], bf, bre, bim);
#pragma unroll
            for (int m = 0; m < 32; ++m) {
                const float nre = __builtin_fmaf(a.x, sre, __builtin_fmaf(-a.y, sim, bre[m])), nim = __builtin_fmaf(a.x, sim, __builtin_fmaf(a.y, sre, bim[m]));
                sre = nre; sim = nim;
            }
        }
        est[(((size_t)(b * 128 + g) * 2 + d) * S5NCH + q) * 64 + lane] = mk2(sre, sim);
    }
}

PHASE_FN void ph_s5_prefix(KP p, int il) {
    p = launder_kp(p);
    const int lane = TID & 63, wid = TID >> 6;
    const cf2* aTt = (const cf2*)(p->ws + WS_AT); const cf2* est = (const cf2*)(p->ws + WS_EST); cf2* sin_ = (cf2*)(p->ws + WS_SIN);
    for (int u = BID * NWAVES + wid; u < NB * 128 * 2; u += NBLK * NWAVES) {
        const int d = u & 1, g = (u >> 1) & 127, b = u >> 8;
        const cf2 aT = aTt[(size_t)((il * 2 + d) * 128 + g) * 64 + lane];
        const size_t base = (((size_t)(b * 128 + g) * 2 + d) * S5NCH) * 64 + lane;
        float sre = 0.f, sim = 0.f;
        sin_[base] = mk2(0.f, 0.f);
#pragma unroll 1
        for (int q0 = 0; q0 < S5NCH - 1; q0 += 13) {
            cf2 ev[13];
#pragma unroll
            for (int k = 0; k < 13; ++k) ev[k] = est[base + (size_t)(q0 + k) * 64];
#pragma unroll
            for (int k = 0; k < 13; ++k) {
                const float nre = __builtin_fmaf(aT.x, sre, __builtin_fmaf(-aT.y, sim, ev[k].x)), nim = __builtin_fmaf(aT.x, sim, __builtin_fmaf(aT.y, sre, ev[k].y));
                sre = nre; sim = nim;
                sin_[base + (size_t)(q0 + k + 1) * 64] = mk2(sre, sim);
            }
        }
    }
}

PHASE_FN void ph_s5_pass2(KP p, int il, LAS unsigned char* lds) {
    p = launder_kp(p);
    const int lane = TID & 63, wid = TID >> 6;
    constexpr int SP = 272;
    LAS unsigned char* Sl = lds + wid * (32 * SP + S5T * 16 * 4);
    LAS float* Yl = (LAS float*)(Sl + 32 * SP);
    const bf16_t* xin = (const bf16_t*)(p->ws + WS_XIN);
    const cf2* abar = (const cf2*)(p->ws + WS_ABAR);
    const bf16_t* bfrag = (const bf16_t*)(p->ws + WS_BFRAG); const bf16_t* cfrag = (const bf16_t*)(p->ws + WS_CFRAG);
    const cf2* sin_ = (const cf2*)(p->ws + WS_SIN);
    bf16_t* gout = (bf16_t*)(p->ws + WS_CAT);
    const float* dsk = p->in[34] + (size_t)il * DM;
    constexpr int NU = NB * 128 * S5NCH;
    for (int u = BID * NWAVES + wid; u < NU; u += NBLK * NWAVES) {
        const int v = u >> 3, j = v % S5NCH, g = (((v / S5NCH) & 15) << 3) | (u & 7), b = v / (S5NCH * 16);
        if (il == 1 && j < CTXL / S5T) continue;
        const int pos0 = j * S5T;
#pragma unroll 1
        for (int d = 0; d < 2; ++d) {
            const int q = d == 0 ? j : (j < 2 ? 1 - j : (S5NCH + 1) - j);
            const int gi = (il * 2 + d) * 128 + g;
            const cf2 a = abar[(size_t)gi * 64 + lane];
            bf16x8 bf[4], cf[4];
#pragma unroll
            for (int t = 0; t < 4; ++t) { bf[t] = *(const bf16x8*)(bfrag + (((size_t)gi * 4 + t) * 64 + lane) * 8); cf[t] = *(const bf16x8*)(cfrag + (((size_t)gi * 4 + t) * 64 + lane) * 8); }
            const cf2 sv = sin_[(((size_t)(b * 128 + g) * 2 + d) * S5NCH + q) * 64 + lane];
            float sre = sv.x, sim = sv.y;
            bf16x8 uav[S5T / 32];
#pragma unroll
            for (int st = 0; st < S5T / 32; ++st) {
                const int pos = s5_pos(d, q * S5T + st * 32 + (lane & 31));
                uav[st] = *(const bf16x8*)(xin + ((size_t)g * MROWS + b * TPB + pos) * 16 + (lane >> 5) * 8);
            }
#pragma unroll
            for (int st = 0; st < S5T / 32; ++st) {
                const int pi0 = q * S5T + st * 32;
                const bf16x8 ua = uav[st];
                float bre[32], bim[32];
                s5_bu(ua, bf, bre, bim);
#pragma unroll
                for (int m = 0; m < 32; ++m) {
                    const float nre = __builtin_fmaf(a.x, sre, __builtin_fmaf(-a.y, sim, bre[m])), nim = __builtin_fmaf(a.x, sim, __builtin_fmaf(a.y, sre, bim[m]));
                    sre = nre; sim = nim;
                    *(LAS unsigned*)(Sl + m * SP + lane * 4) = cvt_pk(sre, sim);
                }
#pragma unroll
                for (int mt = 0; mt < 2; ++mt) {
                    f32x4 acc = {0.f, 0.f, 0.f, 0.f};
#pragma unroll
                    for (int ks = 0; ks < 4; ++ks) {
                        const bf16x8 sb = *(const LAS bf16x8*)(Sl + (mt * 16 + (lane & 15)) * SP + ks * 64 + (lane >> 4) * 16);
                        acc = __builtin_amdgcn_mfma_f32_16x16x32_bf16(cf[ks], sb, acc, 0, 0, 0);
                    }
                    const int tl = s5_pos(d, pi0 + mt * 16 + (lane & 15)) - pos0;
                    LAS f32x4* yp = (LAS f32x4*)(Yl + tl * 16 + 4 * (lane >> 4));
                    if (d == 0) *yp = acc; else { const f32x4 o = *yp; *yp = o + acc; }
                }
            }
        }
#pragma unroll
        for (int hrow = 0; hrow < 2; ++hrow) {
            const int tl = lane + 64 * hrow;
            const size_t ro = ((size_t)(b * TPB + pos0 + tl)) * DM + g * 16;
            const size_t ri = ((size_t)g * MROWS + b * TPB + pos0 + tl) * 16;
            float uu[16];
            { float f[8]; unpack8(*(const u32x4*)(xin + ri), f); for (int k = 0; k < 8; ++k) uu[k] = f[k]; unpack8(*(const u32x4*)(xin + ri + 8), f); for (int k = 0; k < 8; ++k) uu[8 + k] = f[k]; }
            float o[16];
#pragma unroll
            for (int c4 = 0; c4 < 4; ++c4) {
                const f32x4 yv = *(const LAS f32x4*)(Yl + tl * 16 + c4 * 4);
#pragma unroll
                for (int k = 0; k < 4; ++k) o[c4 * 4 + k] = gelu_tanh(yv[k] + dsk[g * 16 + c4 * 4 + k] * uu[c4 * 4 + k]);
            }
            float o0[8], o1[8];
#pragma unroll
            for (int k = 0; k < 8; ++k) { o0[k] = o[k]; o1[k] = o[8 + k]; }
            *(u32x4*)(gout + ro) = pack8(o0); *(u32x4*)(gout + ro + 8) = pack8(o1);
        }
    }
}

__device__ __forceinline__ unsigned fkey(float v) { const unsigned u = __float_as_uint(v); return (u & 0x80000000u) ? ~u : (u | 0x80000000u); }
__device__ __forceinline__ float keyf(unsigned k) { return __uint_as_float((k & 0x80000000u) ? (k & 0x7fffffffu) : ~k); }
#define TOPK_INSERT(list, key) do { unsigned k_ = (key); _Pragma("unroll") for (int q_ = 0; q_ < 16; ++q_) { const unsigned hi_ = max(list[q_], k_); k_ = min(list[q_], k_); list[q_] = hi_; } } while (0)
#define TOPK_SORT16(v) do { _Pragma("unroll") for (int k_ = 2; k_ <= 16; k_ <<= 1) _Pragma("unroll") for (int j_ = k_ >> 1; j_ >= 1; j_ >>= 1) _Pragma("unroll") for (int i_ = 0; i_ < 16; ++i_) { \
        const int l_ = i_ ^ j_; if (l_ > i_) { const unsigned a_ = v[i_], b_ = v[l_]; const bool desc_ = ((i_ & k_) == 0); v[i_] = desc_ ? max(a_, b_) : min(a_, b_); v[l_] = desc_ ? min(a_, b_) : max(a_, b_); } } } while (0)
#define TOPK_TOPMERGE(a, b) do { _Pragma("unroll") for (int q_ = 0; q_ < 16; ++q_) a[q_] = max(a[q_], b[15 - q_]); \
        _Pragma("unroll") for (int st_ = 8; st_ >= 1; st_ >>= 1) _Pragma("unroll") for (int i_ = 0; i_ < 16; ++i_) if ((i_ & st_) == 0) { const unsigned x_ = a[i_], y_ = a[i_ + st_]; a[i_] = max(x_, y_); a[i_ + st_] = min(x_, y_); } } while (0)
#define TOPK_MERGE(list, XM) do { unsigned o_[16]; _Pragma("unroll") for (int q_ = 0; q_ < 16; ++q_) o_[q_] = (unsigned)__builtin_amdgcn_ds_bpermute((lane ^ (XM)) << 2, (int)list[15 - q_]); \
        _Pragma("unroll") for (int q_ = 0; q_ < 16; ++q_) list[q_] = max(list[q_], o_[q_]); \
        _Pragma("unroll") for (int st_ = 8; st_ >= 1; st_ >>= 1) _Pragma("unroll") for (int i_ = 0; i_ < 16; ++i_) if ((i_ & st_) == 0) { const unsigned a_ = list[i_], b_ = list[i_ + st_]; list[i_] = max(a_, b_); list[i_ + st_] = min(a_, b_); } } while (0)
PHASE_FN void ph_peer_topk(KP p, int layer, LAS unsigned char* lds) {
    p = launder_kp(p);
    const int tid = TID, lane = tid & 63, wid = tid >> 6, t = lane & 15, kq = lane >> 4;
    const bf16_t* pq = (const bf16_t*)(p->ws + WS_PQ);
    const bf16_t* keys = (const bf16_t*)(p->ws + WS_KEYS) + (size_t)layer * 8 * 2 * 128 * 128;
    int* pidx = (int*)(p->ws + WS_PIDX); float* pgate = (float*)(p->ws + WS_PGATE);
    constexpr int KP_ = 272;
    LAS unsigned char* kl = lds + 16384;
    {
        const bf16_t* ksrc = keys + ((size_t)((BID & 7) * 2) * 128) * 128;
#pragma unroll
        for (int q8 = 0; q8 < 8; ++q8) { const int c16 = tid + q8 * NTHREADS, row = c16 >> 4, cb = (c16 & 15) * 16;
            *(LAS u32x4*)(kl + row * KP_ + cb) = *(const u32x4*)((const unsigned char*)ksrc + (size_t)c16 * 16); }
    }
    __syncthreads();
    for (int bu = BID; bu < (MROWS / 128) * 8; bu += NBLK) {
        if (layer == 3 && ((bu >> 3) % (TPB / 128)) < CTXL / 128) continue;
        const int h = bu & 7, t0 = (bu >> 3) * 128 + wid * 16;
        const bf16_t* qb0 = pq + (size_t)(t0 + t) * DM + h * 256 + kq * 8;
        const LAS unsigned char* kb0 = kl + t * KP_ + kq * 16;
        unsigned lsA[16], lsB[16];
#pragma unroll 1
        for (int s = 0; s < 2; ++s) {
            bf16x8 qf[4];
#pragma unroll
            for (int ks = 0; ks < 4; ++ks) qf[ks] = *(const bf16x8*)(qb0 + s * 128 + ks * 32);
            unsigned lst[16], l2[16];
#pragma unroll 1
            for (int nb4 = 0; nb4 < 2; ++nb4) {
                bf16x8 kf[4][4];
#pragma unroll
                for (int n4 = 0; n4 < 4; ++n4)
#pragma unroll
                    for (int ks = 0; ks < 4; ++ks) kf[n4][ks] = *(const LAS bf16x8*)(kb0 + (s * 128 + (nb4 * 4 + n4) * 16) * KP_ + ks * 64);
#pragma unroll
                for (int n4 = 0; n4 < 4; ++n4) {
                    f32x4 acc = {0.f, 0.f, 0.f, 0.f};
#pragma unroll
                    for (int ks = 0; ks < 4; ++ks) acc = __builtin_amdgcn_mfma_f32_16x16x32_bf16(kf[n4][ks], qf[ks], acc, 0, 0, 0);
#pragma unroll
                    for (int r = 0; r < 4; ++r) { const unsigned key = (fkey(acc[r]) & ~0x7Fu) | (unsigned)(127 - ((nb4 * 4 + n4) * 16 + 4 * kq + r));
                        if (nb4 == 0) lst[n4 * 4 + r] = key; else l2[n4 * 4 + r] = key; }
                }
            }
            TOPK_SORT16(lst); TOPK_SORT16(l2); TOPK_TOPMERGE(lst, l2);
            TOPK_MERGE(lst, 16); TOPK_MERGE(lst, 32);
            if (s == 0) {
#pragma unroll
                for (int k = 0; k < 16; ++k) lsA[k] = lst[k];
            } else {
#pragma unroll
                for (int k = 0; k < 16; ++k) lsB[k] = lst[k];
            }
        }
        float vb[16];
#pragma unroll
        for (int k = 0; k < 16; ++k) vb[k] = keyf(lsB[k] & ~0x7Fu);
        unsigned cl[16];
        {
            const unsigned ka = kq == 0 ? lsA[0] : (kq == 1 ? lsA[1] : (kq == 2 ? lsA[2] : lsA[3]));
            const float va = keyf(ka & ~0x7Fu);
#pragma unroll
            for (int j = 0; j < 16; ++j) cl[j] = ((kq + 1) * (j + 1) <= 16) ? ((fkey(va + vb[j]) & ~0xFFu) | (unsigned)(255 - (kq * 16 + j))) : 0u;
        }
#pragma unroll
        for (int a4 = 1; a4 < 4; ++a4) {
            const unsigned ka = kq == 0 ? lsA[4 * a4] : (kq == 1 ? lsA[4 * a4 + 1] : (kq == 2 ? lsA[4 * a4 + 2] : lsA[4 * a4 + 3]));
            const float va = keyf(ka & ~0x7Fu);
            const int i = kq + 4 * a4;
            constexpr int JMAXT[4] = {16, 3, 1, 1};
#pragma unroll
            for (int j = 0; j < JMAXT[a4]; ++j) {
                const unsigned key = ((i + 1) * (j + 1) <= 16) ? ((fkey(va + vb[j]) & ~0xFFu) | (unsigned)(255 - (i * 16 + j))) : 0u;
                TOPK_INSERT(cl, key);
            }
        }
        TOPK_MERGE(cl, 16); TOPK_MERGE(cl, 32);
        LAS unsigned* tab = (LAS unsigned*)lds + wid * 512;
        if (kq == 0) {
#pragma unroll
            for (int k = 0; k < 16; ++k) { tab[(t * 2) * 16 + k] = lsA[k]; tab[(t * 2 + 1) * 16 + k] = lsB[k]; }
        }
        if (kq == 0) {
            const float mx = keyf(cl[0] & ~0xFFu);
            float ev[16], ssum = 0.f; int ci[16];
#pragma unroll
            for (int k = 0; k < 16; ++k) {
                ev[k] = __expf(keyf(cl[k] & ~0xFFu) - mx); ssum += ev[k];
                const int flat = 255 - (int)(cl[k] & 0xFFu);
                ci[k] = (127 - (int)(tab[(t * 2) * 16 + (flat >> 4)] & 0x7Fu)) * 128 + (127 - (int)(tab[(t * 2 + 1) * 16 + (flat & 15)] & 0x7Fu));
            }
            const float rs = 1.0f / ssum;
            const size_t ob = (size_t)(t0 + t) * 128 + h * 16;
#pragma unroll
            for (int k4 = 0; k4 < 4; ++k4) {
                *(int4*)(pidx + ob + k4 * 4) = make_int4(ci[k4 * 4], ci[k4 * 4 + 1], ci[k4 * 4 + 2], ci[k4 * 4 + 3]);
                *(f32x4*)(pgate + ob + k4 * 4) = (f32x4){ev[k4 * 4] * rs, ev[k4 * 4 + 1] * rs, ev[k4 * 4 + 2] * rs, ev[k4 * 4 + 3] * rs};
            }
        }
    }
}

template <int CTRL> __device__ __forceinline__ float dppf_add(float v) { return v + dppf<CTRL>(v); }
#define PG_ITEM(it) const int rsel_ = (it) >= ntw ? 1 : 0; const int tl_ = ts * tok_per + wid + 8 * ((it) - rsel_ * ntw); const int tok_ = layer == 3 ? tl_ + CTXL + (tl_ >= SEQ ? CTXL : 0) : tl_; const int range_ = cls + 8 * rsel_
#define PG_IDX(id, it, hf) do { PG_ITEM(it); const int* q_ = pidx + (size_t)tok_ * 128 + g * 16 + (hf) * 8; const int4 a_ = *(const int4*)q_, b_ = *(const int4*)(q_ + 4); \
        id[0] = a_.x; id[1] = a_.y; id[2] = a_.z; id[3] = a_.w; id[4] = b_.x; id[5] = b_.y; id[6] = b_.z; id[7] = b_.w; (void)range_; } while (0)
PHASE_FN void ph_peer_g1(KP p, int layer, LAS unsigned char* lds) {
    p = launder_kp(p);
    const int lane = TID & 63, wid = __builtin_amdgcn_readfirstlane(TID >> 6), g = lane >> 3, j = lane & 7, fm = lane & 15, kg = lane >> 4;
    const unsigned char* pu = p->ws + WS_PU + (size_t)layer * 16384 * 2048;
    const int* pidx = (const int*)(p->ws + WS_PIDX);
    const unsigned char* xq8 = p->ws + WS_XQ8;
    bf16_t* pdot = (bf16_t*)(p->ws + WS_Z);
    const int cls = BID & 7, ts = BID >> 3, nts = (NBLK + 7) >> 3;
    const int ntok = layer == 3 ? NB * SEQ : MROWS, tok_per = (ntok + nts - 1) / nts;
    const int nvalid = min(tok_per, ntok - ts * tok_per), ntw = nvalid > wid ? (nvalid - wid + 7) >> 3 : 0, nit = 2 * ntw;
    LAS unsigned char* buf0 = lds + wid * 18432; LAS unsigned char* buf1 = buf0 + 8192; LAS unsigned char* auxc = buf0 + 16384; LAS unsigned char* auxn = auxc + 1024;
#define G1_DMA(bufp, id, it) do { PG_ITEM(it); (void)tok_; const unsigned char* rb_ = pu + (size_t)range_ * (16384 * 128); \
        _Pragma("unroll") for (int i = 0; i < 8; ++i) { const int sw_ = (i & 1) * 4 + (g >> 1); \
            __builtin_amdgcn_global_load_lds((const unsigned*)(rb_ + (((unsigned)id[(i & 1) * 4 + (i >> 1)] << 7) + (unsigned)((j ^ sw_) << 4))), (LAS unsigned*)(bufp + i * 1024), 16, 0, 0); } } while (0)
#define G1_AUX(auxp, it) do { PG_ITEM(it); const unsigned char* s_ = lane < 32 ? (const unsigned char*)(pidx + (size_t)tok_ * 128) + lane * 16 : xq8 + (size_t)tok_ * DM + range_ * 128 + (lane & 7) * 16; \
        __builtin_amdgcn_global_load_lds((const unsigned*)s_, (LAS unsigned*)(auxp), 16, 0, 0); } while (0)
#define G1_IDS(id, auxp, hf) do { const u32x4 a_ = *(const LAS u32x4*)(auxp + (g * 16 + (hf) * 8) * 4), b_ = *(const LAS u32x4*)(auxp + (g * 16 + (hf) * 8 + 4) * 4); \
        id[0] = (int)a_.x; id[1] = (int)a_.y; id[2] = (int)a_.z; id[3] = (int)a_.w; id[4] = (int)b_.x; id[5] = (int)b_.y; id[6] = (int)b_.z; id[7] = (int)b_.w; } while (0)
#define G1_X(xv, auxp) do { _Pragma("unroll") for (int t = 0; t < 4; ++t) xv[t] = *(const LAS long*)(auxp + 512 + t * 32 + kg * 8); } while (0)
#define G1_COMP(bufp, hf, it, xv) do { f32x4 acc_[4]; \
        _Pragma("unroll") for (int mt = 0; mt < 4; ++mt) { acc_[mt] = (f32x4){0.f, 0.f, 0.f, 0.f}; \
            _Pragma("unroll") for (int t = 0; t < 4; ++t) { const int pos_ = (2 * t + (kg >> 1)) ^ ((fm >> 1) & 7); \
                const long a_ = *(const LAS long*)(bufp + (mt * 16 + fm) * 128 + pos_ * 16 + (kg & 1) * 8); \
                acc_[mt] = __builtin_amdgcn_mfma_f32_16x16x32_fp8_fp8(a_, xv[t], acc_[mt], 0, 0, 0); } } \
        const int r_ = fm & 3; float v_[4]; \
        _Pragma("unroll") for (int mt = 0; mt < 4; ++mt) v_[mt] = r_ == 0 ? acc_[mt][0] : r_ == 1 ? acc_[mt][1] : r_ == 2 ? acc_[mt][2] : acc_[mt][3]; \
        if (fm < 4) { PG_ITEM(it); const int s0_ = (4 * (kg & 1) + r_) * 16 + (hf) * 8 + (kg >> 1) * 4; u32x2 w_; w_.x = cvt_pk(v_[0], v_[1]); w_.y = cvt_pk(v_[2], v_[3]); \
            asm volatile("global_store_dwordx2 %0, %1, off" :: "v"(pdot + ((size_t)range_ * MROWS + tok_) * 128 + s0_), "v"(w_) : "memory"); } } while (0)
#define G1_WAITV(n) asm volatile("s_waitcnt vmcnt(" #n ")" ::: "memory")
#define G1_WAITL() asm volatile("s_waitcnt lgkmcnt(0)" ::: "memory")
    if (nit > 0) {
        int idA[8], idB[8]; long xb[4];
        G1_AUX(auxc, 0); G1_WAITV(0); G1_IDS(idA, auxc, 0); G1_WAITL();
        G1_AUX(auxn, (nit > 1 ? 1 : 0)); G1_DMA(buf0, idA, 0);
#pragma unroll 1
        for (int n = 0; n < nit; ++n) {
            const int n1 = n + 1 < nit ? n + 1 : nit - 1, n2 = n + 2 < nit ? n + 2 : nit - 1;
            G1_IDS(idB, auxc, 1); G1_WAITL();
            G1_DMA(buf1, idB, n);
            G1_WAITV(8);
            G1_X(xb, auxc);
            G1_COMP(buf0, 0, n, xb);
            G1_IDS(idA, auxn, 0); G1_WAITL();
            G1_AUX(auxc, n2);
            G1_DMA(buf0, idA, n1);
            G1_WAITV(9);
            G1_COMP(buf1, 1, n, xb);
            G1_WAITL();
            { LAS unsigned char* t_ = auxc; auxc = auxn; auxn = t_; }
        }
        G1_WAITV(0);
    }
#undef G1_DMA
#undef G1_AUX
#undef G1_IDS
#undef G1_X
#undef G1_COMP
#undef G1_WAITV
#undef G1_WAITL
}
constexpr int PCREC = 272;
PHASE_FN void ph_peer_g1b(KP p, int layer) {
    p = launder_kp(p);
    const int lane = TID & 63, wid = TID >> 6;
    const bf16_t* pdot = (const bf16_t*)(p->ws + WS_Z);
    const int* pidx = (const int*)(p->ws + WS_PIDX); const float* pgate = (const float*)(p->ws + WS_PGATE);
    const float* pus = (const float*)(p->ws + WS_PUS) + (size_t)layer * 16384; const float* pvs = (const float*)(p->ws + WS_PVS) + (size_t)layer * 16384;
    unsigned char* prec = p->ws + WS_PCOEF; const float* xs = (const float*)(p->ws + WS_XS);
    constexpr int TB = 4;
    const int ntok = layer == 3 ? NB * SEQ : MROWS;
#define G1B_ROW(tl) (layer == 3 ? (tl) + CTXL + ((tl) >= SEQ ? CTXL : 0) : (tl))
    for (int t0 = BID * NWAVES + wid; t0 < ntok; t0 += TB * NBLK * NWAVES) {
        unsigned w[TB][16]; int2 id[TB]; f32x2v gt[TB]; float xsc[TB];
#pragma unroll
        for (int u = 0; u < TB; ++u) {
            const int tok = G1B_ROW(min(t0 + u * NBLK * NWAVES, ntok - 1));
#pragma unroll
            for (int r = 0; r < 16; ++r) w[u][r] = __builtin_nontemporal_load((const unsigned*)(pdot + ((size_t)r * MROWS + tok) * 128 + 2 * lane));
            id[u] = *(const int2*)(pidx + (size_t)tok * 128 + 2 * lane);
            gt[u] = *(const f32x2v*)(pgate + (size_t)tok * 128 + 2 * lane);
            xsc[u] = xs[tok];
        }
        float us0[TB], us1[TB], vs0[TB], vs1[TB];
#pragma unroll
        for (int u = 0; u < TB; ++u) { us0[u] = pus[id[u].x]; us1[u] = pus[id[u].y]; vs0[u] = pvs[id[u].x]; vs1[u] = pvs[id[u].y]; }
#pragma unroll
        for (int u = 0; u < TB; ++u) {
            const int tl = t0 + u * NBLK * NWAVES, tok = G1B_ROW(tl);
            float s0 = 0.f, s1 = 0.f;
#pragma unroll
            for (int r = 0; r < 16; ++r) { s0 += bflo(w[u][r]); s1 += bfhi(w[u][r]); }
            f32x2v cf; cf.x = gt[u].x * gelu_tanh(s0 * xsc[u] * us0[u]) * vs0[u]; cf.y = gt[u].y * gelu_tanh(s1 * xsc[u] * us1[u]) * vs1[u];
            const float am = wave_max(fmaxf(fabsf(cf.x), fabsf(cf.y)));
            const float sc = am > 0.f ? am * (1.0f / 224.0f) : 1.0f, inv = 1.0f / sc;
            const float c0 = cf.x * inv, c1 = cf.y * inv;
            const int hi = __builtin_amdgcn_cvt_pk_fp8_f32(c0, c1, 0, false);
            const f32x2v hd = __builtin_amdgcn_cvt_pk_f32_fp8(hi, false);
            const int lo = __builtin_amdgcn_cvt_pk_fp8_f32((c0 - hd.x) * 16.0f, (c1 - hd.y) * 16.0f, 0, false);
            if (tl < ntok) {
                unsigned char* rec = prec + (size_t)tok * PCREC;
                *(unsigned short*)(rec + 2 * lane) = (unsigned short)hi; *(unsigned short*)(rec + 128 + 2 * lane) = (unsigned short)lo;
                if (lane == 0) *(float*)(rec + 256) = sc;
            }
        }
    }
}
#undef G1B_ROW
PHASE_FN void ph_peer_g2(KP p, int layer, LAS unsigned char* lds) {
    p = launder_kp(p);
    const int lane = TID & 63, wid = __builtin_amdgcn_readfirstlane(TID >> 6), g = lane >> 3, j = lane & 7, fm = lane & 15, kg = lane >> 4;
    const unsigned char* pv = p->ws + WS_PV + (size_t)layer * 16384 * 2048;
    const int* pidx = (const int*)(p->ws + WS_PIDX); const unsigned char* prec = p->ws + WS_PCOEF;
    bf16_t* fo = (bf16_t*)(p->ws + WS_YMIX);
    const int cls = BID & 7, ts = BID >> 3, nts = (NBLK + 7) >> 3;
    const int ntok = layer == 3 ? NB * SEQ : MROWS, tok_per = (ntok + nts - 1) / nts;
    const int nvalid = min(tok_per, ntok - ts * tok_per), ntw = nvalid > wid ? (nvalid - wid + 7) >> 3 : 0, nit = 2 * ntw;
    LAS unsigned char* buf0 = lds + wid * 18432; LAS unsigned char* buf1 = buf0 + 8192; LAS unsigned char* auxc = buf0 + 16384; LAS unsigned char* auxn = auxc + 1024;
#define G2_DMA(bufp, id, it) do { PG_ITEM(it); (void)tok_; const unsigned char* rb_ = pv + (size_t)range_ * (16384 * 128); \
        _Pragma("unroll") for (int i = 0; i < 8; ++i) { const int sw_ = (i & 1) * 4 + (g >> 1); \
            __builtin_amdgcn_global_load_lds((const unsigned*)(rb_ + (((unsigned)id[i] << 7) + (unsigned)((j ^ sw_) << 4))), (LAS unsigned*)(bufp + i * 1024), 16, 0, 0); } } while (0)
#define G2_AUX(auxp, it) do { PG_ITEM(it); (void)range_; const unsigned char* s_ = lane < 32 ? (const unsigned char*)(pidx + (size_t)tok_ * 128) + lane * 16 : prec + (size_t)tok_ * PCREC + min(lane - 32, 16) * 16; \
        __builtin_amdgcn_global_load_lds((const unsigned*)s_, (LAS unsigned*)(auxp), 16, 0, 0); } while (0)
#define G2_IDS(id, auxp, hf) do { _Pragma("unroll") for (int i = 0; i < 8; ++i) id[i] = *(const LAS int*)(auxp + ((hf) * 64 + i * 8 + g) * 4); } while (0)
    int va[8];
    { const int rb_ = (int)(uintptr_t)(lds + wid * 18432) + (kg * 8 + (fm >> 1)) * 128 + (fm & 1) * 8; const int sw_ = (kg & 1) * 4 + (fm >> 2);
#pragma unroll
      for (int ct = 0; ct < 8; ++ct) va[ct] = rb_ + ((ct ^ sw_) << 4); }
#define G2_TR(dst, ct, off) asm volatile("ds_read_b64_tr_b8 %0, %1 offset:%2" : "=&v"(dst) : "v"(va[ct]), "i"(off) : "memory")
#define G2_COMP(bo, hf) do { long b_[16]; \
        _Pragma("unroll") for (int ct = 0; ct < 8; ++ct) { G2_TR(b_[ct], ct, (bo)); G2_TR(b_[8 + ct], ct, (bo) + 4096); } \
        asm volatile("s_waitcnt lgkmcnt(0)" ::: "memory"); __builtin_amdgcn_sched_barrier(0); \
        _Pragma("unroll") for (int ct = 0; ct < 8; ++ct) { acc[ct] = __builtin_amdgcn_mfma_f32_16x16x32_fp8_fp8(av[(hf) * 2], b_[ct], acc[ct], 0, 0, 0); \
            acc[ct] = __builtin_amdgcn_mfma_f32_16x16x32_fp8_fp8(av[(hf) * 2 + 1], b_[8 + ct], acc[ct], 0, 0, 0); } } while (0)
#define G2_WAITV(n) asm volatile("s_waitcnt vmcnt(" #n ")" ::: "memory")
#define G2_WAITL() asm volatile("s_waitcnt lgkmcnt(0)" ::: "memory")
    if (nit > 0) {
        int idA[8], idB[8]; long av[4];
        G2_AUX(auxc, 0); G2_WAITV(0); G2_IDS(idA, auxc, 0); G2_WAITL();
        G2_AUX(auxn, (nit > 1 ? 1 : 0)); G2_DMA(buf0, idA, 0);
#pragma unroll 1
        for (int n = 0; n < nit; ++n) {
            const int n1 = n + 1 < nit ? n + 1 : nit - 1, n2 = n + 2 < nit ? n + 2 : nit - 1;
            f32x4 acc[8];
#pragma unroll
            for (int ct = 0; ct < 8; ++ct) acc[ct] = (f32x4){0.f, 0.f, 0.f, 0.f};
            G2_IDS(idB, auxc, 1);
#pragma unroll
            for (int q = 0; q < 4; ++q) { const long a_ = *(const LAS long*)(auxc + 512 + (fm & 1) * 128 + q * 32 + kg * 8); av[q] = (fm & 2) ? 0l : a_; }
            const float scl = *(const LAS float*)(auxc + 768);
            G2_WAITL();
            G2_DMA(buf1, idB, n);
            G2_WAITV(8);
            G2_COMP(0, 0);
            G2_IDS(idA, auxn, 0); G2_WAITL();
            G2_AUX(auxc, n2);
            G2_DMA(buf0, idA, n1);
            G2_WAITV(9);
            G2_COMP(8192, 1);
            {
                PG_ITEM(n);
                bf16_t* o_ = fo + (size_t)tok_ * DM + range_ * 128 + kg * 32 + fm;
#pragma unroll
                for (int e = 0; e < 2; ++e) {
                    const float h_ = kg == 0 ? acc[e][0] : kg == 1 ? acc[2 + e][0] : kg == 2 ? acc[4 + e][0] : acc[6 + e][0];
                    const float l_ = kg == 0 ? acc[e][1] : kg == 1 ? acc[2 + e][1] : kg == 2 ? acc[4 + e][1] : acc[6 + e][1];
                    const unsigned w_ = cvt_pk(scl * (h_ + l_ * 0.0625f), 0.f);
                    asm volatile("global_store_short %0, %1, off" :: "v"(o_ + e * 16), "v"(w_) : "memory");
                }
            }
            G2_WAITL();
            { LAS unsigned char* t_ = auxc; auxc = auxn; auxn = t_; }
        }
        G2_WAITV(0);
    }
#undef G2_DMA
#undef G2_AUX
#undef G2_IDS
#undef G2_COMP
#undef G2_TR
#undef G2_WAITV
#undef G2_WAITL
}
PHASE_FN void ph_peer_g3(KP p, int layer) {
    p = launder_kp(p);
    const int lane = TID & 63, wid = TID >> 6;
    float* h = (float*)(p->ws + WS_H); bf16_t* xin = (bf16_t*)(p->ws + WS_XIN);
    const bf16_t* fo = (const bf16_t*)(p->ws + WS_YMIX);
    const float* mvl = (const float*)(p->ws + WS_MVEC) + (size_t)layer * 3 * 12288;
    const float* mvn = (const float*)(p->ws + WS_MVEC) + (size_t)(layer < 3 ? layer + 1 : 3) * 3 * 12288;
    const float* lg = p->in[8] + (size_t)layer * DM; const float* lb = p->in[9] + (size_t)layer * DM;
    const int ntok = layer == 3 ? NB * SEQ : MROWS;
    for (int tl = BID * NWAVES + wid; tl < ntok; tl += NBLK * NWAVES) {
        const int tok = layer == 3 ? tl + CTXL + (tl >= SEQ ? CTXL : 0) : tl;
        const int b = tok / TPB, pos = tok - b * TPB, kind = pos < CTXL ? 2 : b;
        const float* mv = mvl + (size_t)kind * 12288; const float* mn = mvn + (size_t)kind * 12288;
        float x[32]; float s = 0.f;
#pragma unroll
        for (int c = 0; c < 4; ++c) {
            const int col = c * 512 + lane * 8;
            const f32x4 h0 = __builtin_nontemporal_load((const f32x4*)(h + (size_t)tok * DM + col)), h1 = __builtin_nontemporal_load((const f32x4*)(h + (size_t)tok * DM + col + 4));
            float y[8]; unpack8(__builtin_nontemporal_load((const u32x4*)(fo + (size_t)tok * DM + col)), y);
            const f32x4 g0 = *(const f32x4*)(mv + 5 * 2048 + col), g1 = *(const f32x4*)(mv + 5 * 2048 + col + 4);
#pragma unroll
            for (int k = 0; k < 4; ++k) { x[c * 8 + k] = DN_ALPHA * h0[k] + g0[k] * y[k]; x[c * 8 + 4 + k] = DN_ALPHA * h1[k] + g1[k] * y[4 + k]; }
#pragma unroll
            for (int k = 0; k < 8; ++k) s += x[c * 8 + k];
        }
        const float mean = wave_sum(s) * (1.0f / DM);
        float q = 0.f;
#pragma unroll
        for (int k = 0; k < 32; ++k) { x[k] -= mean; q += x[k] * x[k]; }
        const float rstd = rsqrtf(wave_sum(q) * (1.0f / DM) + LN_EPS);
#pragma unroll
        for (int c = 0; c < 4; ++c) {
            const int col = c * 512 + lane * 8;
            float hn[8], xf[8];
#pragma unroll
            for (int k = 0; k < 8; ++k) { hn[k] = x[c * 8 + k] * rstd * lg[col + k] + lb[col + k]; xf[k] = hn[k] * (1.0f + mn[2048 + col + k]) + mn[col + k]; }
            if (layer < 3) {
                __builtin_nontemporal_store((f32x4){hn[0], hn[1], hn[2], hn[3]}, (f32x4*)(h + (size_t)tok * DM + col));
                __builtin_nontemporal_store((f32x4){hn[4], hn[5], hn[6], hn[7]}, (f32x4*)(h + (size_t)tok * DM + col + 4));
                if ((layer & 1) == 0) *(u32x4*)(xin + ((size_t)(col >> 4) * MROWS + tok) * 16 + (col & 8)) = pack8(xf);
                else *(u32x4*)(xin + (size_t)tok * DM + col) = pack8(xf);
            } else if (pos >= CTXL) {
                float* o = p->out + ((size_t)b * SEQ + (pos - CTXL)) * DM + col;
                __builtin_nontemporal_store((f32x4){hn[0], hn[1], hn[2], hn[3]}, (f32x4*)o); __builtin_nontemporal_store((f32x4){hn[4], hn[5], hn[6], hn[7]}, (f32x4*)(o + 4));
            }
        }
    }
}

#ifndef REP_MASK
#define REP_MASK 0
#endif
constexpr int PH_PER_PAIR = 24, N_PHASES = 2 + 2 * PH_PER_PAIR;

PHASE_FN void ph_p0_convert(KP p, LAS unsigned char* lds) {
    p = launder_kp(p);
    for (int e = 0; e < 2; ++e) {
        transpose_cvt(p->in[10] + (size_t)e * 2048 * INW, 2048, INW, (bf16_t*)(p->ws + WS_WIN) + (size_t)e * 4096 * 2048, 4096, lds);
        transpose_cvt(p->in[23] + (size_t)e * 512 * 1536, 512, 1536, (bf16_t*)(p->ws + WS_WUQ) + (size_t)e * 1536 * 512, 1536, lds);
        transpose_cvt(p->in[25] + (size_t)e * 256 * 2048, 256, 2048, (bf16_t*)(p->ws + WS_WUKV) + (size_t)e * 2048 * 256, 2048, lds);
        transpose_cvt(p->in[26] + (size_t)e * 2048 * 2048, 2048, 2048, (bf16_t*)(p->ws + WS_WO) + (size_t)e * 2048 * 2048, 2048, lds);
        transpose_cvt(p->in[35] + (size_t)e * 2048 * 2048, 2048, 2048, (bf16_t*)(p->ws + WS_OD) + (size_t)e * 4096 * 2048, 2048, lds);
        transpose_cvt(p->in[36] + (size_t)e * 2048 * 2048, 2048, 2048, (bf16_t*)(p->ws + WS_OD) + (size_t)e * 4096 * 2048 + (size_t)2048 * 2048, 2048, lds);
    }
    for (int e = 0; e < 2; ++e) transpose_cvt(p->in[19] + (size_t)e * 64 * 4096, 64, 4096, (bf16_t*)(p->ws + WS_W4T) + (size_t)e * 4096 * 64, 4096, lds);
    for (int l = 0; l < 4; ++l)
        transpose_cvt(p->in[37] + (size_t)l * 2048 * 2048, 2048, 2048, (bf16_t*)(p->ws + WS_WQ) + (size_t)l * 2048 * 2048, 2048, lds);
    cvt_bf16(p->in[38], (bf16_t*)(p->ws + WS_KEYS), (size_t)4 * 8 * 2 * 128 * 128);
}
PHASE_FN void ph_gemm_plain(LAS unsigned char* lds, const bf16_t* A, const bf16_t* Bt, bf16_t* C, int N, int K, int ldc, int skip_ctx) {
    EpiBf16G<AddrPlain> E{{C, ldc}};
    run_gemm(lds, A, Bt, MROWS, N, K, E, skip_ctx);
}
PHASE_FN void ph_fill_table(KP p, int layer, int which, int nunits) {
    p = launder_kp(p);
    const int rem = nunits % NBLK, c = BID;
    int wkr, nwkr;
    if (rem == 0) { wkr = c; nwkr = NBLK; } else { if (c < rem) return; wkr = c - rem; nwkr = NBLK - rem; }
    cvt_fp8_rows(p->in[39 + which] + (size_t)layer * 16384 * 2048, p->ws + (which ? WS_PV : WS_PU) + (size_t)layer * 16384 * 2048, (float*)(p->ws + (which ? WS_PVS : WS_PUS)) + (size_t)layer * 16384, 16384, wkr, nwkr);
}
PHASE_FN void ph_gemm_q(LAS unsigned char* lds, const bf16_t* A, const bf16_t* Bt, bf16_t* Q) {
    EpiQ E{Q};
    run_gemm(lds, A, Bt, MROWS, 1536, QRANK, E);
}
PHASE_FN void ph_gemm_kv(LAS unsigned char* lds, const bf16_t* A, const bf16_t* Bt, bf16_t* K, bf16_t* V) {
    EpiKV E{K, V};
    run_gemm(lds, A, Bt, MROWS, 2048, KVRANK, E);
}

__global__ void __launch_bounds__(NTHREADS, 2) hybrid_fwd(Params pv) {
    extern __shared__ __attribute__((aligned(16))) unsigned char lds_raw[];
    LAS unsigned char* lds = (LAS unsigned char*)lds_raw;
    KP p = (KP)__builtin_amdgcn_kernarg_segment_ptr();
    volatile LAS unsigned* xbw = (volatile LAS unsigned*)(lds + LDS_BYTES - 64);
    if (threadIdx.x < 4) xbw[threadIdx.x] = 0u;
    __syncthreads();
    const int lo = pv.ph_lo, hi = pv.ph_hi;
    unsigned char* ws = pv.ws;
    XcdBarrier bar; bar.bar = (unsigned*)(ws + WS_CTL); bar.x = 0; bar.st = xbw;
    if (hi - lo > 1) bar = xcd_barrier_post((unsigned*)(ws + WS_CTL), xbw);
#define IN(k) (lo <= (k) && (k) < hi)
#define RUN(bit, ...) do { __VA_ARGS__; if (REP_MASK & (1 << (bit))) { __syncthreads(); __VA_ARGS__; } } while (0)
#define SEAM(k) do { if (IN(k) && IN((k) + 1)) { xcd_barrier(bar); if (REP_MASK & 1024) xcd_barrier(bar); } } while (0)

    if (IN(0)) { RUN(6, ph_mod(p, lds); ph_p0_convert(p, lds); ph_hdn3(p); ph_s5par(p); (void)0); }
    SEAM(0);
    if (IN(1)) { RUN(13, ph_hinit(p)); ph_hk(p); }
    SEAM(1);

#pragma unroll
    for (int pair = 0; pair < 2; ++pair) {
        const int pb = 2 + pair * PH_PER_PAIR;
        const int le = 2 * pair, lod = 2 * pair + 1;
        if (IN(pb + 0)) RUN(0, ph_gemm_plain(lds, (const bf16_t*)(ws + WS_XIN), (const bf16_t*)(ws + WS_WIN) + (size_t)pair * 4096 * 2048, (bf16_t*)(ws + WS_Z), INWP, DM, INWP, 0)); if (IN(pb + 0)) { if (pair == 0) ph_fill_table(p, 0, 0, (MROWS / 256) * (INWP / 256)); else ph_fill_table(p, 2, 1, (MROWS / 256) * (INWP / 256)); }
        SEAM(pb + 0);
        if (IN(pb + 1)) { RUN(5, ph_e2a_rows(p, pair); ph_e2a_conv(p, pair, lds)); }
        SEAM(pb + 1);
        if (IN(pb + 2)) {
            RUN(0, ph_gemm_q(lds, (const bf16_t*)(ws + WS_QN), (const bf16_t*)(ws + WS_WUQ) + (size_t)pair * 1536 * 512, (bf16_t*)(ws + WS_Q)));
            RUN(0, ph_gemm_kv(lds, (const bf16_t*)(ws + WS_KVN), (const bf16_t*)(ws + WS_WUKV) + (size_t)pair * 2048 * 256, (bf16_t*)(ws + WS_K), (bf16_t*)(ws + WS_V)));
        }
        SEAM(pb + 2);
        if (IN(pb + 3)) { RUN(1, ph_attention(p, lds)); RUN(2, ph_hyena(p, pair, lds)); }
        SEAM(pb + 3);
        if (IN(pb + 4)) RUN(5, ph_e4_transpose(p, lds));
        SEAM(pb + 4);
        if (IN(pb + 5)) RUN(0, ph_gemm_plain(lds, (const bf16_t*)(ws + WS_CAT), (const bf16_t*)(ws + WS_WO) + (size_t)pair * 2048 * 2048, (bf16_t*)(ws + WS_YMIX), DM, DM, DM, 0)); if (IN(pb + 5)) { if (pair == 0) ph_fill_table(p, 0, 1, (MROWS / 256) * (DM / 256)); else ph_fill_table(p, 3, 0, (MROWS / 256) * (DM / 256)); }
        SEAM(pb + 5);
        if (IN(pb + 6)) ph_ln_mix<false>(p, le);
        SEAM(pb + 6);
        if (IN(pb + 7)) RUN(0, ph_gemm_plain(lds, (const bf16_t*)(ws + WS_XFFN), (const bf16_t*)(ws + WS_WQ) + (size_t)le * 2048 * 2048, (bf16_t*)(ws + WS_PQ), DM, DM, DM, 0)); if (IN(pb + 7)) { if (pair == 0) ph_fill_table(p, 1, 0, (MROWS / 256) * (DM / 256)); else ph_fill_table(p, 3, 1, (MROWS / 256) * (DM / 256)); }
        SEAM(pb + 7);
        if (IN(pb + 8)) RUN(3, ph_peer_topk(p, le, lds));
        SEAM(pb + 8);
        if (IN(pb + 9)) RUN(7, ph_peer_g1(p, le, lds));
        SEAM(pb + 9);
        if (IN(pb + 10)) RUN(9, ph_peer_g1b(p, le));
        SEAM(pb + 10);
        if (IN(pb + 11)) RUN(8, ph_peer_g2(p, le, lds));
        SEAM(pb + 11);
        if (IN(pb + 12)) ph_peer_g3(p, le);
        SEAM(pb + 12);
        if (IN(pb + 13)) RUN(4, ph_s5_pass1(p, pair));
        SEAM(pb + 13);
        if (IN(pb + 14)) ph_s5_prefix(p, pair);
        SEAM(pb + 14);
        if (IN(pb + 15)) RUN(4, ph_s5_pass2(p, pair, lds));
        SEAM(pb + 15);
        if (IN(pb + 16)) RUN(0, ph_gemm_plain(lds, (const bf16_t*)(ws + WS_CAT), (const bf16_t*)(ws + WS_OD) + (size_t)pair * 4096 * 2048, (bf16_t*)(ws + WS_Z), 4096, DM, 4096, pair == 1)); if (IN(pb + 16) && pair == 0) ph_fill_table(p, 1, 1, (MROWS / 256) * (4096 / 256));
        SEAM(pb + 16);
        if (IN(pb + 17)) ph_ln_mix<true>(p, lod);
        SEAM(pb + 17);
        if (IN(pb + 18)) RUN(0, ph_gemm_plain(lds, (const bf16_t*)(ws + WS_XFFN), (const bf16_t*)(ws + WS_WQ) + (size_t)lod * 2048 * 2048, (bf16_t*)(ws + WS_PQ), DM, DM, DM, pair == 1)); if (IN(pb + 18) && pair == 0) ph_fill_table(p, 2, 0, (MROWS / 256) * (DM / 256));
        SEAM(pb + 18);
        if (IN(pb + 19)) RUN(3, ph_peer_topk(p, lod, lds));
        SEAM(pb + 19);
        if (IN(pb + 20)) RUN(7, ph_peer_g1(p, lod, lds));
        SEAM(pb + 20);
        if (IN(pb + 21)) RUN(9, ph_peer_g1b(p, lod));
        SEAM(pb + 21);
        if (IN(pb + 22)) RUN(8, ph_peer_g2(p, lod, lds));
        SEAM(pb + 22);
        if (IN(pb + 23)) ph_peer_g3(p, lod);
        SEAM(pb + 23);
    }
#undef IN
#undef SEAM
}

extern "C" void kernel_launch(void* const* d_in, const int* in_sizes, int n_in, void* d_out, int out_size, void* d_ws, size_t ws_size, hipStream_t stream) {
    static int grid = 0;
    if (grid == 0) {
        if (n_in != 41 || out_size != NB * SEQ * DM || ws_size < WS_END) {
            fprintf(stderr, "kernel_launch: built for 41 inputs, out %d, ws >= %zu; got n_in %d out %d ws %zu\n", NB * SEQ * DM, (size_t)WS_END, n_in, out_size, ws_size);
            grid = -1; return;
        }
        int dev = 0, cus = 0, per_cu = 0;
        if (hipGetDevice(&dev) != hipSuccess || hipDeviceGetAttribute(&cus, hipDeviceAttributeMultiprocessorCount, dev) != hipSuccess) { grid = -1; return; }
        if (hipFuncSetAttribute((const void*)hybrid_fwd, hipFuncAttributeMaxDynamicSharedMemorySize, LDS_BYTES) != hipSuccess) { fprintf(stderr, "kernel_launch: hipFuncSetAttribute failed\n"); grid = -1; return; }
        if (hipOccupancyMaxActiveBlocksPerMultiprocessor(&per_cu, (const void*)hybrid_fwd, NTHREADS, LDS_BYTES) != hipSuccess || per_cu < 1) {
            fprintf(stderr, "kernel_launch: occupancy query reports %d blocks per CU\n", per_cu); (void)hipGetLastError();
        }
        grid = (cus / 8) * 8;
    }
    if (grid < 0) return;
    (void)hipMemsetAsync((char*)d_ws + WS_CTL, 0, 16384, stream);
    Params a{};
    for (int i = 0; i < 41; ++i) a.in[i] = (const float*)d_in[i];
    a.out = (float*)d_out; a.ws = (unsigned char*)d_ws;
#if NLAUNCH == 1
    a.ph_lo = 0; a.ph_hi = N_PHASES;
    hipLaunchKernelGGL(hybrid_fwd, dim3(grid), dim3(NTHREADS), LDS_BYTES, stream, a);
#else
    for (int ph = 0; ph < N_PHASES; ++ph) {
        a.ph_lo = ph; a.ph_hi = ph + 1;
        hipLaunchKernelGGL(hybrid_fwd, dim3(grid), dim3(NTHREADS), LDS_BYTES, stream, a);
    }
#endif
    const hipError_t le = hipPeekAtLastError();
    if (le != hipSuccess) fprintf(stderr, "kernel_launch: launch failed: %s\n", hipGetErrorName(le));
}
```

```cpp
#include <hip/hip_runtime.h>
#include <cstdio>
#include <cstdint>
#include <cstddef>

#ifndef REP_MASK
#define REP_MASK 0
#endif
#ifndef NLAUNCH
#define NLAUNCH 1
#endif

typedef unsigned short bf16_t;
typedef short bf16x8 __attribute__((ext_vector_type(8)));
typedef short s16x4 __attribute__((ext_vector_type(4)));
typedef float f32x4 __attribute__((ext_vector_type(4)));
typedef float f32x16 __attribute__((ext_vector_type(16)));
typedef unsigned u32x4 __attribute__((ext_vector_type(4)));
typedef unsigned u32x2 __attribute__((ext_vector_type(2)));
typedef float cf2 __attribute__((ext_vector_type(2)));

constexpr int DM = 2048, NB = 2, SEQ = 8192, CTXL = 256, TPB = SEQ + CTXL, MROWS = NB * TPB;
constexpr int NTHREADS = 512, NWAVES = 8;
constexpr int HYW = 1024, OHY = 3072, OQ = 3584, OKV = 3840, INW = 3904, INWP = 4096;
constexpr int NH = 8, DQK = 192, DVH = 128, QRANK = 512, KVRANK = 256;
constexpr float DN_ALPHA = 1.6817928305074290f;
constexpr float LN_EPS = 1e-5f, RMS_EPS = 1e-6f;
constexpr float MLA_SCALE = 0.07216878364870322f;
constexpr int S5T = 128, S5NCH = TPB / S5T;
constexpr int LDS_BYTES = 163840;

constexpr size_t al256(size_t x) { return (x + 255) & ~(size_t)255; }
constexpr size_t WS_CTL   = 0;
constexpr size_t WS_MVEC  = 16384;
constexpr size_t WS_H     = al256(WS_MVEC + (size_t)4 * 3 * 12288 * 4);
constexpr size_t WS_XIN   = al256(WS_H + (size_t)MROWS * DM * 4);
constexpr size_t WS_XFFN  = al256(WS_XIN + (size_t)MROWS * DM * 2);
constexpr size_t WS_Z     = al256(WS_XFFN + (size_t)MROWS * DM * 2);
constexpr size_t WS_QN    = al256(WS_Z + (size_t)MROWS * 4096 * 2);
constexpr size_t WS_KVN   = al256(WS_QN + (size_t)MROWS * 512 * 2);
constexpr size_t WS_Q     = al256(WS_KVN + (size_t)MROWS * 256 * 2);
constexpr size_t WS_K     = al256(WS_Q + (size_t)NB * NH * TPB * DQK * 2);
constexpr size_t WS_V     = al256(WS_K + (size_t)NB * NH * TPB * DQK * 2);
constexpr size_t WS_CAT   = al256(WS_V + (size_t)NB * NH * TPB * DVH * 2);
constexpr size_t WS_ZCT   = al256(WS_CAT + (size_t)MROWS * DM * 2);
constexpr size_t WS_YT    = al256(WS_ZCT + (size_t)3072 * MROWS * 2);
constexpr size_t WS_YMIX  = al256(WS_YT + (size_t)1024 * MROWS * 2);
constexpr size_t WS_PQ    = al256(WS_YMIX + (size_t)MROWS * DM * 2);
constexpr size_t WS_PIDX  = al256(WS_PQ + (size_t)MROWS * DM * 2);
constexpr size_t WS_PGATE = al256(WS_PIDX + (size_t)MROWS * 128 * 4);
constexpr size_t WS_PCOEF = al256(WS_PGATE + (size_t)MROWS * 128 * 4);
constexpr size_t WS_WIN   = al256(WS_PCOEF + (size_t)MROWS * 128 * 4);
constexpr size_t WS_WUQ   = al256(WS_WIN + (size_t)2 * 4096 * 2048 * 2);
constexpr size_t WS_WUKV  = al256(WS_WUQ + (size_t)2 * 1536 * 512 * 2);
constexpr size_t WS_WO    = al256(WS_WUKV + (size_t)2 * 2048 * 256 * 2);
constexpr size_t WS_OD    = al256(WS_WO + (size_t)2 * 2048 * 2048 * 2);
constexpr size_t WS_WQ    = al256(WS_OD + (size_t)2 * 4096 * 2048 * 2);
constexpr size_t WS_KEYS  = al256(WS_WQ + (size_t)4 * 2048 * 2048 * 2);
constexpr size_t WS_PU    = al256(WS_KEYS + (size_t)4 * 8 * 2 * 128 * 128 * 2);
constexpr size_t WS_PV    = al256(WS_PU + (size_t)4 * 16384 * 2048);
constexpr size_t WS_PUS   = al256(WS_PV + (size_t)4 * 16384 * 2048);
constexpr size_t WS_PVS   = al256(WS_PUS + (size_t)4 * 16384 * 4);
constexpr size_t WS_HDN3  = al256(WS_PVS + (size_t)4 * 16384 * 4);
constexpr size_t HK_LAT   = (size_t)2 * 1024 * 2 * 8192;
constexpr size_t HK_CTX   = (size_t)2 * 1024 * 2 * 256;
constexpr size_t WS_HK    = al256(WS_HDN3 + (size_t)2 * 8448 * 64 * 4);
constexpr size_t WS_ABAR  = al256(WS_HK + 2 * (HK_LAT + HK_CTX) * 4);
constexpr size_t WS_AT    = al256(WS_ABAR + (size_t)2 * 2 * 128 * 64 * 8);
constexpr size_t WS_BFRAG = al256(WS_AT + (size_t)2 * 2 * 128 * 64 * 8);
constexpr size_t WS_CFRAG = al256(WS_BFRAG + (size_t)2 * 2 * 128 * 4 * 64 * 16);
constexpr size_t WS_EST   = al256(WS_CFRAG + (size_t)2 * 2 * 128 * 4 * 64 * 16);
constexpr size_t WS_SIN   = al256(WS_EST + (size_t)2 * 128 * 2 * S5NCH * 64 * 8);
constexpr size_t WS_TW    = al256(WS_SIN + (size_t)2 * 128 * 2 * S5NCH * 64 * 8);
constexpr size_t WS_W4T   = al256(WS_TW + (size_t)8192 * 8);
constexpr size_t WS_XQ8   = al256(WS_W4T + (size_t)2 * 4096 * 64 * 2);
constexpr size_t WS_XS    = al256(WS_XQ8 + (size_t)MROWS * DM);
constexpr size_t WS_END   = al256(WS_XS + (size_t)MROWS * 4);
constexpr size_t FFT_SCR_PER_BLOCK = 512 * 1024;
static_assert(256 * FFT_SCR_PER_BLOCK <= (size_t)MROWS * 4096 * 2, "fft scratch must fit the z region");
static_assert((size_t)16 * MROWS * 128 * 4 <= (size_t)MROWS * 4096 * 2, "peer partial dots must fit the z region");

struct Params {
    const float* in[41];
    float* out;
    unsigned char* ws;
    int ph_lo, ph_hi;
};

#define LAS __attribute__((address_space(3)))
typedef const __attribute__((address_space(4))) Params* KP;
#ifndef PHASE_FN
#define PHASE_FN __device__ __forceinline__
#endif

__device__ __forceinline__ int opaque_tid() { int t = (int)threadIdx.x; asm volatile("" : "+v"(t)); return t; }
__device__ __forceinline__ KP launder_kp(KP p) { unsigned long long v = (unsigned long long)p; asm volatile("" : "+s"(v)); return (KP)v; }
__device__ __forceinline__ int opaque_bid() { int t = (int)blockIdx.x; asm volatile("" : "+s"(t)); return t; }
#define TID  (opaque_tid())

__device__ __forceinline__ cf2 mk2(float a, float b) { cf2 r; r.x = a; r.y = b; return r; }
__device__ __forceinline__ float bf2f(bf16_t b) { return __uint_as_float(((unsigned)b) << 16); }
__device__ __forceinline__ float bflo(unsigned w) { return __uint_as_float(w << 16); }
__device__ __forceinline__ float bfhi(unsigned w) { return __uint_as_float(w & 0xffff0000u); }
__device__ __forceinline__ unsigned cvt_pk(float lo, float hi) { unsigned r; asm volatile("v_cvt_pk_bf16_f32 %0, %1, %2" : "=v"(r) : "v"(lo), "v"(hi)); return r; }
__device__ __forceinline__ bf16_t f2bf(float f) { return (bf16_t)(cvt_pk(f, 0.f) & 0xffffu); }
template <int CTRL> __device__ __forceinline__ float dppf(float v) { return __builtin_bit_cast(float, __builtin_amdgcn_update_dpp(0, __builtin_bit_cast(int, v), CTRL, 0xF, 0xF, true)); }
__device__ __forceinline__ float rdlane(float v, int l) { return __builtin_bit_cast(float, __builtin_amdgcn_readlane(__builtin_bit_cast(int, v), l)); }
__device__ __forceinline__ float wave_sum(float v) {
    v += dppf<0xB1>(v); v += dppf<0x4E>(v); v += dppf<0x141>(v); v += dppf<0x140>(v);
    return (rdlane(v, 0) + rdlane(v, 16)) + (rdlane(v, 32) + rdlane(v, 48));
}
__device__ __forceinline__ float wave_max(float v) {
    v = fmaxf(v, dppf<0xB1>(v)); v = fmaxf(v, dppf<0x4E>(v)); v = fmaxf(v, dppf<0x141>(v)); v = fmaxf(v, dppf<0x140>(v));
    return fmaxf(fmaxf(rdlane(v, 0), rdlane(v, 16)), fmaxf(rdlane(v, 32), rdlane(v, 48)));
}
typedef int i32x2v __attribute__((ext_vector_type(2)));
typedef float f32x2v __attribute__((ext_vector_type(2)));
__device__ __forceinline__ void dec16(const u32x4 w, float (&f)[16]) {
#pragma unroll
    for (int d = 0; d < 4; ++d) {
        const f32x2v lo = __builtin_amdgcn_cvt_pk_f32_fp8((int)w[d], false), hi = __builtin_amdgcn_cvt_pk_f32_fp8((int)w[d], true);
        f[4 * d] = lo.x; f[4 * d + 1] = lo.y; f[4 * d + 2] = hi.x; f[4 * d + 3] = hi.y;
    }
}
__device__ __forceinline__ float gelu_tanh(float x) {
    const float z = 0.7978845608028654f * (x + 0.044715f * x * x * x);
    const float e = __expf(2.0f * z);
    const float t = 1.0f - 2.0f / (e + 1.0f);
    return 0.5f * x * (1.0f + t);
}
__device__ __forceinline__ void unpack8(const u32x4 w, float (&f)[8]) {
    f[0] = bflo(w.x); f[1] = bfhi(w.x); f[2] = bflo(w.y); f[3] = bfhi(w.y); f[4] = bflo(w.z); f[5] = bfhi(w.z); f[6] = bflo(w.w); f[7] = bfhi(w.w);
}
__device__ __forceinline__ u32x4 pack8(const float (&f)[8]) {
    u32x4 w; w.x = cvt_pk(f[0], f[1]); w.y = cvt_pk(f[2], f[3]); w.z = cvt_pk(f[4], f[5]); w.w = cvt_pk(f[6], f[7]); return w;
}

namespace pg8 {
#define PG8_LAS __attribute__((address_space(3)))
typedef unsigned short bf16_t;
typedef short bf16x8 __attribute__((ext_vector_type(8)));
typedef float f32x4 __attribute__((ext_vector_type(4)));
typedef unsigned u32x4 __attribute__((ext_vector_type(4)));
constexpr int BM = 256, BK = 64, HALF = 128, HTB = HALF * BK * 2  , STAGE_BYTES = 8 * HTB, NXCD = 8, WGM = 8;

__host__ __device__ __forceinline__ int lds_byte(int r, int c) { const int st = (r >> 4) * 2 + (c >> 5), rr = r & 15, cc = c & 31, ob = rr * 64 + cc * 2; return st * 1024 + (ob ^ (((ob >> 9) & 1) << 5)); }
__host__ __device__ __forceinline__ void stage_rc(int b, int& R, int& C) { const int st = b / 1024, sb = b % 1024, swz = sb ^ (((sb >> 9) & 1) << 5); R = (st >> 1) * 16 + swz / 64; C = (st & 1) * 32 + (swz % 64) / 2; }
__host__ __device__ __forceinline__ int perm32(int rho) { const int n = rho >> 4, i = rho & 15; return 8 * (i >> 2) + 4 * n + (i & 3); }

struct Unit { int pm, pn; };
struct Gemm { const bf16_t* A; const bf16_t* Bt; int M, N, K; };

struct StaticOrder {
    int nM, nN, nwg, G, c;
    __host__ __device__ void init(int M, int N, int G_, int c_) { nM = M / BM; nN = N / BM; nwg = nM * nN; G = G_; c = c_; }
    __host__ __device__ bool next(int i, Unit& u) const {
        const long L = (long)i * G + c; if (L >= nwg) return false;
        int wgid = (int)L; { const int q = nwg / NXCD, r = nwg % NXCD, xcd = wgid % NXCD, off = wgid / NXCD; wgid = (xcd < r ? xcd * (q + 1) : r * (q + 1) + (xcd - r) * q) + off; }
        const int nig = WGM * nN, gid = wgid / nig, fm = gid * WGM, gsz = (nM - fm) < WGM ? (nM - fm) : WGM;
        u.pm = fm + ((wgid % nig) % gsz); u.pn = (wgid % nig) / gsz; return true;
    }
    __device__ __forceinline__ void a_ready(const Unit&) const {}
    __device__ __forceinline__ void done(const Unit&) const {}
};
__device__ __forceinline__ unsigned cvt_pk_bf16(float lo, float hi) { unsigned r; asm volatile("v_cvt_pk_bf16_f32 %0, %1, %2" : "=v"(r) : "v"(lo), "v"(hi)); return r; }
typedef float f32x2 __attribute__((ext_vector_type(2)));
__device__ __forceinline__ f32x2 gelu_pk(f32x2 v) {
    const f32x2 av = __builtin_elementwise_abs(v), d = av * 0.2316418882f + 1.0f;
    f32x2 t; t.x = __builtin_amdgcn_rcpf(d.x); t.y = __builtin_amdgcn_rcpf(d.y);
    f32x2 q = t * 0.5307027145f + (-0.7265760135f); q = q * t + 0.7107068705f; q = q * t + (-0.142248368f); q = q * t + 0.127414796f; q = q * t;
    const f32x2 s = (v * v) * (-0.72134752044f);
    f32x2 e; e.x = __builtin_amdgcn_exp2f(s.x); e.y = __builtin_amdgcn_exp2f(s.y);
    const f32x2 m = v * (q * e), r = v - m;
    f32x2 o; o.x = v.x < 0.f ? m.x : r.x; o.y = v.y < 0.f ? m.y : r.y; return o;
}

template <class Epi, class Sched, bool STAMP = false>
__device__ __forceinline__ void gemm_phase(PG8_LAS unsigned char* lds, const Gemm g, const Sched& S, const Epi& E, unsigned long long* stamps) {
    const int tid = TID, wid = __builtin_amdgcn_readfirstlane(tid >> 6), lane = tid & 63, wr = wid >> 2, wc = wid & 3, fr = lane & 15, fq = lane >> 4;
    const int K = g.K, nt = K / BK;
    int ts_lo = 0, ts_hi = 0, nts = 0; const unsigned long long rt_entry = STAMP ? (unsigned long long)wall_clock64() : 0ull;
#define PG8_STAMP() do { if (STAMP && wid == 0 && nts < 64) { const unsigned long long _c = (unsigned long long)clock64(); \
        ts_lo = (lane == nts) ? (int)(unsigned)_c : ts_lo; ts_hi = (lane == nts) ? (int)(unsigned)(_c >> 32) : ts_hi; ++nts; } } while (0)
    PG8_STAMP();
    unsigned voffA[2], voffB[2];
#pragma unroll
    for (int i = 0; i < 2; ++i) { int R, C; stage_rc(tid * 16 + i * 8192, R, C); const int Rb = Epi::PERM ? ((R & ~31) + perm32(R & 31)) : R;
        voffA[i] = (unsigned)(R * K + C) * 2u; voffB[i] = (unsigned)(Rb * K + C) * 2u; }
    const size_t kstep = (size_t)(BK * 2);
    const size_t hstep = (size_t)HALF * K * 2;
    const size_t tstep = 2 * hstep;
    const unsigned ldsw = (unsigned)wid * 1024u;
    const int aoff = lds_byte(wr * 64 + fr, fq * 8), boff = lds_byte(wc * 32 + fr, fq * 8);
#define PG8_SA(b, h) (((b) * 2 + (h)) * HTB)
#define PG8_SB(b, h) ((4 + (b) * 2 + (h)) * HTB)
#define PG8_STAGE(bufoff, gbase, voff) do { _Pragma("unroll") for (int _i = 0; _i < 2; ++_i) \
        __builtin_amdgcn_global_load_lds((const unsigned*)((const char*)(gbase) + (voff)[_i]), (PG8_LAS unsigned*)(lds + (bufoff) + ldsw + _i * 8192), 16, 0, 0); } while (0)
#define PG8_LDA(dst, b, h) do { _Pragma("unroll") for (int m = 0; m < 4; ++m) _Pragma("unroll") for (int k = 0; k < 2; ++k) dst[m][k] = *(const PG8_LAS bf16x8*)(lds + PG8_SA(b, h) + aoff + m * 2048 + k * 1024); } while (0)
#define PG8_LDB(dst, b, h) do { _Pragma("unroll") for (int n = 0; n < 2; ++n) _Pragma("unroll") for (int k = 0; k < 2; ++k) dst[n][k] = *(const PG8_LAS bf16x8*)(lds + PG8_SB(b, h) + boff + n * 2048 + k * 1024); } while (0)
#define PG8_MMA(ai, bj, At, Bt) do { __builtin_amdgcn_s_setprio(1); _Pragma("unroll") for (int m = 0; m < 4; ++m) _Pragma("unroll") for (int n = 0; n < 2; ++n) _Pragma("unroll") for (int k = 0; k < 2; ++k) \
        acc[ai][bj][m][n] = __builtin_amdgcn_mfma_f32_16x16x32_bf16(Bt[n][k], At[m][k], acc[ai][bj][m][n], 0, 0, 0); __builtin_amdgcn_s_setprio(0); } while (0)
#define PG8_WAIT_V(n) asm volatile("s_waitcnt vmcnt(" #n ")" ::: "memory")
#define PG8_WAIT_L(n) asm volatile("s_waitcnt lgkmcnt(" #n ")" ::: "memory")
#define PG8_BAR __builtin_amdgcn_s_barrier()
#define PG8_SCHED __builtin_amdgcn_sched_barrier(0)
    Unit cur, nxt; int ui = 0;
    if (!S.next(0, cur)) return;
    f32x4 acc[2][2][4][2];
#pragma unroll
    for (int a = 0; a < 2; ++a)
#pragma unroll
        for (int b = 0; b < 2; ++b)
#pragma unroll
            for (int m = 0; m < 4; ++m)
#pragma unroll
                for (int n = 0; n < 2; ++n) acc[a][b][m][n] = (f32x4){0.f, 0.f, 0.f, 0.f};
    bf16x8 At[4][2], B0[2][2], B1[2][2];
    const char* cA = (const char*)g.A + (size_t)cur.pm * tstep; const char* cB = (const char*)g.Bt + (size_t)cur.pn * tstep;
    S.a_ready(cur);
    PG8_STAGE(PG8_SB(0, 0), cB, voffB); PG8_STAGE(PG8_SA(0, 0), cA, voffA); PG8_STAGE(PG8_SB(0, 1), cB + hstep, voffB); PG8_STAGE(PG8_SA(0, 1), cA + hstep, voffA);
    if (wr == 1) PG8_BAR;
    PG8_WAIT_V(4); PG8_BAR;
    PG8_STAGE(PG8_SB(1, 0), cB + kstep, voffB); PG8_STAGE(PG8_SA(1, 0), cA + kstep, voffA); PG8_STAGE(PG8_SB(1, 1), cB + hstep + kstep, voffB);
    PG8_WAIT_V(6); PG8_BAR;
    PG8_STAMP();
    for (;;) {
        const bool has_next = S.next(ui + 1, nxt);
        const char* nA = has_next ? (const char*)g.A + (size_t)nxt.pm * tstep : cA; const char* nB = has_next ? (const char*)g.Bt + (size_t)nxt.pn * tstep : cB;
        for (int t = 0; t < nt; t += 2) {
            const bool last = (t == nt - 2);
            const char* a1 = cA + (size_t)(t + 1) * kstep;
            const char* a2 = last ? nA : cA + (size_t)(t + 2) * kstep; const char* b2 = last ? nB : cB + (size_t)(t + 2) * kstep;
            const char* a3 = a2 + kstep; const char* b3 = b2 + kstep;
            if (last && has_next) S.a_ready(nxt);
            PG8_LDB(B0, 0, 0); PG8_SCHED; PG8_LDA(At, 0, 0); PG8_STAGE(PG8_SA(1, 1), a1 + hstep, voffA);
            PG8_WAIT_L(8); PG8_BAR; PG8_WAIT_L(0); PG8_MMA(0, 0, At, B0); PG8_BAR; PG8_SCHED;
            PG8_LDB(B1, 0, 1); PG8_STAGE(PG8_SB(0, 0), b2, voffB);
            PG8_BAR; PG8_WAIT_L(0); PG8_MMA(0, 1, At, B1); PG8_BAR;
            PG8_LDA(At, 0, 1); PG8_STAGE(PG8_SA(0, 0), a2, voffA);
            PG8_BAR; PG8_WAIT_L(0); PG8_MMA(1, 0, At, B0); PG8_BAR; PG8_SCHED;
            PG8_STAGE(PG8_SB(0, 1), b2 + hstep, voffB);
            PG8_WAIT_V(6); PG8_BAR; PG8_MMA(1, 1, At, B1); PG8_BAR;
            PG8_LDB(B0, 1, 0); PG8_SCHED; PG8_LDA(At, 1, 0); PG8_STAGE(PG8_SA(0, 1), a2 + hstep, voffA);
            PG8_WAIT_L(8); PG8_BAR; PG8_WAIT_L(0); PG8_MMA(0, 0, At, B0); PG8_BAR; PG8_SCHED;
            PG8_LDB(B1, 1, 1); PG8_STAGE(PG8_SB(1, 0), b3, voffB);
            PG8_BAR; PG8_WAIT_L(0); PG8_MMA(0, 1, At, B1); PG8_BAR;
            PG8_LDA(At, 1, 1); PG8_STAGE(PG8_SA(1, 0), a3, voffA);
            PG8_BAR; PG8_WAIT_L(0); PG8_MMA(1, 0, At, B0); PG8_BAR; PG8_SCHED;
            PG8_STAGE(PG8_SB(1, 1), b3 + hstep, voffB);
            PG8_WAIT_V(6); PG8_BAR; PG8_MMA(1, 1, At, B1); PG8_BAR;
        }
        PG8_STAMP();
        if constexpr (!Epi::AFTER_DRAIN) { E(acc, cur, wr, wc, fr, fq); S.done(cur); }
        PG8_STAMP();
        if (!has_next) break;
#pragma unroll
        for (int a = 0; a < 2; ++a)
#pragma unroll
            for (int b = 0; b < 2; ++b)
#pragma unroll
                for (int m = 0; m < 4; ++m)
#pragma unroll
                    for (int n = 0; n < 2; ++n) acc[a][b][m][n] = (f32x4){0.f, 0.f, 0.f, 0.f};
        cur = nxt; cA = nA; cB = nB; ++ui;
    }
    PG8_WAIT_V(0);
    if (wr == 0) PG8_BAR;
    PG8_BAR;
    if constexpr (Epi::AFTER_DRAIN) { E.fused(acc, cur, wr, wc, fr, fq, lds, wid, lane); S.done(cur); }
    PG8_STAMP();
    if (STAMP && wid == 0) { stamps[lane] = lane < nts ? (((unsigned long long)(unsigned)ts_hi << 32) | (unsigned)ts_lo) : 0ull;
        if (lane == 62) stamps[62] = rt_entry; if (lane == 63) stamps[63] = (unsigned long long)wall_clock64(); }
#undef PG8_STAMP
#undef PG8_SA
#undef PG8_SB
#undef PG8_STAGE
#undef PG8_LDA
#undef PG8_LDB
#undef PG8_MMA
#undef PG8_WAIT_V
#undef PG8_WAIT_L
#undef PG8_BAR
#undef PG8_SCHED
}
}

#define XB_TMO      128
#define XB_XCNT(j)  (256  + 64 * (j))
#define XB_XSUB(j)  (1280 + 64 * (j))
#define XB_XGEN(j)  (2304 + 64 * (j))
#define XB_TOP      3328
#define XB_TOPGEN   3392
#define XCD_BAR_WORDS 3456
#define XB_SPIN_CAP (1u << 22)
#define LAS __attribute__((address_space(3)))

__device__ __forceinline__ unsigned xb_ld(unsigned* p)              { return __hip_atomic_load(p, __ATOMIC_RELAXED, __HIP_MEMORY_SCOPE_AGENT); }
__device__ __forceinline__ unsigned xb_add(unsigned* p, unsigned v) { return __hip_atomic_fetch_add(p, v, __ATOMIC_RELAXED, __HIP_MEMORY_SCOPE_AGENT); }
__device__ __forceinline__ unsigned xb_xcc_id() { return (unsigned)__builtin_amdgcn_s_getreg((3 << 11) | 20) & 0xFu; }
#define XB_SPIN(cond, bar) do { unsigned _sp = 0; while (cond) { __builtin_amdgcn_s_sleep(1); \
    if ((++_sp & 255u) == 0u) { if (xb_ld(&(bar)[XB_TMO])) break; if (_sp > XB_SPIN_CAP) { atomicAdd(&(bar)[XB_TMO], 1u); break; } } } } while (0)

struct XcdBarrier {
    unsigned* bar; unsigned x;
    volatile LAS unsigned* st;
};

__device__ __forceinline__ XcdBarrier xcd_barrier_post(unsigned* bar, volatile LAS unsigned* st) {
    XcdBarrier b; b.bar = bar; b.x = xb_xcc_id(); b.st = st;
    if (threadIdx.x == 0) (void)xb_add(&bar[XB_XCNT(b.x)], 1u);
    return b;
}
__device__ __forceinline__ void xcd_barrier_complete(unsigned* bar, unsigned x, unsigned& nloc, unsigned& nx) {
    const unsigned G = gridDim.x * gridDim.y * gridDim.z;
    unsigned sum, cnt, mine, sp = 0u;
    for (;;) {
        sum = 0u; cnt = 0u; mine = 0u;
#pragma unroll
        for (unsigned j = 0; j < 16; ++j) { const unsigned c = xb_ld(&bar[XB_XCNT(j)]); sum += c; cnt += (c > 0u) ? 1u : 0u; mine = (j == x) ? c : mine; }
        if (sum == G) break;
        __builtin_amdgcn_s_sleep(1);
        if ((++sp & 255u) == 0u) { if (xb_ld(&bar[XB_TMO])) break; if (sp > XB_SPIN_CAP) { atomicAdd(&bar[XB_TMO], 1u); break; } }
    }
    nloc = mine > 0u ? mine : 1u; nx = cnt > 0u ? cnt : 1u;
}

__device__ __forceinline__ void xcd_barrier(const XcdBarrier& b) {
    asm volatile("s_waitcnt vmcnt(0)" ::: "memory");
    __syncthreads();
    if (threadIdx.x == 0) {
        unsigned* bar = b.bar;
        __builtin_amdgcn_s_waitcnt(0);
        unsigned nloc = b.st[0], nx = b.st[1];
        if (nloc == 0u) { xcd_barrier_complete(bar, b.x, nloc, nx); b.st[0] = nloc; b.st[1] = nx; }
        const unsigned old = xb_add(&bar[XB_XSUB(b.x)], 1u);
        const unsigned gen = old / nloc;
        if (old + 1u == (gen + 1u) * nloc) {
            __builtin_amdgcn_fence(__ATOMIC_RELEASE, "agent");
            asm volatile("s_waitcnt vmcnt(0)" ::: "memory");
            const unsigned og = xb_add(&bar[XB_TOP], 1u);
            const unsigned tg = og / nx;
            if (og + 1u == (tg + 1u) * nx) xb_add(&bar[XB_TOPGEN], 1u);
            else XB_SPIN(xb_ld(&bar[XB_TOPGEN]) == tg, bar);
            __builtin_amdgcn_fence(__ATOMIC_ACQUIRE, "agent");
            xb_add(&bar[XB_XGEN(b.x)], 1u);
            asm volatile("s_waitcnt vmcnt(0)" ::: "memory");
        } else {
            XB_SPIN(xb_ld(&bar[XB_XGEN(b.x)]) == gen, bar);
            __builtin_amdgcn_fence(__ATOMIC_ACQUIRE, "agent");
            asm volatile("s_waitcnt vmcnt(0)" ::: "memory");
        }
    }
    __syncthreads();
}


#define BID  (opaque_bid())
#define NBLK ((int)gridDim.x)

PHASE_FN void ph_mod(KP p, LAS unsigned char* lds) {
    p = launder_kp(p);
    LAS float* act = (LAS float*)lds;
    LAS float* red = act + 3 * 2048;
    const int tid = TID;
    for (int i = tid; i < 3 * 2048; i += NTHREADS) {
        const int kind = i >> 11, k = i & 2047;
        const float c = kind < 2 ? p->in[1][kind * 2048 + k] : p->in[3][k];
        act[i] = c / (1.0f + expf(-c));
    }
    __syncthreads();
    float* mvec = (float*)(p->ws + WS_MVEC);
    const int cg = tid % 48, kg = tid / 48;
    for (int unit = BID; unit < 256; unit += NBLK) {
        const int col4 = unit * 48 + cg, layer = col4 / 3072, n4 = col4 % 3072;
        f32x4 a0 = {0.f, 0.f, 0.f, 0.f}, a1 = a0, a2 = a0;
        if (kg < 10) {
            const f32x4* w = (const f32x4*)(p->in[4] + (size_t)layer * 2048 * 12288) + n4;
            int k = kg;
            for (; k + 70 < 2048; k += 80) {
                f32x4 wv[8];
#pragma unroll
                for (int q = 0; q < 8; ++q) wv[q] = __builtin_nontemporal_load(w + (size_t)(k + 10 * q) * 3072);
#pragma unroll
                for (int q = 0; q < 8; ++q) { a0 += act[k + 10 * q] * wv[q]; a1 += act[2048 + k + 10 * q] * wv[q]; a2 += act[4096 + k + 10 * q] * wv[q]; }
            }
            for (; k < 2048; k += 10) {
                const f32x4 wv = w[(size_t)k * 3072];
                a0 += act[k] * wv; a1 += act[2048 + k] * wv; a2 += act[4096 + k] * wv;
            }
            LAS float* r = red + (kg * 48 + cg) * 12;
#pragma unroll
            for (int j = 0; j < 4; ++j) { r[j] = a0[j]; r[4 + j] = a1[j]; r[8 + j] = a2[j]; }
        }
        __syncthreads();
        for (int o = tid; o < 48 * 12; o += NTHREADS) {
            const int c2 = o / 12, q = o % 12, kind = q >> 2, j = q & 3;
            float s = 0.f;
#pragma unroll
            for (int g = 0; g < 10; ++g) s += red[(g * 48 + c2) * 12 + q];
            const int cc4 = unit * 48 + c2, ly = cc4 / 3072, n = (cc4 % 3072) * 4 + j;
            mvec[((size_t)ly * 3 + kind) * 12288 + n] = s + p->in[5][(size_t)ly * 12288 + n];
        }
        __syncthreads();
    }
}

__device__ __forceinline__ void transpose_cvt(const float* __restrict__ src, int K, int N, bf16_t* __restrict__ dst, int Npad, LAS unsigned char* lds) {
    LAS float* t = (LAS float*)lds;
    const int tid = TID, tk = K / 64, tn = Npad / 64, ntile = tk * tn;
    for (int u0 = BID * 4; u0 < ntile; u0 += NBLK * 4) {
        f32x4 v[4][2];
#pragma unroll
        for (int q = 0; q < 4; ++q) {
            const int u = u0 + q, k0 = (u % tk) * 64, n0 = (u / tk) * 64;
#pragma unroll
            for (int h = 0; h < 2; ++h) {
                const int r = (tid >> 4) + 32 * h, c4 = (tid & 15) * 4;
                v[q][h] = (f32x4){0.f, 0.f, 0.f, 0.f};
                if (u < ntile && n0 + c4 < N) v[q][h] = __builtin_nontemporal_load((const f32x4*)(src + (size_t)(k0 + r) * N + n0 + c4));
            }
        }
#pragma unroll
        for (int q = 0; q < 4; ++q)
#pragma unroll
            for (int h = 0; h < 2; ++h) {
                const int r = (tid >> 4) + 32 * h, c4 = (tid & 15) * 4;
#pragma unroll
                for (int j = 0; j < 4; ++j) t[(q * 64 + r) * 65 + c4 + j] = v[q][h][j];
            }
        __syncthreads();
#pragma unroll
        for (int q = 0; q < 4; ++q) {
            const int u = u0 + q, k0 = (u % tk) * 64, n0 = (u / tk) * 64;
            if (u < ntile) {
                const int n = tid >> 3, kc = (tid & 7) * 8;
                float f[8];
#pragma unroll
                for (int j = 0; j < 8; ++j) f[j] = t[(q * 64 + kc + j) * 65 + n];
                *(u32x4*)(dst + (size_t)(n0 + n) * K + k0 + kc) = pack8(f);
            }
        }
        __syncthreads();
    }
}

__device__ __forceinline__ void cvt_bf16(const float* __restrict__ src, bf16_t* __restrict__ dst, size_t n) {
    const size_t n8 = n / 8, stride = (size_t)NBLK * NTHREADS;
    for (size_t i = (size_t)BID * NTHREADS + TID; i < n8; i += stride) {
        const f32x4 a = *(const f32x4*)(src + i * 8), b = *(const f32x4*)(src + i * 8 + 4);
        u32x4 w; w.x = cvt_pk(a[0], a[1]); w.y = cvt_pk(a[2], a[3]); w.z = cvt_pk(b[0], b[1]); w.w = cvt_pk(b[2], b[3]);
        *(u32x4*)(dst + i * 8) = w;
    }
}

__device__ __forceinline__ void cvt_fp8_rows(const float* __restrict__ src, unsigned char* __restrict__ dst, float* __restrict__ scales, int nrows, int wkr, int nwkr) {
    const int lane = TID & 63, wid = TID >> 6;
    for (int r0 = (wkr * NWAVES + wid) * 2; r0 < nrows; r0 += nwkr * NWAVES * 2) {
        f32x4 v[2][2][4];
#pragma unroll
        for (int rr = 0; rr < 2; ++rr)
#pragma unroll
            for (int c = 0; c < 2; ++c)
#pragma unroll
                for (int q = 0; q < 4; ++q) v[rr][c][q] = __builtin_nontemporal_load((const f32x4*)(src + (size_t)(r0 + rr) * DM + lane * 16 + c * 1024 + q * 4));
#pragma unroll
        for (int rr = 0; rr < 2; ++rr) {
            float am = 0.f;
#pragma unroll
            for (int c = 0; c < 2; ++c)
#pragma unroll
                for (int q = 0; q < 4; ++q)
#pragma unroll
                    for (int k = 0; k < 4; ++k) am = fmaxf(am, fabsf(v[rr][c][q][k]));
            am = wave_max(am);
            const float sc = am > 0.f ? am * (1.0f / 224.0f) : 1.0f, inv = 1.0f / sc;
#pragma unroll
            for (int c = 0; c < 2; ++c) {
                u32x4 w;
#pragma unroll
                for (int q = 0; q < 4; ++q) {
                    int x = __builtin_amdgcn_cvt_pk_fp8_f32(v[rr][c][q][0] * inv, v[rr][c][q][1] * inv, 0, false);
                    x = __builtin_amdgcn_cvt_pk_fp8_f32(v[rr][c][q][2] * inv, v[rr][c][q][3] * inv, x, true);
                    w[q] = (unsigned)x;
                }
                __builtin_nontemporal_store(w, (u32x4*)(dst + ((size_t)(c * 8 + (lane >> 3)) * 16384 + (r0 + rr)) * 128 + (lane & 7) * 16));
            }
            if (lane == 0) scales[r0 + rr] = sc;
        }
    }
}

PHASE_FN void ph_hdn3(KP p) {
    p = launder_kp(p);
    const int lane = TID & 63, wid = TID >> 6;
    float* hdn3 = (float*)(p->ws + WS_HDN3);
    for (int pp = BID * NWAVES + wid; pp < 2 * 8448; pp += NBLK * NWAVES) {
        const int e = pp / 8448, pos = pp % 8448;
        const int L = pos < 8192 ? 8192 : 256, i = pos < 8192 ? pos : pos - 8192;
        const float* w1 = p->in[13] + (size_t)e * 33 * 64; const float* b1 = p->in[14] + e * 64;
        const float* w2 = p->in[15] + (size_t)e * 64 * 64; const float* b2 = p->in[16] + e * 64;
        const float* w3 = p->in[17] + (size_t)e * 64 * 64; const float* b3 = p->in[18] + e * 64;
        const float fr = p->in[20][e * 64 + lane];
        const float t = (float)i / (float)(L - 1);
        const float w = (float)(6.283185307179586 / (double)L) * (float)i;
        float feat = 0.f;
        if (lane == 0) feat = t;
        else if (lane < 33) {
            const int k = (lane - 1) & 15;
            const float fk = 1e-4f + (float)k * ((15.0f - 1e-4f) / 15.0f);
            feat = lane < 17 ? cosf(fk * w) : -sinf(fk * w);
        }
        float acc = b1[lane];
#pragma unroll
        for (int f = 0; f < 33; ++f) acc += __builtin_bit_cast(float, __builtin_amdgcn_readlane(__builtin_bit_cast(int, feat), f)) * w1[f * 64 + lane];
        float hcur = sinf(fr * acc);
        acc = b2[lane];
#pragma unroll
        for (int f = 0; f < 64; ++f) acc += __builtin_bit_cast(float, __builtin_amdgcn_readlane(__builtin_bit_cast(int, hcur), f)) * w2[f * 64 + lane];
        hcur = sinf(fr * acc);
        acc = b3[lane];
#pragma unroll
        for (int f = 0; f < 64; ++f) acc += __builtin_bit_cast(float, __builtin_amdgcn_readlane(__builtin_bit_cast(int, hcur), f)) * w3[f * 64 + lane];
        hcur = sinf(fr * acc);
        hdn3[((size_t)e * 8448 + pos) * 64 + lane] = hcur;
    }
}

PHASE_FN void ph_hk(KP p) {
    p = launder_kp(p);
    const int lane = TID & 63, wid = TID >> 6, n = lane & 15, kg = lane >> 4;
    for (int u = BID * NWAVES + wid; u < 2 * 132 * 64; u += NBLK * NWAVES) {
        const int cg = u & 63, pt = (u >> 6) % 132, e = u / (132 * 64), pos0 = pt * 64;
        const float* hdn3 = (const float*)(p->ws + WS_HDN3) + (size_t)e * 8448 * 64;
        const bf16_t* w4t = (const bf16_t*)(p->ws + WS_W4T) + (size_t)e * 4096 * 64;
        bf16_t* hk = (bf16_t*)(p->ws + WS_HK) + (size_t)e * (HK_LAT + HK_CTX);
        bf16x8 af[4][2];
#pragma unroll
        for (int mt = 0; mt < 4; ++mt)
#pragma unroll
            for (int ks = 0; ks < 2; ++ks) {
                const float* hp = hdn3 + (size_t)(pos0 + mt * 16 + n) * 64 + ks * 32 + kg * 8;
                const f32x4 a = *(const f32x4*)hp, b = *(const f32x4*)(hp + 4);
                u32x4 w; w.x = cvt_pk(a[0], a[1]); w.y = cvt_pk(a[2], a[3]); w.z = cvt_pk(b[0], b[1]); w.w = cvt_pk(b[2], b[3]);
                af[mt][ks] = *reinterpret_cast<bf16x8*>(&w);
            }
        const bool lat = pos0 < 8192;
        const int L = lat ? 8192 : 256, ib = (lat ? pos0 : pos0 - 8192) + 4 * kg;
        bf16_t* base = hk + (lat ? 0 : HK_LAT);
        const float rl = 1.0f / (float)(L - 1);
#pragma unroll 2
        for (int ct = 0; ct < 4; ++ct) {
            const int col = cg * 64 + ct * 16 + n;
            const bf16x8 b0 = *(const bf16x8*)(w4t + (size_t)col * 64 + kg * 8), b1 = *(const bf16x8*)(w4t + (size_t)col * 64 + 32 + kg * 8);
            const int dir = col >> 11, o = (col >> 10) & 1, c = col & 1023;
            const float a0 = -3.0701134573253944f, a1 = -15.350567286626973f;
            const float delta = fabsf(a0 + (float)(o * 1024 + c) * ((a1 - a0) / 2047.0f));
            bf16_t* row = base + ((size_t)(o * 1024 + c) * 2 + dir) * L + ib;
#pragma unroll
            for (int mt = 0; mt < 4; ++mt) {
                f32x4 acc = {0.f, 0.f, 0.f, 0.f};
                acc = __builtin_amdgcn_mfma_f32_16x16x32_bf16(af[mt][0], b0, acc, 0, 0, 0);
                acc = __builtin_amdgcn_mfma_f32_16x16x32_bf16(af[mt][1], b1, acc, 0, 0, 0);
                float ov[4];
#pragma unroll
                for (int r = 0; r < 4; ++r) ov[r] = acc[r] * __expf(-((float)(ib + mt * 16 + r) * rl) * delta);
                u32x2 w; w.x = cvt_pk(ov[0], ov[1]); w.y = cvt_pk(ov[2], ov[3]);
                __builtin_nontemporal_store(w, (u32x2*)(row + mt * 16));
            }
        }
    }
}

PHASE_FN void ph_s5par(KP p) {
    p = launder_kp(p);
    cf2* abar = (cf2*)(p->ws + WS_ABAR); cf2* aT = (cf2*)(p->ws + WS_AT);
    bf16_t* bfrag = (bf16_t*)(p->ws + WS_BFRAG); bf16_t* cfrag = (bf16_t*)(p->ws + WS_CFRAG);
    for (int i = (NBLK - 1 - BID) * NTHREADS + TID; i < 2 * 2 * 128 * 64; i += NBLK * NTHREADS) {
        const int pp = i & 63, g = (i >> 6) & 127, d = (i >> 13) & 1, il = i >> 14;
        const int gi = (il * 2 + d) * 128 + g;
        const double lre = p->in[27][(size_t)gi * 64 + pp], lim = p->in[28][(size_t)gi * 64 + pp];
        const double dt = exp((double)p->in[29][gi]);
        const double zr = lre * dt, zi = lim * dt;
        const double er = exp(zr), ar = er * cos(zi), ai = er * sin(zi);
        abar[i] = mk2((float)ar, (float)ai);
        const double eT = exp(zr * S5T);
        aT[i] = mk2((float)(eT * cos(zi * S5T)), (float)(eT * sin(zi * S5T)));
        const double nr = ar - 1.0, ni = ai, den = lre * lre + lim * lim;
        const double qr = (nr * lre + ni * lim) / den, qi = (ni * lre - nr * lim) / den;
        const size_t fb = (size_t)gi * 4 * 64 * 8;
#pragma unroll
        for (int c = 0; c < 16; ++c) {
            const double br = p->in[30][((size_t)gi * 64 + pp) * 16 + c], bi = p->in[31][((size_t)gi * 64 + pp) * 16 + c];
            const double rr = qr * br - qi * bi, ri = qr * bi + qi * br;
            const int ln = (pp & 31) + 32 * (c >> 3), j = c & 7;
            bfrag[fb + ((size_t)(0 + (pp >> 5)) * 64 + ln) * 8 + j] = f2bf((float)rr);
            bfrag[fb + ((size_t)(2 + (pp >> 5)) * 64 + ln) * 8 + j] = f2bf((float)ri);
            const float cr = p->in[32][((size_t)gi * 16 + c) * 64 + pp], ci = p->in[33][((size_t)gi * 16 + c) * 64 + pp];
#pragma unroll
            for (int ri2 = 0; ri2 < 2; ++ri2) {
                const int k = 2 * pp + ri2, ks = k >> 5, kgq = (k & 31) >> 3, jj = k & 7;
                cfrag[fb + ((size_t)ks * 64 + c + 16 * kgq) * 8 + jj] = f2bf(ri2 ? -ci : cr);
            }
        }
    }
}

PHASE_FN void ph_tw(KP p) {
    p = launder_kp(p);
    cf2* tw = (cf2*)(p->ws + WS_TW);
    for (int i = BID * NTHREADS + TID; i < 8192; i += NBLK * NTHREADS) {
        const double a = -6.283185307179586476925 * (double)i / 16384.0;
        tw[i] = mk2((float)cos(a), (float)sin(a));
    }
}

PHASE_FN void ph_hinit(KP p) {
    p = launder_kp(p);
    bf16_t* xin = (bf16_t*)(p->ws + WS_XIN);
    const float* mvec = (const float*)(p->ws + WS_MVEC);
    const size_t n8 = (size_t)MROWS * DM / 8;
    for (size_t i = (size_t)BID * NTHREADS + TID; i < n8; i += (size_t)NBLK * NTHREADS) {
        const int r = (int)(i / 256), col = (int)(i % 256) * 8, b = r / TPB, pos = r % TPB;
        const float* src = pos < CTXL ? p->in[2] + ((size_t)b * CTXL + pos) * DM + col : p->in[0] + ((size_t)b * SEQ + (pos - CTXL)) * DM + col;
        const float* mv = mvec + (size_t)(pos < CTXL ? 2 : b) * 12288;
        const f32x4 a = __builtin_nontemporal_load((const f32x4*)src), c = __builtin_nontemporal_load((const f32x4*)(src + 4));
        float f[8];
#pragma unroll
        for (int j = 0; j < 4; ++j) { f[j] = a[j] * (1.0f + mv[2048 + col + j]) + mv[col + j]; f[4 + j] = c[j] * (1.0f + mv[2048 + col + 4 + j]) + mv[col + 4 + j]; }
        *(u32x4*)(xin + (size_t)r * DM + col) = pack8(f);
    }
}

template <class AddrF> struct EpiBf16G {
    static constexpr bool PERM = true, AFTER_DRAIN = false;
    AddrF F;
    __device__ __forceinline__ void operator()(const pg8::f32x4 (&acc)[2][2][4][2], const pg8::Unit& u, int wr, int wc, int fr, int fq) const {
        int pm_ = u.pm; asm volatile("" : "+s"(pm_));
        int cw = wc * 32 + 8 * fq; asm volatile("" : "+v"(cw));
        const int row0 = pm_ * 256 + wr * 64 + fr, col0 = u.pn * 256 + cw;
#pragma unroll
        for (int ai = 0; ai < 2; ++ai)
#pragma unroll
            for (int m = 0; m < 4; ++m)
#pragma unroll
                for (int bj = 0; bj < 2; ++bj) {
                    const pg8::f32x4 v0 = acc[ai][bj][m][0], v1 = acc[ai][bj][m][1];
                    u32x4 w; w.x = cvt_pk(v0[0], v0[1]); w.y = cvt_pk(v0[2], v0[3]); w.z = cvt_pk(v1[0], v1[1]); w.w = cvt_pk(v1[2], v1[3]);
                    *(u32x4*)F(row0 + ai * 128 + m * 16, col0 + bj * 128) = w;
                }
    }
};
struct AddrPlain { bf16_t* base; int ld; __device__ __forceinline__ bf16_t* operator()(int row, int col) const { return base + (size_t)row * ld + col; } };
struct EpiKV {
    static constexpr bool PERM = true, AFTER_DRAIN = false;
    bf16_t* k; bf16_t* v;
    __device__ __forceinline__ void operator()(const pg8::f32x4 (&acc)[2][2][4][2], const pg8::Unit& u, int wr, int wc, int fr, int fq) const {
        int pm_ = u.pm; asm volatile("" : "+s"(pm_));
        int cw = wc * 32 + 8 * fq; asm volatile("" : "+v"(cw));
        const int b = pm_ / 33, posb = (pm_ - b * 33) * 256 + wr * 64 + fr;
        const size_t rb = (size_t)(b * NH + u.pn) * TPB + posb;
        bf16_t* kp = k + rb * DQK + cw; bf16_t* vp = v + rb * DVH + cw;
#pragma unroll
        for (int ai = 0; ai < 2; ++ai)
#pragma unroll
            for (int m = 0; m < 4; ++m)
#pragma unroll
                for (int bj = 0; bj < 2; ++bj) {
                    const pg8::f32x4 v0 = acc[ai][bj][m][0], v1 = acc[ai][bj][m][1];
                    u32x4 w; w.x = cvt_pk(v0[0], v0[1]); w.y = cvt_pk(v0[2], v0[3]); w.z = cvt_pk(v1[0], v1[1]); w.w = cvt_pk(v1[2], v1[3]);
                    *(u32x4*)(bj == 0 ? kp + (size_t)(ai * 128 + m * 16) * DQK : vp + (size_t)(ai * 128 + m * 16) * DVH) = w;
                }
    }
};
struct EpiQ {
    static constexpr bool PERM = true, AFTER_DRAIN = false;
    bf16_t* q;
    __device__ __forceinline__ void operator()(const pg8::f32x4 (&acc)[2][2][4][2], const pg8::Unit& u, int wr, int wc, int fr, int fq) const {
        int pm_ = u.pm; asm volatile("" : "+s"(pm_));
        int cw = wc * 32 + 8 * fq; asm volatile("" : "+v"(cw));
        const int b = pm_ / 33, posb = (pm_ - b * 33) * 256 + wr * 64 + fr;
#pragma unroll
        for (int bj = 0; bj < 2; ++bj) {
            const int col = u.pn * 256 + bj * 128 + cw, h = col / DQK, d = col - h * DQK;
            bf16_t* qp = q + ((size_t)(b * NH + h) * TPB + posb) * DQK + d;
#pragma unroll
            for (int ai = 0; ai < 2; ++ai)
#pragma unroll
                for (int m = 0; m < 4; ++m) {
                    const pg8::f32x4 v0 = acc[ai][bj][m][0], v1 = acc[ai][bj][m][1];
                    u32x4 w; w.x = cvt_pk(v0[0], v0[1]); w.y = cvt_pk(v0[2], v0[3]); w.z = cvt_pk(v1[0], v1[1]); w.w = cvt_pk(v1[2], v1[3]);
                    *(u32x4*)(qp + (size_t)(ai * 128 + m * 16) * DQK) = w;
                }
        }
    }
};

struct PanelOrder : pg8::StaticOrder {
    int skip;
    __device__ __forceinline__ bool next(int i, pg8::Unit& u) const {
        const bool ok = pg8::StaticOrder::next(i, u);
        if (skip) u.pm = u.pm < 32 ? u.pm + 1 : u.pm + 2;
        return ok;
    }
};
template <class Epi> __device__ __forceinline__ void run_gemm(LAS unsigned char* lds, const bf16_t* A, const bf16_t* Bt, int M, int N, int K, const Epi& E, int skip_ctx = 0) {
    pg8::Gemm g{A, Bt, M, N, K}; PanelOrder S; S.init(skip_ctx ? M - 2 * CTXL : M, N, NBLK, BID); S.skip = skip_ctx;
    pg8::gemm_phase<Epi, PanelOrder, false>((PG8_LAS unsigned char*)lds, g, S, E, nullptr);
}

PHASE_FN void ph_e2a_rows(KP p, int e) {
    p = launder_kp(p);
    const int lane = TID & 63, wid = TID >> 6;
    const bf16_t* z = (const bf16_t*)(p->ws + WS_Z);
    bf16_t* qn = (bf16_t*)(p->ws + WS_QN); bf16_t* kvn = (bf16_t*)(p->ws + WS_KVN); bf16_t* Kb = (bf16_t*)(p->ws + WS_K);
    const float* qg = p->in[22] + e * QRANK; const float* kg = p->in[24] + e * KVRANK;
    float qgv[8], kgv[4];
#pragma unroll
    for (int j = 0; j < 8; ++j) qgv[j] = qg[lane * 8 + j];
#pragma unroll
    for (int j = 0; j < 4; ++j) kgv[j] = kg[lane * 4 + j];
    const int f16i = lane & 15;
    const float inv = exp2f(-(float)f16i * (13.287712379549449f / 16.0f));
    constexpr int RB = 4;
    for (int r0 = BID * NWAVES + wid; r0 < MROWS; r0 += RB * NBLK * NWAVES) {
        u32x4 wq[RB]; u32x2 wk[RB]; float xr[RB];
#pragma unroll
        for (int u = 0; u < RB; ++u) {
            const bf16_t* zr = z + (size_t)min(r0 + u * NBLK * NWAVES, MROWS - 1) * INWP;
            wq[u] = *(const u32x4*)(zr + OHY + lane * 8); wk[u] = *(const u32x2*)(zr + OQ + lane * 4); xr[u] = bf2f(zr[OKV + lane]);
        }
#pragma unroll
        for (int u = 0; u < RB; ++u) {
            const int r = r0 + u * NBLK * NWAVES;
            if (r >= MROWS) break;
            const int b = r / TPB, pos = r - b * TPB;
            {
                float f[8]; unpack8(wq[u], f);
                float ss = 0.f;
#pragma unroll
                for (int j = 0; j < 8; ++j) ss += f[j] * f[j];
                ss = wave_sum(ss);
                const float rs = rsqrtf(ss * (1.0f / QRANK) + RMS_EPS);
#pragma unroll
                for (int j = 0; j < 8; ++j) f[j] = f[j] * rs * qgv[j];
                *(u32x4*)(qn + (size_t)r * QRANK + lane * 8) = pack8(f);
            }
            {
                const u32x2 w = wk[u];
                float f0 = bflo(w.x), f1 = bfhi(w.x), f2 = bflo(w.y), f3 = bfhi(w.y);
                float ss = wave_sum(f0 * f0 + f1 * f1 + f2 * f2 + f3 * f3);
                const float rs = rsqrtf(ss * (1.0f / KVRANK) + RMS_EPS);
                u32x2 o; o.x = cvt_pk(f0 * rs * kgv[0], f1 * rs * kgv[1]); o.y = cvt_pk(f2 * rs * kgv[2], f3 * rs * kgv[3]);
                *(u32x2*)(kvn + (size_t)r * KVRANK + lane * 4) = o;
            }
            {
                const float x = xr[u];
                const float xp = __builtin_bit_cast(float, __builtin_amdgcn_ds_bpermute((lane ^ 16) << 2, __builtin_bit_cast(int, x)));
                float o = x;
                if (pos >= CTXL) {
                    const int t = pos - CTXL;
                    const float ang = (float)((lane & 32) ? (t & 63) : (t >> 6)) * inv;
                    const float rev = ang * 0.15915494309189535f; const float fr_ = rev - floorf(rev); const float sn = __builtin_amdgcn_sinf(fr_), cs = __builtin_amdgcn_cosf(fr_);
                    o = (lane & 16) ? x * cs + xp * sn : x * cs - xp * sn;
                }
                const bf16_t ob = f2bf(o);
#pragma unroll
                for (int h = 0; h < NH; ++h) Kb[((size_t)(b * NH + h) * TPB + pos) * DQK + 128 + lane] = ob;
            }
        }
    }
}

PHASE_FN void ph_e2a_conv(KP p, int e, LAS unsigned char* lds) {
    p = launder_kp(p);
    LAS bf16_t* T = (LAS bf16_t*)lds;
    const int tid = TID;
    const bf16_t* z = (const bf16_t*)(p->ws + WS_Z);
    bf16_t* zct = (bf16_t*)(p->ws + WS_ZCT);
    const float* cw = p->in[11] + (size_t)e * 3 * OHY; const float* cb = p->in[12] + (size_t)e * OHY;
    const int row = tid >> 3, chunk = tid & 7;
    u32x4 cur[2], prv[2], nxt[2];
#define CV_LOAD(u) do { const int ct_ = (u) % 24, rt_ = (u) / 24, b_ = rt_ / 132, tt_ = rt_ % 132; \
        const int pos_ = tt_ * 64 + row, lo_ = tt_ < 4 ? 0 : CTXL, hi_ = tt_ < 4 ? CTXL : TPB; \
        const bf16_t* zc_ = z + ((size_t)(b_ * TPB + pos_)) * INWP + ct_ * 128 + chunk * 16; const u32x4 zero_ = {0u, 0u, 0u, 0u}; \
        cur[0] = *(const u32x4*)zc_; cur[1] = *(const u32x4*)(zc_ + 8); \
        if (pos_ - 1 >= lo_) { prv[0] = *(const u32x4*)(zc_ - INWP); prv[1] = *(const u32x4*)(zc_ - INWP + 8); } else { prv[0] = zero_; prv[1] = zero_; } \
        if (pos_ + 1 < hi_) { nxt[0] = *(const u32x4*)(zc_ + INWP); nxt[1] = *(const u32x4*)(zc_ + INWP + 8); } else { nxt[0] = zero_; nxt[1] = zero_; } } while (0)
    int u = BID;
    if (u < 264 * 24) CV_LOAD(u);
    for (; u < 264 * 24; u += NBLK) {
        const int ct = u % 24, rt = u / 24, b = rt / 132, tt = rt % 132, pos0 = tt * 64, ch0 = ct * 128 + chunk * 16;
#pragma unroll
        for (int hh = 0; hh < 2; ++hh) {
            float fc[8], fp[8], fn[8]; unpack8(cur[hh], fc); unpack8(prv[hh], fp); unpack8(nxt[hh], fn);
#pragma unroll
            for (int j = 0; j < 8; ++j) {
                const int ch = ch0 + hh * 8 + j;
                const float o = fp[j] * cw[ch] + fc[j] * cw[OHY + ch] + fn[j] * cw[2 * OHY + ch] + cb[ch];
                T[(chunk * 16 + hh * 8 + j) * 72 + row] = f2bf(o);
            }
        }
        if (u + NBLK < 264 * 24) CV_LOAD(u + NBLK);
        __syncthreads();
#pragma unroll
        for (int k = 0; k < 2; ++k) {
            const int q = tid + k * NTHREADS, ch = q >> 3, pc = q & 7;
            const u32x4 w = *(const LAS u32x4*)(T + ch * 72 + pc * 8);
            __builtin_nontemporal_store(w, (u32x4*)(zct + ((size_t)(ct * 128 + ch) * NB + b) * TPB + pos0 + pc * 8));
        }
        __syncthreads();
    }
#undef CV_LOAD
}

PHASE_FN void ph_e4_transpose(KP p, LAS unsigned char* lds) {
    p = launder_kp(p);
    LAS bf16_t* T = (LAS bf16_t*)lds;
    const int tid = TID;
    const bf16_t* yt = (const bf16_t*)(p->ws + WS_YT);
    bf16_t* cat = (bf16_t*)(p->ws + WS_CAT);
    constexpr int NU = NB * 66 * 16;
    u32x4 ld[2];
#define E4_LOAD(u) do { const int ct_ = (u) % 16, tt_ = ((u) / 16) % 66, b_ = (u) / (16 * 66); \
        const bf16_t* s_ = yt + ((size_t)(ct_ * 64 + (tid >> 3)) * NB + b_) * TPB + tt_ * 128 + (tid & 7) * 8; ld[0] = __builtin_nontemporal_load((const u32x4*)s_); ld[1] = __builtin_nontemporal_load((const u32x4*)(s_ + 64)); } while (0)
    int u = BID;
    if (u < NU) E4_LOAD(u);
    for (; u < NU; u += NBLK) {
        const int ct = u % 16, tt = (u / 16) % 66, b = u / (16 * 66);
        const int pos0 = tt * 128, c0 = ct * 64;
        *(LAS u32x4*)(T + (tid >> 3) * 136 + (tid & 7) * 8) = ld[0]; *(LAS u32x4*)(T + (tid >> 3) * 136 + 64 + (tid & 7) * 8) = ld[1];
        if (u + NBLK < NU) E4_LOAD(u + NBLK);
        __syncthreads();
#pragma unroll
        for (int hp = 0; hp < 2; ++hp) {
            const int pos = hp * 64 + (tid >> 3), cc = tid & 7;
            unsigned short s[8];
#pragma unroll
            for (int j = 0; j < 8; ++j) s[j] = T[(cc * 8 + j) * 136 + pos];
            u32x4 w; w.x = s[0] | ((unsigned)s[1] << 16); w.y = s[2] | ((unsigned)s[3] << 16); w.z = s[4] | ((unsigned)s[5] << 16); w.w = s[6] | ((unsigned)s[7] << 16);
            *(u32x4*)(cat + ((size_t)(b * TPB + pos0 + pos)) * DM + c0 + cc * 8) = w;
        }
        __syncthreads();
    }
#undef E4_LOAD
}

template <bool GATED> PHASE_FN void ph_ln_mix(KP p, int layer) {
    p = launder_kp(p);
    const int lane = TID & 63, wid = TID >> 6;
    float* h = (float*)(p->ws + WS_H); bf16_t* xffn = (bf16_t*)(p->ws + WS_XFFN);
    unsigned char* xq8 = p->ws + WS_XQ8; float* xs = (float*)(p->ws + WS_XS);
    const bf16_t* ysrc = (const bf16_t*)(p->ws + (GATED ? WS_Z : WS_YMIX));
    const float* mvec = (const float*)(p->ws + WS_MVEC) + (size_t)layer * 3 * 12288;
    const float* lg = p->in[6] + (size_t)layer * DM; const float* lb = p->in[7] + (size_t)layer * DM;
    for (int r = BID * NWAVES + wid; r < MROWS; r += NBLK * NWAVES) {
        const int b = r / TPB, pos = r - b * TPB;
        if (layer == 3 && pos < CTXL) continue;
        const float* mv = mvec + (size_t)(pos < CTXL ? 2 : b) * 12288;
        const float* hrow = layer == 0 ? (pos < CTXL ? p->in[2] + ((size_t)b * CTXL + pos) * DM : p->in[0] + ((size_t)b * SEQ + (pos - CTXL)) * DM) : h + (size_t)r * DM;
        float x[32];
        float s = 0.f;
#pragma unroll
        for (int c = 0; c < 4; ++c) {
            const int col = c * 512 + lane * 8;
            const f32x4 h0 = __builtin_nontemporal_load((const f32x4*)(hrow + col)), h1 = __builtin_nontemporal_load((const f32x4*)(hrow + col + 4));
            float y[8];
            if (GATED) {
                float o[8], g[8];
                unpack8(__builtin_nontemporal_load((const u32x4*)(ysrc + (size_t)r * 4096 + col)), o); unpack8(__builtin_nontemporal_load((const u32x4*)(ysrc + (size_t)r * 4096 + 2048 + col)), g);
#pragma unroll
                for (int j = 0; j < 8; ++j) y[j] = o[j] / (1.0f + __expf(-g[j]));
            } else unpack8(__builtin_nontemporal_load((const u32x4*)(ysrc + (size_t)r * DM + col)), y);
            const f32x4 g0 = *(const f32x4*)(mv + 2 * 2048 + col), g1 = *(const f32x4*)(mv + 2 * 2048 + col + 4);
#pragma unroll
            for (int j = 0; j < 4; ++j) { x[c * 8 + j] = DN_ALPHA * h0[j] + g0[j] * y[j]; x[c * 8 + 4 + j] = DN_ALPHA * h1[j] + g1[j] * y[4 + j]; }
#pragma unroll
            for (int j = 0; j < 8; ++j) s += x[c * 8 + j];
        }
        const float mean = wave_sum(s) * (1.0f / DM);
        float q = 0.f;
#pragma unroll
        for (int j = 0; j < 32; ++j) { x[j] -= mean; q += x[j] * x[j]; }
        const float rstd = rsqrtf(wave_sum(q) * (1.0f / DM) + LN_EPS);
        float am = 0.f;
#pragma unroll
        for (int c = 0; c < 4; ++c) {
            const int col = c * 512 + lane * 8;
            float hn[8], xf[8];
#pragma unroll
            for (int j = 0; j < 8; ++j) {
                hn[j] = x[c * 8 + j] * rstd * lg[col + j] + lb[col + j];
                xf[j] = hn[j] * (1.0f + mv[4 * 2048 + col + j]) + mv[3 * 2048 + col + j];
                x[c * 8 + j] = xf[j]; am = fmaxf(am, fabsf(xf[j]));
            }
            __builtin_nontemporal_store((f32x4){hn[0], hn[1], hn[2], hn[3]}, (f32x4*)(h + (size_t)r * DM + col));
            __builtin_nontemporal_store((f32x4){hn[4], hn[5], hn[6], hn[7]}, (f32x4*)(h + (size_t)r * DM + col + 4));
            *(u32x4*)(xffn + (size_t)r * DM + col) = pack8(xf);
        }
        am = wave_max(am);
        const float sc = am > 0.f ? am * (1.0f / 224.0f) : 1.0f, inv = 1.0f / sc;
#pragma unroll
        for (int c = 0; c < 4; ++c) {
            u32x2 w;
            int t0 = __builtin_amdgcn_cvt_pk_fp8_f32(x[c * 8 + 0] * inv, x[c * 8 + 1] * inv, 0, false); t0 = __builtin_amdgcn_cvt_pk_fp8_f32(x[c * 8 + 2] * inv, x[c * 8 + 3] * inv, t0, true);
            int t1 = __builtin_amdgcn_cvt_pk_fp8_f32(x[c * 8 + 4] * inv, x[c * 8 + 5] * inv, 0, false); t1 = __builtin_amdgcn_cvt_pk_fp8_f32(x[c * 8 + 6] * inv, x[c * 8 + 7] * inv, t1, true);
            w.x = (unsigned)t0; w.y = (unsigned)t1;
            *(u32x2*)(xq8 + (size_t)r * DM + c * 512 + lane * 8) = w;
        }
        if (lane == 0) xs[r] = sc;
    }
}

namespace att {
constexpr int QBLK = 32, KVBLK = 64;
constexpr int SHM_V = KVBLK * 128 * 2, SHM_KN = KVBLK * 128 * 2, SHM_KR = KVBLK * 64 * 2;
#ifndef ATT_NQL
#define ATT_NQL 4
#endif
constexpr int NQL = ATT_NQL;
constexpr int NSLOT = 3;
constexpr int OFF_V = 0, OFF_KN = NSLOT * SHM_V, OFF_KR = OFF_KN + NSLOT * SHM_KN, OFF_WS = OFF_KR + NSLOT * SHM_KR, OFF_QS = OFF_WS + NWAVES * 64 * 4, SHM_ATTN = OFF_QS + NWAVES * NQL * 64 * 16;
#ifndef ATT_TWO_TILE
#define ATT_TWO_TILE 1
#endif
static_assert(SHM_ATTN <= LDS_BYTES - 64, "attention LDS map");
#ifndef ATT_SDEPTH
#define ATT_SDEPTH 1
#endif
constexpr int SDEPTH = ATT_SDEPTH;
constexpr float THR = 8.f;
#define KSWZ(row, colB) ((row) * 256 + ((colB) ^ (((row) & 7) << 4)))
#define KRSWZ(row, colB) ((row) * 128 + ((colB) ^ ((((row) >> 1) & 7) << 4)))
#define SBAR() __builtin_amdgcn_sched_barrier(0)
__device__ __forceinline__ int crow(int r, int hi) { return (r & 3) + 8 * (r >> 2) + 4 * hi; }

__device__ __forceinline__ void partialSM(f32x16& p0, f32x16& p1, float& m_reg, float& mn, float& alpha) {
    constexpr float C = MLA_SCALE * 1.4426950408889634f;
    float pmax = p0[0];
#pragma unroll
    for (int r = 1; r < 16; ++r) pmax = fmaxf(pmax, p0[r]);
#pragma unroll
    for (int r = 0; r < 16; ++r) pmax = fmaxf(pmax, p1[r]);
    { auto rr = __builtin_amdgcn_permlane32_swap(__float_as_uint(pmax), __float_as_uint(pmax), false, false);
      pmax = fmaxf(__uint_as_float(rr[0]), __uint_as_float(rr[1])); }
    if (__builtin_expect(__all(pmax - m_reg <= THR / MLA_SCALE), 1)) { mn = m_reg; alpha = 1.f; }
    else { mn = fmaxf(m_reg, pmax); alpha = __builtin_amdgcn_exp2f((m_reg - mn) * C); m_reg = mn; }
    const float mnC = -mn * C;
#pragma unroll
    for (int r = 0; r < 16; ++r) p0[r] = fmaf(p0[r], C, mnC);
#pragma unroll
    for (int r = 0; r < 16; ++r) p1[r] = fmaf(p1[r], C, mnC);
#pragma unroll
    for (int r = 0; r < 16; ++r) p0[r] = __builtin_amdgcn_exp2f(p0[r]);
}
__device__ __forceinline__ void finishSM(f32x16& p0, f32x16& p1, float alpha, float& l_reg, bf16x8& pa0, bf16x8& pa1, bf16x8& pa2, bf16x8& pa3) {
#pragma unroll
    for (int r = 0; r < 16; ++r) p1[r] = __builtin_amdgcn_exp2f(p1[r]);
    float ps = 0;
#pragma unroll
    for (int r = 0; r < 16; ++r) ps += p0[r];
#pragma unroll
    for (int r = 0; r < 16; ++r) ps += p1[r];
    { auto rr = __builtin_amdgcn_permlane32_swap(__float_as_uint(ps), __float_as_uint(ps), false, false);
      ps = __uint_as_float(rr[0]) + __uint_as_float(rr[1]); }
    l_reg = l_reg * alpha + ps;
#define PK4(P, BASE, OUT) do { unsigned a0 = cvt_pk(P[BASE + 0], P[BASE + 1]), a1 = cvt_pk(P[BASE + 2], P[BASE + 3]);   \
    unsigned b0 = cvt_pk(P[BASE + 4], P[BASE + 5]), b1 = cvt_pk(P[BASE + 6], P[BASE + 7]);                              \
    auto r0 = __builtin_amdgcn_permlane32_swap(a0, b0, false, false); auto r1 = __builtin_amdgcn_permlane32_swap(a1, b1, false, false); \
    u32x4 w = {r0[0], r1[0], r0[1], r1[1]}; OUT = *reinterpret_cast<bf16x8*>(&w); } while (0)
    PK4(p0, 0, pa0); PK4(p0, 8, pa1); PK4(p1, 0, pa2); PK4(p1, 8, pa3);
#undef PK4
}
__device__ __forceinline__ void qkt(f32x16& p0, f32x16& p1, const char* Kn, const char* Kr, const bf16x8* qr, const char* qs, int r32, int hi) {
    p0 = f32x16{}; p1 = f32x16{};
#pragma unroll
    for (int d0 = 0; d0 < 8; ++d0) { const int cb = (d0 * 16 + hi * 8) * 2;
        const bf16x8 b0 = *reinterpret_cast<const bf16x8*>(Kn + KSWZ(r32, cb));
        const bf16x8 b1 = *reinterpret_cast<const bf16x8*>(Kn + KSWZ(32 + r32, cb));
        const bf16x8 qf = (d0 >= 12 - NQL) ? *reinterpret_cast<const bf16x8*>(qs + (d0 - (12 - NQL)) * 1024) : qr[d0];
        p0 = __builtin_amdgcn_mfma_f32_32x32x16_bf16(b0, qf, p0, 0, 0, 0);
        p1 = __builtin_amdgcn_mfma_f32_32x32x16_bf16(b1, qf, p1, 0, 0, 0);
        if (d0 == 3 || d0 == 7) SBAR(); }
#pragma unroll
    for (int d0 = 0; d0 < 4; ++d0) { const int cb = (d0 * 16 + hi * 8) * 2;
        const bf16x8 b0 = *reinterpret_cast<const bf16x8*>(Kr + KRSWZ(r32, cb));
        const bf16x8 b1 = *reinterpret_cast<const bf16x8*>(Kr + KRSWZ(32 + r32, cb));
        const bf16x8 qf = (8 + d0 >= 12 - NQL) ? *reinterpret_cast<const bf16x8*>(qs + (8 + d0 - (12 - NQL)) * 1024) : qr[8 + d0];
        p0 = __builtin_amdgcn_mfma_f32_32x32x16_bf16(b0, qf, p0, 0, 0, 0);
        p1 = __builtin_amdgcn_mfma_f32_32x32x16_bf16(b1, qf, p1, 0, 0, 0); }
}
__device__ __forceinline__ int v_st(int k, int c) { const int kk = (k & ~0xC) | ((k & 4) << 1) | ((k & 8) >> 1); return ((kk >> 3) * 4 + (c >> 5)) * 512 + ((kk & 7) * 32 + (c & 31)) * 2; }
__device__ __forceinline__ int v_rd_base(int lane) { return ((lane & 3) << 3) | (((lane >> 2) & 3) << 6) | (((lane >> 4) & 1) << 5) | (((lane >> 5) & 1) << 8); }
constexpr int v_rd_off(int d0, int ks, int half) { return d0 * 512 + ks * 4096 + half * 2048; }
template <int OFF> __device__ __forceinline__ s16x4 tr_read(int vb) {
    s16x4 r; asm volatile("ds_read_b64_tr_b16 %0, %1 offset:%2" : "=&v"(r) : "v"(vb), "i"(OFF) : "memory"); return r;
}
template <int D0> __device__ __forceinline__ void pv_one(f32x16& od, int vb, bf16x8 pa0, bf16x8 pa1, bf16x8 pa2, bf16x8 pa3) {
    const s16x4 l0 = tr_read<v_rd_off(D0, 0, 0)>(vb), h0 = tr_read<v_rd_off(D0, 0, 1)>(vb), l1 = tr_read<v_rd_off(D0, 1, 0)>(vb), h1 = tr_read<v_rd_off(D0, 1, 1)>(vb);
    const s16x4 l2 = tr_read<v_rd_off(D0, 2, 0)>(vb), h2 = tr_read<v_rd_off(D0, 2, 1)>(vb), l3 = tr_read<v_rd_off(D0, 3, 0)>(vb), h3 = tr_read<v_rd_off(D0, 3, 1)>(vb);
    asm volatile("s_waitcnt lgkmcnt(0)" ::: "memory"); SBAR();
#define PK(L, H) (bf16x8){L[0], L[1], L[2], L[3], H[0], H[1], H[2], H[3]}
    od = __builtin_amdgcn_mfma_f32_32x32x16_bf16(pa0, PK(l0, h0), od, 0, 0, 0);
    od = __builtin_amdgcn_mfma_f32_32x32x16_bf16(pa1, PK(l1, h1), od, 0, 0, 0);
    od = __builtin_amdgcn_mfma_f32_32x32x16_bf16(pa2, PK(l2, h2), od, 0, 0, 0);
    od = __builtin_amdgcn_mfma_f32_32x32x16_bf16(pa3, PK(l3, h3), od, 0, 0, 0);
#undef PK
}
__device__ __forceinline__ void pv_d0(f32x16* o, int vb, bf16x8 pa0, bf16x8 pa1, bf16x8 pa2, bf16x8 pa3) {
    pv_one<0>(o[0], vb, pa0, pa1, pa2, pa3); pv_one<1>(o[1], vb, pa0, pa1, pa2, pa3); pv_one<2>(o[2], vb, pa0, pa1, pa2, pa3); pv_one<3>(o[3], vb, pa0, pa1, pa2, pa3);
}

__device__ __forceinline__ void attn_body(const bf16_t* __restrict__ Qb, const bf16_t* __restrict__ Kh, const bf16_t* __restrict__ Vh,
                                          bf16_t* __restrict__ Ob, int ldo, int seq, int rope_t0, char* lds) {
    const int tid = TID, wid = tid >> 6, lane = tid & 63, r32 = lane & 31, hi = lane >> 5;
    char* V_lds = lds + OFF_V; char* Kn_lds = lds + OFF_KN; char* Kr_lds = lds + OFF_KR;
    float* ws = (float*)(lds + OFF_WS) + wid * 64; float* li_l = ws; float* al_l = ws + 32;
    float m_reg = -1e30f, l_reg = 0; f32x16 o[4] = {}; bf16x8 qr[12];
    char* qs = lds + OFF_QS + (wid * NQL * 64 + lane) * 16;
    const bf16_t* Qw = Qb + (size_t)(wid * QBLK + r32) * DQK + hi * 8;
#pragma unroll
    for (int d0 = 0; d0 < 12; ++d0) qr[d0] = *reinterpret_cast<const bf16x8*>(Qw + d0 * 16);
    if (rope_t0 >= 0) {
        const int t = rope_t0 + wid * QBLK + r32;
        const float frow = (float)(t >> 6), fcol = (float)(t & 63);
#pragma unroll
        for (int ax = 0; ax < 2; ++ax) {
            u32x4 w0 = *reinterpret_cast<u32x4*>(&qr[8 + 2 * ax]), w1 = *reinterpret_cast<u32x4*>(&qr[9 + 2 * ax]);
            float x0[8], x1[8]; unpack8(w0, x0); unpack8(w1, x1);
#pragma unroll
            for (int j = 0; j < 8; ++j) {
                const float inv = exp2f(-(float)(hi * 8 + j) * (13.287712379549449f / 16.0f));
                const float ang = (ax ? fcol : frow) * inv;
                const float rev = ang * 0.15915494309189535f; const float fr_ = rev - floorf(rev); const float sn = __builtin_amdgcn_sinf(fr_), cs = __builtin_amdgcn_cosf(fr_);
                const float y0 = x0[j] * cs - x1[j] * sn, y1 = x1[j] * cs + x0[j] * sn;
                x0[j] = y0; x1[j] = y1;
            }
            w0 = pack8(x0); w1 = pack8(x1);
            qr[8 + 2 * ax] = *reinterpret_cast<bf16x8*>(&w0); qr[9 + 2 * ax] = *reinterpret_cast<bf16x8*>(&w1);
        }
    }
#pragma unroll
    for (int d0 = 12 - NQL; d0 < 12; ++d0) *reinterpret_cast<bf16x8*>(qs + (d0 - (12 - NQL)) * 1024) = qr[d0];
    const int sr = tid >> 4, sc = (tid & 15) * 8, vst0 = v_st(sr, sc), vst1 = v_st(32 + sr, sc);
    const int krr = tid >> 3, krc = (tid & 7) * 8;
    const int vb0 = (int)(uintptr_t)V_lds + v_rd_base(lane);
    struct { bf16x8 vs0, vs1, ks0, ks1, kr; } sr_[1];
    const unsigned ovs0 = (unsigned)((sr * DVH + sc) * 2), ovs1 = (unsigned)(((32 + sr) * DVH + sc) * 2), oks0 = (unsigned)((sr * DQK + sc) * 2), oks1 = (unsigned)(((32 + sr) * DQK + sc) * 2),
                   okr = (unsigned)((krr * DQK + 128 + krc) * 2);
    const __amdgpu_buffer_rsrc_t rK_ = __builtin_amdgcn_make_buffer_rsrc((void*)Kh, 0, seq * DQK * 2, 0x00020000);
    const __amdgpu_buffer_rsrc_t rV_ = __builtin_amdgcn_make_buffer_rsrc((void*)Vh, 0, seq * DVH * 2, 0x00020000);
#define BLD_(r, vo, so) __builtin_bit_cast(bf16x8, __builtin_amdgcn_raw_buffer_load_b128((r), (int)(vo), (so), 0))
#define SLOAD(i, k0) do { const int sk_ = (k0) * (DQK * 2), sv_ = (k0) * (DVH * 2); \
    sr_[i].vs0 = BLD_(rV_, ovs0, sv_); sr_[i].vs1 = BLD_(rV_, ovs1, sv_); \
    sr_[i].ks0 = BLD_(rK_, oks0, sk_); sr_[i].ks1 = BLD_(rK_, oks1, sk_); sr_[i].kr = BLD_(rK_, okr, sk_); } while (0)
#define SWRITE(b, i) do { *(bf16x8*)(V_lds + (b) * SHM_V + vst0) = sr_[i].vs0; *(bf16x8*)(V_lds + (b) * SHM_V + vst1) = sr_[i].vs1; const int kc = sc * 2; \
    *(bf16x8*)(Kn_lds + (b) * SHM_KN + KSWZ(sr, kc)) = sr_[i].ks0; *(bf16x8*)(Kn_lds + (b) * SHM_KN + KSWZ(32 + sr, kc)) = sr_[i].ks1; \
    *(bf16x8*)(Kr_lds + (b) * SHM_KR + KRSWZ(krr, krc * 2)) = sr_[i].kr; } while (0)
#define SWAIT() do { if constexpr (SDEPTH == 2) asm volatile("s_waitcnt vmcnt(5)" ::: "memory"); else asm volatile("s_waitcnt vmcnt(0)" ::: "memory"); } while (0)
#define RESC(a) do { if (__any((a) < 1.f)) { if (hi == 0) al_l[r32] = (a); asm volatile("s_waitcnt lgkmcnt(0)" ::: "memory"); \
    _Pragma("unroll") for (int d = 0; d < 4; ++d) _Pragma("unroll") for (int r = 0; r < 16; ++r) o[d][r] *= al_l[crow(r, hi)]; } } while (0)
    const int NT = seq / KVBLK;
#if ATT_TWO_TILE
    f32x16 pA0, pA1, pB0, pB1; float mnA, mnB, alA, alB; bf16x8 pa0, pa1, pa2, pa3;
    SLOAD(0, 0); asm volatile("s_waitcnt vmcnt(0)" ::: "memory"); SWRITE(0, 0); __syncthreads();
    qkt(pA0, pA1, Kn_lds, Kr_lds, qr, qs, r32, hi); partialSM(pA0, pA1, m_reg, mnA, alA);
    SLOAD(0, KVBLK); asm volatile("s_waitcnt vmcnt(0)" ::: "memory"); SWRITE(1, 0); __syncthreads();
    int sp = 0, sj = 1, sn = 2;
    for (int j = 1; j + 1 < NT; j += 2) {
        SBAR(); qkt(pB0, pB1, Kn_lds + sj * SHM_KN, Kr_lds + sj * SHM_KR, qr, qs, r32, hi);
        finishSM(pA0, pA1, alA, l_reg, pa0, pa1, pa2, pa3); SBAR();
        SLOAD(0, (j + 1) * KVBLK); SBAR();
        pv_d0(o, vb0 + sp * SHM_V, pa0, pa1, pa2, pa3); partialSM(pB0, pB1, m_reg, mnB, alB);
        asm volatile("s_waitcnt vmcnt(0)" ::: "memory"); SWRITE(sn, 0);
        RESC(alB); __syncthreads();
        SBAR(); qkt(pA0, pA1, Kn_lds + sn * SHM_KN, Kr_lds + sn * SHM_KR, qr, qs, r32, hi);
        finishSM(pB0, pB1, alB, l_reg, pa0, pa1, pa2, pa3); SBAR();
        SLOAD(0, (j + 2) * KVBLK); SBAR();
        pv_d0(o, vb0 + sj * SHM_V, pa0, pa1, pa2, pa3); partialSM(pA0, pA1, m_reg, mnA, alA);
        asm volatile("s_waitcnt vmcnt(0)" ::: "memory"); SWRITE(sp, 0);
        RESC(alA); __syncthreads();
        { const int t0_ = sp; sp = sn; sn = sj; sj = t0_; }
    }
    SBAR(); qkt(pB0, pB1, Kn_lds + sj * SHM_KN, Kr_lds + sj * SHM_KR, qr, qs, r32, hi);
    finishSM(pA0, pA1, alA, l_reg, pa0, pa1, pa2, pa3); SBAR();
    pv_d0(o, vb0 + sp * SHM_V, pa0, pa1, pa2, pa3); partialSM(pB0, pB1, m_reg, mnB, alB);
    RESC(alB);
    finishSM(pB0, pB1, alB, l_reg, pa0, pa1, pa2, pa3); SBAR();
    pv_d0(o, vb0 + sj * SHM_V, pa0, pa1, pa2, pa3);
    __syncthreads();
#else
    f32x16 p0, p1; float mn, al; bf16x8 pa0, pa1, pa2, pa3;
    SLOAD(0, 0); asm volatile("s_waitcnt vmcnt(0)" ::: "memory"); SWRITE(0, 0); __syncthreads();
    for (int j = 0; j < NT; ++j) {
        const int bsel = j & 1;
        if (j + 1 < NT) SLOAD(0, (j + 1) * KVBLK);
        SBAR();
        qkt(p0, p1, Kn_lds + bsel * SHM_KN, Kr_lds + bsel * SHM_KR, qr, qs, r32, hi);
        partialSM(p0, p1, m_reg, mn, al);
        RESC(al);
        finishSM(p0, p1, al, l_reg, pa0, pa1, pa2, pa3); SBAR();
        pv_d0(o, vb0 + bsel * SHM_V, pa0, pa1, pa2, pa3);
        if (j + 1 < NT) { asm volatile("s_waitcnt vmcnt(0)" ::: "memory"); if (bsel) { SWRITE(0, 0); } else { SWRITE(1, 0); } }
        __syncthreads();
    }
#endif
    if (hi == 0) li_l[r32] = l_reg; asm volatile("s_waitcnt lgkmcnt(0)" ::: "memory");
    float rli[16];
#pragma unroll
    for (int r = 0; r < 16; ++r) rli[r] = __builtin_amdgcn_rcpf(li_l[crow(r, hi)]);
    bf16_t* Ow = Ob + (size_t)(wid * QBLK) * ldo;
#pragma unroll
    for (int r = 0; r < 16; ++r) { const int orow = crow(r, hi);
#pragma unroll
        for (int d0 = 0; d0 < 4; ++d0) Ow[(size_t)orow * ldo + d0 * 32 + r32] = f2bf(o[d0][r] * rli[r]); }
#undef SLOAD
#undef BLD_
#undef SWRITE
#undef SWAIT
#undef RESC
}
}

PHASE_FN void ph_attention(KP p, LAS unsigned char* ldsl) {
    p = launder_kp(p);
    char* lds = (char*)ldsl;
    const bf16_t* Q = (const bf16_t*)(p->ws + WS_Q); const bf16_t* K = (const bf16_t*)(p->ws + WS_K); const bf16_t* V = (const bf16_t*)(p->ws + WS_V);
    bf16_t* cat = (bf16_t*)(p->ws + WS_CAT);
    const int nrounds = (512 + 16 + NBLK - 1) / NBLK;
    for (int r = 0; r < nrounds; ++r) {
        int u = BID + r * NBLK;
        if (NBLK == 256 && r == 2) u = 512 + ((BID + 128) & 255);
        if (u >= 512 + 16) continue;
        int b, h, q0, seq, rope;
        if (u < 512) { const int bh = 2 * (u & 7) + (u >> 8); b = bh >> 3; h = bh & 7; const int qb = (u >> 3) & 31; q0 = CTXL + qb * 256; seq = TPB; rope = qb * 256; }
        else { const int v = u - 512; b = v >> 3; h = v & 7; q0 = 0; seq = CTXL; rope = -1; }
        const size_t hb = (size_t)(b * NH + h) * TPB;
        __syncthreads();
        att::attn_body(Q + (hb + q0) * DQK, K + hb * DQK, V + hb * DVH, cat + ((size_t)(b * TPB + q0)) * DM + 1024 + h * 128, DM, seq, rope, lds);
    }
    __syncthreads();
}

#define PADI(i) ((i) + ((i) >> 5))
namespace hy {
__device__ __forceinline__ cf2 cmul(cf2 a, cf2 w) { const cf2 wr = {-w.y, w.x}; const cf2 r = (cf2){a.x, a.x} * w; return __builtin_elementwise_fma((cf2){a.y, a.y}, wr, r); }
__device__ __forceinline__ cf2 cmulc(cf2 a, cf2 w) { const cf2 wc = {w.x, -w.y}, wr = {w.y, w.x}; const cf2 r = (cf2){a.x, a.x} * wc; return __builtin_elementwise_fma((cf2){a.y, a.y}, wr, r); }
template <int D, int K> __device__ __forceinline__ cf2 rotc(cf2 w) {
    constexpr float c = 0.70710678118654752f;
    if constexpr (K == 0) return w;
    else if constexpr (D == 4 && K == 1) return mk2(w.y, -w.x);
    else if constexpr (D == 8 && K == 2) return mk2(w.y, -w.x);
    else if constexpr (D == 8 && K == 1) return mk2(c * (w.x + w.y), c * (w.y - w.x));
    else { static_assert(D == 8 && K == 3, "rotc"); return mk2(c * (w.y - w.x), -c * (w.x + w.y)); }
}
__device__ __forceinline__ constexpr float w32c(int k) { constexpr float c[16] = {1.0f, 0.98078528040323043f, 0.92387953251128674f, 0.83146961230254524f, 0.70710678118654752f, 0.55557023301960222f, 0.38268343236508977f, 0.19509032201612827f,
    0.0f, -0.19509032201612827f, -0.38268343236508977f, -0.55557023301960222f, -0.70710678118654752f, -0.83146961230254524f, -0.92387953251128674f, -0.98078528040323043f}; return c[k]; }
__device__ __forceinline__ constexpr float w32s(int k) { constexpr float s[16] = {0.0f, -0.19509032201612827f, -0.38268343236508977f, -0.55557023301960222f, -0.70710678118654752f, -0.83146961230254524f, -0.92387953251128674f, -0.98078528040323043f,
    -1.0f, -0.98078528040323043f, -0.92387953251128674f, -0.83146961230254524f, -0.70710678118654752f, -0.55557023301960222f, -0.38268343236508977f, -0.19509032201612827f}; return s[k]; }

template <bool INV> __device__ __forceinline__ void bfly(cf2& a, cf2& b, cf2 w) {
    if (!INV) { const cf2 u = a, v = b; a = u + v; b = cmul(u - v, w); }
    else { const cf2 u = a, v = cmulc(b, w); a = u + v; b = u - v; }
}
template <bool INV> __device__ __forceinline__ void r5_regs(cf2 (&x)[32]) {
#pragma unroll
    for (int ss = 0; ss < 5; ++ss) {
        const int s = INV ? 4 - ss : ss, half = 32 >> (s + 1);
#pragma unroll
        for (int q = 0; q < 32; ++q) if ((q & half) == 0) bfly<INV>(x[q], x[q + half], mk2(w32c((q & (half - 1)) << s), w32s((q & (half - 1)) << s)));
    }
}
template <int R, bool INV, int LM, int LOGTOT>
__device__ __forceinline__ void fft_pass(LAS cf2* X) {
    constexpr int G = 1 << R, lm = LM;
    constexpr int lst = lm - R, st = 1 << lst;
    static_assert(st >= 32, "padded stride must be linear in q");
    constexpr int pst = st + (st >> 5);
    constexpr int ngroups = 1 << (LOGTOT - R), NIT = ngroups / NTHREADS;
    static_assert(NIT >= 1 && NIT * NTHREADS == ngroups, "groups per thread");
    const float rs0 = __uint_as_float((unsigned)(127 - lm) << 23);
    cf2 xb[2][G];
    auto xaddr = [&](int it) -> LAS cf2* { const int gi = TID + it * NTHREADS; const int blk = gi >> lst, j = gi & (st - 1); return X + PADI((blk << lm) + j); };
    { LAS cf2* p0 = xaddr(0);
#pragma unroll
      for (int q = 0; q < G; ++q) xb[0][q] = ((volatile LAS cf2*)p0)[q * pst];       }
#pragma unroll
    for (int it = 0; it < NIT; ++it) {
        cf2 (&x)[G] = xb[it & 1];
        if (it + 1 < NIT) { LAS cf2* pn = xaddr(it + 1);
#pragma unroll
            for (int q = 0; q < G; ++q) xb[(it + 1) & 1][q] = ((volatile LAS cf2*)pn)[q * pst]; }
        const int gi = TID + it * NTHREADS, j = gi & (st - 1);
        cf2 wp[R];
        { const float rev = (float)j * rs0; wp[0] = mk2(__builtin_amdgcn_cosf(rev), -__builtin_amdgcn_sinf(rev)); }
#pragma unroll
        for (int s = 1; s < R; ++s) wp[s] = cmul(wp[s - 1], wp[s - 1]);
#pragma unroll
        for (int ss = 0; ss < R; ++ss) {
            const int s = INV ? R - 1 - ss : ss;
            if (s == 0) {
                if constexpr (R == 3) { bfly<INV>(x[0], x[4], wp[0]); bfly<INV>(x[1], x[5], rotc<8, 1>(wp[0])); bfly<INV>(x[2], x[6], rotc<8, 2>(wp[0])); bfly<INV>(x[3], x[7], rotc<8, 3>(wp[0])); }
                else if constexpr (R == 2) { bfly<INV>(x[0], x[2], wp[0]); bfly<INV>(x[1], x[3], rotc<4, 1>(wp[0])); }
                else { bfly<INV>(x[0], x[1], wp[0]); }
            } else if (s == 1) {
                if constexpr (R == 3) { bfly<INV>(x[0], x[2], wp[1]); bfly<INV>(x[1], x[3], rotc<4, 1>(wp[1])); bfly<INV>(x[4], x[6], wp[1]); bfly<INV>(x[5], x[7], rotc<4, 1>(wp[1])); }
                else if constexpr (R == 2) { bfly<INV>(x[0], x[1], wp[1]); bfly<INV>(x[2], x[3], wp[1]); }
            } else {
                if constexpr (R == 3) { bfly<INV>(x[0], x[1], wp[2]); bfly<INV>(x[2], x[3], wp[2]); bfly<INV>(x[4], x[5], wp[2]); bfly<INV>(x[6], x[7], wp[2]); }
            }
        }
        LAS cf2* pc = xaddr(it);
#pragma unroll
        for (int q = 0; q < G; ++q) pc[q * pst] = x[q];
    }
    __syncthreads();
}
template <int LOGN, int LT> __device__ __forceinline__ void fft_fwd_upper(LAS cf2* X) {
    static_assert(LOGN == 14 || LOGN == 9, "pass plan");
    if constexpr (LOGN == 14) { fft_pass<3, false, 14, LT>(X); fft_pass<3, false, 11, LT>(X); fft_pass<3, false, 8, LT>(X); }
    else { fft_pass<3, false, 9, LT>(X); fft_pass<1, false, 6, LT>(X); }
}
template <int LOGN, int LT> __device__ __forceinline__ void fft_inv_upper(LAS cf2* X) {
    if constexpr (LOGN == 14) { fft_pass<3, true, 8, LT>(X); fft_pass<3, true, 11, LT>(X); fft_pass<3, true, 14, LT>(X); }
    else { fft_pass<1, true, 6, LT>(X); fft_pass<3, true, 9, LT>(X); }
}
}

template <int NCH, int LOGL>
__device__ __forceinline__ void hyena_unit(KP p, int e, int c0, LAS unsigned char* lds, cf2* scr) {
    constexpr int L = 1 << LOGL, N = 2 * L, LOGN = LOGL + 1, TOT = NCH * N;
    constexpr int LOGTOT = LOGN + (NCH == 8 ? 3 : 0), NGR = TOT / 32;
    constexpr bool lat = (NCH == 1);
    constexpr int pos0 = lat ? CTXL : 0;
    LAS cf2* X = (LAS cf2*)lds;
    LAS float* red = (LAS float*)(lds + 147456);
    const int tid = TID, lane = tid & 63, wid = tid >> 6;
    const bf16_t* zct = (const bf16_t*)(p->ws + WS_ZCT);
    bf16_t* yt = (bf16_t*)(p->ws + WS_YT);
    const bf16_t* hk = (const bf16_t*)(p->ws + WS_HK) + (size_t)e * (HK_LAT + HK_CTX) + (lat ? 0 : HK_LAT);
    cf2* KS0 = scr; cf2* KS1 = scr + 16384; cf2* Y1 = scr + 32768;
#pragma unroll 1
    for (int rep_ = 0; rep_ < ((REP_MASK & 2048) ? 2 : 1); ++rep_) {
    {
        float as0 = 0.f, as1 = 0.f;
        if constexpr (lat) {
            const bf16_t* h0 = hk + ((size_t)c0 * 2) * L; const bf16_t* h1 = hk + ((size_t)(1024 + c0) * 2) * L;
            u32x4 f0[2], b0[2], f1[2], b1[2];
#pragma unroll
            for (int kk = 0; kk < 2; ++kk) { const int i = 8 * tid + 4096 * kk; f0[kk] = *(const u32x4*)(h0 + i); b0[kk] = *(const u32x4*)(h0 + L + i); f1[kk] = *(const u32x4*)(h1 + i); b1[kk] = *(const u32x4*)(h1 + L + i); }
#pragma unroll
            for (int kk = 0; kk < 2; ++kk) {
                float vf0[8], vb0[8], vf1[8], vb1[8]; unpack8(f0[kk], vf0); unpack8(b0[kk], vb0); unpack8(f1[kk], vf1); unpack8(b1[kk], vb1);
#pragma unroll
                for (int e8 = 0; e8 < 8; ++e8) {
                    const int i = 8 * tid + 4096 * kk + e8;
                    as0 += fabsf(vf0[e8]) + fabsf(vb0[e8]); as1 += fabsf(vf1[e8]) + fabsf(vb1[e8]);
                    X[PADI(i)] = mk2(vf0[e8], vf1[e8]);
                    if (i == 0) X[PADI(L)] = mk2(0.f, 0.f); else X[PADI(N - i)] = mk2(vb0[e8], vb1[e8]);
                }
            }
        } else
        for (int k = 0; k < NCH * L / NTHREADS; ++k) {
            const int ch = wid, i = lane + 64 * k;
            const bf16_t* h0 = hk + ((size_t)(c0 + ch) * 2) * L; const bf16_t* h1 = hk + ((size_t)(1024 + c0 + ch) * 2) * L;
            const float f0 = bf2f(h0[i]), b0 = bf2f(h0[L + i]), f1 = bf2f(h1[i]), b1 = bf2f(h1[L + i]);
            as0 += fabsf(f0) + fabsf(b0); as1 += fabsf(f1) + fabsf(b1);
            X[PADI(ch * N + i)] = mk2(f0, f1);
            if (i == 0) X[PADI(ch * N + L)] = mk2(0.f, 0.f); else X[PADI(ch * N + N - i)] = mk2(b0, b1);
        }
        as0 = wave_sum(as0); as1 = wave_sum(as1);
        __syncthreads();
        if (lane == 0) { red[wid] = as0; red[8 + wid] = as1; }
        __syncthreads();
    }
    hy::fft_fwd_upper<LOGN, LOGTOT>(X);
    for (int gi = tid; gi < NGR; gi += NTHREADS) {
        cf2 x[32];
#pragma unroll
        for (int k = 0; k < 32; ++k) x[k] = ((volatile LAS cf2*)X)[PADI(gi * 32 + k)];
        hy::r5_regs<false>(x);
#pragma unroll
        for (int k = 0; k < 32; ++k) X[PADI(gi * 32 + k)] = x[k];
    }
    __syncthreads();
    for (int gi = tid; gi < NGR; gi += NTHREADS) {
        const int ch = (gi * 32) >> LOGN;
        float n0, n1;
        if constexpr (lat) { n0 = 0.f; n1 = 0.f;
#pragma unroll
            for (int w = 0; w < NWAVES; ++w) { n0 += red[w]; n1 += red[8 + w]; } }
        else { n0 = red[ch]; n1 = red[8 + ch]; }
        const float r0 = 0.5f / (n0 * (float)N), r1 = 0.5f / (n1 * (float)N);
#pragma unroll 8
        for (int k = 0; k < 32; ++k) {
            const int q = gi * 32 + k, ql = q & (N - 1);
            const int f = (int)(__brev((unsigned)ql) >> (32 - LOGN));
            const int qp = (q - ql) + (int)(__brev((unsigned)((N - f) & (N - 1))) >> (32 - LOGN));
            const cf2 a = X[PADI(q)], b = X[PADI(qp)];
            KS0[k * NGR + gi] = mk2((a.x + b.x) * r0, (a.y - b.y) * r0);
            KS1[k * NGR + gi] = mk2((a.y + b.y) * r1, (b.x - a.x) * r1);
        }
    }
    __syncthreads();
    }
    if constexpr (lat) {
        const bf16_t* vp = zct + ((size_t)(2048 + c0) * NB) * TPB + pos0;
        u32x4 r0[2], r1[2];
#pragma unroll
        for (int kk = 0; kk < 2; ++kk) { const int i = 8 * tid + 4096 * kk; r0[kk] = *(const u32x4*)(vp + i); r1[kk] = *(const u32x4*)(vp + TPB + i); }
#pragma unroll
        for (int kk = 0; kk < 2; ++kk) {
            const int i = 8 * tid + 4096 * kk; float a[8], b[8]; unpack8(r0[kk], a); unpack8(r1[kk], b);
#pragma unroll
            for (int e = 0; e < 8; ++e) { X[PADI(i + e)] = mk2(a[e], b[e]); X[PADI(L + i + e)] = mk2(0.f, 0.f); }
        }
    } else
    for (int g = tid; g < NCH * L; g += NTHREADS) {
        const int ch = g >> LOGL, i = g & (L - 1);
        const bf16_t* vp = zct + ((size_t)(2048 + c0 + ch) * NB) * TPB + pos0;
        X[PADI(ch * N + i)] = mk2(bf2f(vp[i]), bf2f(vp[TPB + i])); X[PADI(ch * N + L + i)] = mk2(0.f, 0.f);
    }
    __syncthreads();
#pragma unroll 1
    for (int o = 0; o < 2; ++o) {
        hy::fft_fwd_upper<LOGN, LOGTOT>(X);
        const cf2* KS = o ? KS1 : KS0;
        for (int gi = tid; gi < NGR; gi += NTHREADS) {
            cf2 x[32];
#pragma unroll
            for (int k = 0; k < 32; ++k) x[k] = ((volatile LAS cf2*)X)[PADI(gi * 32 + k)];
            hy::r5_regs<false>(x);
#pragma unroll
            for (int k = 0; k < 32; ++k) x[k] = hy::cmul(x[k], KS[k * NGR + gi]);
            hy::r5_regs<true>(x);
#pragma unroll
            for (int k = 0; k < 32; ++k) X[PADI(gi * 32 + k)] = x[k];
        }
        __syncthreads();
        hy::fft_inv_upper<LOGN, LOGTOT>(X);
        if constexpr (lat) {
            const int c = c0;
#pragma unroll
            for (int kk = 0; kk < 2; ++kk) {
                const int i = 8 * tid + 4096 * kk;
                if (o == 0) {
                    const bf16_t* vp = zct + ((size_t)(2048 + c) * NB) * TPB + pos0; const bf16_t* x1p = zct + ((size_t)c * NB) * TPB + pos0;
                    const float bias0 = p->in[21][(size_t)e * 2048 + c];
                    float v0[8], v1[8], g0[8], g1[8];
                    unpack8(*(const u32x4*)(vp + i), v0); unpack8(*(const u32x4*)(vp + TPB + i), v1); unpack8(*(const u32x4*)(x1p + i), g0); unpack8(*(const u32x4*)(x1p + TPB + i), g1);
#pragma unroll
                    for (int q = 0; q < 8; ++q) {
                        const cf2 cv = X[PADI(i + q)];
                        const float y0 = g0[q] * (cv.x + v0[q] * bias0), y1 = g1[q] * (cv.y + v1[q] * bias0);
                        Y1[i + q] = mk2(y0, y1);
                        X[PADI(i + q)] = mk2(y0, y1); X[PADI(L + i + q)] = mk2(0.f, 0.f);
                    }
                } else {
                    const bf16_t* x2p = zct + ((size_t)(1024 + c) * NB) * TPB + pos0;
                    const float bias1 = p->in[21][(size_t)e * 2048 + 1024 + c];
                    float g0[8], g1[8], o0[8], o1[8];
                    unpack8(*(const u32x4*)(x2p + i), g0); unpack8(*(const u32x4*)(x2p + TPB + i), g1);
                    f32x4 yv[4];
#pragma unroll
                    for (int q = 0; q < 4; ++q) yv[q] = *(const f32x4*)(Y1 + i + 2 * q);
#pragma unroll
                    for (int q = 0; q < 8; ++q) {
                        const cf2 cv = X[PADI(i + q)];
                        o0[q] = g0[q] * (cv.x + yv[q >> 1][(q & 1) * 2] * bias1); o1[q] = g1[q] * (cv.y + yv[q >> 1][(q & 1) * 2 + 1] * bias1);
                    }
                    __builtin_nontemporal_store(pack8(o0), (u32x4*)(yt + ((size_t)c * NB + 0) * TPB + pos0 + i));
                    __builtin_nontemporal_store(pack8(o1), (u32x4*)(yt + ((size_t)c * NB + 1) * TPB + pos0 + i));
                }
            }
        } else
        for (int g = tid; g < NCH * L; g += NTHREADS) {
            const int ch = g >> LOGL, i = g & (L - 1), c = c0 + ch;
            const cf2 cv = X[PADI(ch * N + i)];
            if (o == 0) {
                const bf16_t* vp = zct + ((size_t)(2048 + c) * NB) * TPB + pos0; const bf16_t* x1p = zct + ((size_t)c * NB) * TPB + pos0;
                const float bias0 = p->in[21][(size_t)e * 2048 + c];
                const float y0 = bf2f(x1p[i]) * (cv.x + bf2f(vp[i]) * bias0), y1 = bf2f(x1p[TPB + i]) * (cv.y + bf2f(vp[TPB + i]) * bias0);
                Y1[g] = mk2(y0, y1);
                X[PADI(ch * N + i)] = mk2(y0, y1); X[PADI(ch * N + L + i)] = mk2(0.f, 0.f);
            } else {
                const bf16_t* x2p = zct + ((size_t)(1024 + c) * NB) * TPB + pos0;
                const float bias1 = p->in[21][(size_t)e * 2048 + 1024 + c];
                const cf2 y1v = Y1[g];
                const float y0 = bf2f(x2p[i]) * (cv.x + y1v.x * bias1), y1 = bf2f(x2p[TPB + i]) * (cv.y + y1v.y * bias1);
                yt[((size_t)c * NB + 0) * TPB + pos0 + i] = f2bf(y0);
                yt[((size_t)c * NB + 1) * TPB + pos0 + i] = f2bf(y1);
            }
        }
        __syncthreads();
    }
}

PHASE_FN void ph_hyena(KP p, int e, LAS unsigned char* lds) {
    p = launder_kp(p);
    cf2* scr = (cf2*)(p->ws + WS_Z + (size_t)BID * FFT_SCR_PER_BLOCK);
    for (int u = BID; u < 1024 + 128; u += NBLK) {
        if (u < 1024) hyena_unit<1, 13>(p, e, u, lds, scr);
        else hyena_unit<8, 8>(p, e, (u - 1024) * 8, lds, scr);
    }
}

__device__ __forceinline__ int s5_pos(int d, int pi) { return d == 0 ? pi : (pi < CTXL ? CTXL - 1 - pi : (TPB + CTXL - 1) - pi); }

__device__ __forceinline__ void s5_bu(const bf16x8 ua, const bf16x8 (&bf)[4], float (&bre)[32], float (&bim)[32]) {
    const f32x16 z = {};
    f32x16 t0 = __builtin_amdgcn_mfma_f32_32x32x16_bf16(ua, bf[0], z, 0, 0, 0);
    f32x16 t1 = __builtin_amdgcn_mfma_f32_32x32x16_bf16(ua, bf[1], z, 0, 0, 0);
    f32x16 t2 = __builtin_amdgcn_mfma_f32_32x32x16_bf16(ua, bf[2], z, 0, 0, 0);
    f32x16 t3 = __builtin_amdgcn_mfma_f32_32x32x16_bf16(ua, bf[3], z, 0, 0, 0);
#pragma unroll
    for (int r = 0; r < 16; ++r) {
        const auto sr = __builtin_amdgcn_permlane32_swap(__float_as_uint(t0[r]), __float_as_uint(t1[r]), false, false);
        const auto si = __builtin_amdgcn_permlane32_swap(__float_as_uint(t2[r]), __float_as_uint(t3[r]), false, false);
        const int m0 = (r & 3) + 8 * (r >> 2);
        bre[m0] = __uint_as_float(sr[0]); bre[m0 + 4] = __uint_as_float(sr[1]);
        bim[m0] = __uint_as_float(si[0]); bim[m0 + 4] = __uint_as_float(si[1]);
    }
}

PHASE_FN void ph_s5_pass1(KP p, int il) {
    p = launder_kp(p);
    const int lane = TID & 63, wid = TID >> 6;
    const bf16_t* xin = (const bf16_t*)(p->ws + WS_XIN);
    const cf2* abar = (const cf2*)(p->ws + WS_ABAR); const bf16_t* bfrag = (const bf16_t*)(p->ws + WS_BFRAG);
    cf2* est = (cf2*)(p->ws + WS_EST);
    constexpr int NQ = S5NCH - 1, NU = NB * 128 * 2 * NQ;
    for (int u = BID * NWAVES + wid; u < NU; u += NBLK * NWAVES) {
        const int q = u % NQ, d = (u / NQ) & 1, g = (u / (NQ * 2)) & 127, b = u / (NQ * 2 * 128);
        const int gi = (il * 2 + d) * 128 + g;
        const cf2 a = abar[(size_t)gi * 64 + lane];
        bf16x8 bf[4];
#pragma unroll
        for (int t = 0; t < 4; ++t) bf[t] = *(const bf16x8*)(bfrag + (((size_t)gi * 4 + t) * 64 + lane) * 8);
        float sre = 0.f, sim = 0.f;
        bf16x8 uav[S5T / 32];
#pragma unroll
        for (int st = 0; st < S5T / 32; ++st) {
            const int pos = s5_pos(d, q * S5T + st * 32 + (lane & 31));
            uav[st] = *(const bf16x8*)(xin + ((size_t)g * MROWS + b * TPB + pos) * 16 + (lane >> 5) * 8);
        }
#pragma unroll
        for (int st = 0; st < S5T / 32; ++st) {
            float bre[32], bim[32];
            s5_bu(uav[st], bf, bre, bim);
#pragma unroll
            for (int m = 0; m < 32; ++m) {
                const float nre = __builtin_fmaf(a.x, sre, __builtin_fmaf(-a.y, sim, bre[m])), nim = __builtin_fmaf(a.x, sim, __builtin_fmaf(a.y, sre, bim[m]));
                sre = nre; sim = nim;
            }
        }
        est[(((size_t)(b * 128 + g) * 2 + d) * S5NCH + q) * 64 + lane] = mk2(sre, sim);
    }
}

PHASE_FN void ph_s5_prefix(KP p, int il) {
    p = launder_kp(p);
    const int lane = TID & 63, wid = TID >> 6;
    const cf2* aTt = (const cf2*)(p->ws + WS_AT); const cf2* est = (const cf2*)(p->ws + WS_EST); cf2* sin_ = (cf2*)(p->ws + WS_SIN);
    for (int u = BID * NWAVES + wid; u < NB * 128 * 2; u += NBLK * NWAVES) {
        const int d = u & 1, g = (u >> 1) & 127, b = u >> 8;
        const cf2 aT = aTt[(size_t)((il * 2 + d) * 128 + g) * 64 + lane];
        const size_t base = (((size_t)(b * 128 + g) * 2 + d) * S5NCH) * 64 + lane;
        float sre = 0.f, sim = 0.f;
        sin_[base] = mk2(0.f, 0.f);
#pragma unroll 1
        for (int q0 = 0; q0 < S5NCH - 1; q0 += 13) {
            cf2 ev[13];
#pragma unroll
            for (int k = 0; k < 13; ++k) ev[k] = est[base + (size_t)(q0 + k) * 64];
#pragma unroll
            for (int k = 0; k < 13; ++k) {
                const float nre = __builtin_fmaf(aT.x, sre, __builtin_fmaf(-aT.y, sim, ev[k].x)), nim = __builtin_fmaf(aT.x, sim, __builtin_fmaf(aT.y, sre, ev[k].y));
                sre = nre; sim = nim;
                sin_[base + (size_t)(q0 + k + 1) * 64] = mk2(sre, sim);
            }
        }
    }
}

PHASE_FN void ph_s5_pass2(KP p, int il, LAS unsigned char* lds) {
    p = launder_kp(p);
    const int lane = TID & 63, wid = TID >> 6;
    constexpr int SP = 272;
    LAS unsigned char* Sl = lds + wid * (32 * SP + S5T * 16 * 4);
    LAS float* Yl = (LAS float*)(Sl + 32 * SP);
    const bf16_t* xin = (const bf16_t*)(p->ws + WS_XIN);
    const cf2* abar = (const cf2*)(p->ws + WS_ABAR);
    const bf16_t* bfrag = (const bf16_t*)(p->ws + WS_BFRAG); const bf16_t* cfrag = (const bf16_t*)(p->ws + WS_CFRAG);
    const cf2* sin_ = (const cf2*)(p->ws + WS_SIN);
    bf16_t* gout = (bf16_t*)(p->ws + WS_CAT);
    const float* dsk = p->in[34] + (size_t)il * DM;
    constexpr int NU = NB * 128 * S5NCH;
    for (int u = BID * NWAVES + wid; u < NU; u += NBLK * NWAVES) {
        const int v = u >> 3, j = v % S5NCH, g = (((v / S5NCH) & 15) << 3) | (u & 7), b = v / (S5NCH * 16);
        if (il == 1 && j < CTXL / S5T) continue;
        const int pos0 = j * S5T;
#pragma unroll 1
        for (int d = 0; d < 2; ++d) {
            const int q = d == 0 ? j : (j < 2 ? 1 - j : (S5NCH + 1) - j);
            const int gi = (il * 2 + d) * 128 + g;
            const cf2 a = abar[(size_t)gi * 64 + lane];
            bf16x8 bf[4], cf[4];
#pragma unroll
            for (int t = 0; t < 4; ++t) { bf[t] = *(const bf16x8*)(bfrag + (((size_t)gi * 4 + t) * 64 + lane) * 8); cf[t] = *(const bf16x8*)(cfrag + (((size_t)gi * 4 + t) * 64 + lane) * 8); }
            const cf2 sv = sin_[(((size_t)(b * 128 + g) * 2 + d) * S5NCH + q) * 64 + lane];
            float sre = sv.x, sim = sv.y;
            bf16x8 uav[S5T / 32];
#pragma unroll
            for (int st = 0; st < S5T / 32; ++st) {
                const int pos = s5_pos(d, q * S5T + st * 32 + (lane & 31));
                uav[st] = *(const bf16x8*)(xin + ((size_t)g * MROWS + b * TPB + pos) * 16 + (lane >> 5) * 8);
            }
#pragma unroll
            for (int st = 0; st < S5T / 32; ++st) {
                const int pi0 = q * S5T + st * 32;
                const bf16x8 ua = uav[st];
                float bre[32], bim[32];
                s5_bu(ua, bf, bre, bim);
#pragma unroll
                for (int m = 0; m < 32; ++m) {
                    const float nre = __builtin_fmaf(a.x, sre, __builtin_fmaf(-a.y, sim, bre[m])), nim = __builtin_fmaf(a.x, sim, __builtin_fmaf(a.y, sre, bim[m]));
                    sre = nre; sim = nim;
                    *(LAS unsigned*)(Sl + m * SP + lane * 4) = cvt_pk(sre, sim);
                }
#pragma unroll
                for (int mt = 0; mt < 2; ++mt) {
                    f32x4 acc = {0.f, 0.f, 0.f, 0.f};
#pragma unroll
                    for (int ks = 0; ks < 4; ++ks) {
                        const bf16x8 sb = *(const LAS bf16x8*)(Sl + (mt * 16 + (lane & 15)) * SP + ks * 64 + (lane >> 4) * 16);
                        acc = __builtin_amdgcn_mfma_f32_16x16x32_bf16(cf[ks], sb, acc, 0, 0, 0);
                    }
                    const int tl = s5_pos(d, pi0 + mt * 16 + (lane & 15)) - pos0;
                    LAS f32x4* yp = (LAS f32x4*)(Yl + tl * 16 + 4 * (lane >> 4));
                    if (d == 0) *yp = acc; else { const f32x4 o = *yp; *yp = o + acc; }
                }
            }
        }
#pragma unroll
        for (int hrow = 0; hrow < 2; ++hrow) {
            const int tl = lane + 64 * hrow;
            const size_t ro = ((size_t)(b * TPB + pos0 + tl)) * DM + g * 16;
            const size_t ri = ((size_t)g * MROWS + b * TPB + pos0 + tl) * 16;
            float uu[16];
            { float f[8]; unpack8(*(const u32x4*)(xin + ri), f); for (int k = 0; k < 8; ++k) uu[k] = f[k]; unpack8(*(const u32x4*)(xin + ri + 8), f); for (int k = 0; k < 8; ++k) uu[8 + k] = f[k]; }
            float o[16];
#pragma unroll
            for (int c4 = 0; c4 < 4; ++c4) {
                const f32x4 yv = *(const LAS f32x4*)(Yl + tl * 16 + c4 * 4);
#pragma unroll
                for (int k = 0; k < 4; ++k) o[c4 * 4 + k] = gelu_tanh(yv[k] + dsk[g * 16 + c4 * 4 + k] * uu[c4 * 4 + k]);
            }
            float o0[8], o1[8];
#pragma unroll
            for (int k = 0; k < 8; ++k) { o0[k] = o[k]; o1[k] = o[8 + k]; }
            *(u32x4*)(gout + ro) = pack8(o0); *(u32x4*)(gout + ro + 8) = pack8(o1);
        }
    }
}

__device__ __forceinline__ unsigned fkey(float v) { const unsigned u = __float_as_uint(v); return (u & 0x80000000u) ? ~u : (u | 0x80000000u); }
__device__ __forceinline__ float keyf(unsigned k) { return __uint_as_float((k & 0x80000000u) ? (k & 0x7fffffffu) : ~k); }
#define TOPK_INSERT(list, key) do { unsigned k_ = (key); _Pragma("unroll") for (int q_ = 0; q_ < 16; ++q_) { const unsigned hi_ = max(list[q_], k_); k_ = min(list[q_], k_); list[q_] = hi_; } } while (0)
#define TOPK_SORT16(v) do { _Pragma("unroll") for (int k_ = 2; k_ <= 16; k_ <<= 1) _Pragma("unroll") for (int j_ = k_ >> 1; j_ >= 1; j_ >>= 1) _Pragma("unroll") for (int i_ = 0; i_ < 16; ++i_) { \
        const int l_ = i_ ^ j_; if (l_ > i_) { const unsigned a_ = v[i_], b_ = v[l_]; const bool desc_ = ((i_ & k_) == 0); v[i_] = desc_ ? max(a_, b_) : min(a_, b_); v[l_] = desc_ ? min(a_, b_) : max(a_, b_); } } } while (0)
#define TOPK_TOPMERGE(a, b) do { _Pragma("unroll") for (int q_ = 0; q_ < 16; ++q_) a[q_] = max(a[q_], b[15 - q_]); \
        _Pragma("unroll") for (int st_ = 8; st_ >= 1; st_ >>= 1) _Pragma("unroll") for (int i_ = 0; i_ < 16; ++i_) if ((i_ & st_) == 0) { const unsigned x_ = a[i_], y_ = a[i_ + st_]; a[i_] = max(x_, y_); a[i_ + st_] = min(x_, y_); } } while (0)
#define TOPK_MERGE(list, XM) do { unsigned o_[16]; _Pragma("unroll") for (int q_ = 0; q_ < 16; ++q_) o_[q_] = (unsigned)__builtin_amdgcn_ds_bpermute((lane ^ (XM)) << 2, (int)list[15 - q_]); \
        _Pragma("unroll") for (int q_ = 0; q_ < 16; ++q_) list[q_] = max(list[q_], o_[q_]); \
        _Pragma("unroll") for (int st_ = 8; st_ >= 1; st_ >>= 1) _Pragma("unroll") for (int i_ = 0; i_ < 16; ++i_) if ((i_ & st_) == 0) { const unsigned a_ = list[i_], b_ = list[i_ + st_]; list[i_] = max(a_, b_); list[i_ + st_] = min(a_, b_); } } while (0)
PHASE_FN void ph_peer_topk(KP p, int layer, LAS unsigned char* lds) {
    p = launder_kp(p);
    const int tid = TID, lane = tid & 63, wid = tid >> 6, t = lane & 15, kq = lane >> 4;
    const bf16_t* pq = (const bf16_t*)(p->ws + WS_PQ);
    const bf16_t* keys = (const bf16_t*)(p->ws + WS_KEYS) + (size_t)layer * 8 * 2 * 128 * 128;
    int* pidx = (int*)(p->ws + WS_PIDX); float* pgate = (float*)(p->ws + WS_PGATE);
    constexpr int KP_ = 272;
    LAS unsigned char* kl = lds + 16384;
    {
        const bf16_t* ksrc = keys + ((size_t)((BID & 7) * 2) * 128) * 128;
#pragma unroll
        for (int q8 = 0; q8 < 8; ++q8) { const int c16 = tid + q8 * NTHREADS, row = c16 >> 4, cb = (c16 & 15) * 16;
            *(LAS u32x4*)(kl + row * KP_ + cb) = *(const u32x4*)((const unsigned char*)ksrc + (size_t)c16 * 16); }
    }
    __syncthreads();
    for (int bu = BID; bu < (MROWS / 128) * 8; bu += NBLK) {
        if (layer == 3 && ((bu >> 3) % (TPB / 128)) < CTXL / 128) continue;
        const int h = bu & 7, t0 = (bu >> 3) * 128 + wid * 16;
        const bf16_t* qb0 = pq + (size_t)(t0 + t) * DM + h * 256 + kq * 8;
        const LAS unsigned char* kb0 = kl + t * KP_ + kq * 16;
        unsigned lsA[16], lsB[16];
#pragma unroll 1
        for (int s = 0; s < 2; ++s) {
            bf16x8 qf[4];
#pragma unroll
            for (int ks = 0; ks < 4; ++ks) qf[ks] = *(const bf16x8*)(qb0 + s * 128 + ks * 32);
            unsigned lst[16], l2[16];
#pragma unroll 1
            for (int nb4 = 0; nb4 < 2; ++nb4) {
                bf16x8 kf[4][4];
#pragma unroll
                for (int n4 = 0; n4 < 4; ++n4)
#pragma unroll
                    for (int ks = 0; ks < 4; ++ks) kf[n4][ks] = *(const LAS bf16x8*)(kb0 + (s * 128 + (nb4 * 4 + n4) * 16) * KP_ + ks * 64);
#pragma unroll
                for (int n4 = 0; n4 < 4; ++n4) {
                    f32x4 acc = {0.f, 0.f, 0.f, 0.f};
#pragma unroll
                    for (int ks = 0; ks < 4; ++ks) acc = __builtin_amdgcn_mfma_f32_16x16x32_bf16(kf[n4][ks], qf[ks], acc, 0, 0, 0);
#pragma unroll
                    for (int r = 0; r < 4; ++r) { const unsigned key = (fkey(acc[r]) & ~0x7Fu) | (unsigned)(127 - ((nb4 * 4 + n4) * 16 + 4 * kq + r));
                        if (nb4 == 0) lst[n4 * 4 + r] = key; else l2[n4 * 4 + r] = key; }
                }
            }
            TOPK_SORT16(lst); TOPK_SORT16(l2); TOPK_TOPMERGE(lst, l2);
            TOPK_MERGE(lst, 16); TOPK_MERGE(lst, 32);
            if (s == 0) {
#pragma unroll
                for (int k = 0; k < 16; ++k) lsA[k] = lst[k];
            } else {
#pragma unroll
                for (int k = 0; k < 16; ++k) lsB[k] = lst[k];
            }
        }
        float vb[16];
#pragma unroll
        for (int k = 0; k < 16; ++k) vb[k] = keyf(lsB[k] & ~0x7Fu);
        unsigned cl[16];
        {
            const unsigned ka = kq == 0 ? lsA[0] : (kq == 1 ? lsA[1] : (kq == 2 ? lsA[2] : lsA[3]));
            const float va = keyf(ka & ~0x7Fu);
#pragma unroll
            for (int j = 0; j < 16; ++j) cl[j] = ((kq + 1) * (j + 1) <= 16) ? ((fkey(va + vb[j]) & ~0xFFu) | (unsigned)(255 - (kq * 16 + j))) : 0u;
        }
#pragma unroll
        for (int a4 = 1; a4 < 4; ++a4) {
            const unsigned ka = kq == 0 ? lsA[4 * a4] : (kq == 1 ? lsA[4 * a4 + 1] : (kq == 2 ? lsA[4 * a4 + 2] : lsA[4 * a4 + 3]));
            const float va = keyf(ka & ~0x7Fu);
            const int i = kq + 4 * a4;
            constexpr int JMAXT[4] = {16, 3, 1, 1};
#pragma unroll
            for (int j = 0; j < JMAXT[a4]; ++j) {
                const unsigned key = ((i + 1) * (j + 1) <= 16) ? ((fkey(va + vb[j]) & ~0xFFu) | (unsigned)(255 - (i * 16 + j))) : 0u;
                TOPK_INSERT(cl, key);
            }
        }
        TOPK_MERGE(cl, 16); TOPK_MERGE(cl, 32);
        LAS unsigned* tab = (LAS unsigned*)lds + wid * 512;
        if (kq == 0) {
#pragma unroll
            for (int k = 0; k < 16; ++k) { tab[(t * 2) * 16 + k] = lsA[k]; tab[(t * 2 + 1) * 16 + k] = lsB[k]; }
        }
        if (kq == 0) {
            const float mx = keyf(cl[0] & ~0xFFu);
            float ev[16], ssum = 0.f; int ci[16];
#pragma unroll
            for (int k = 0; k < 16; ++k) {
                ev[k] = __expf(keyf(cl[k] & ~0xFFu) - mx); ssum += ev[k];
                const int flat = 255 - (int)(cl[k] & 0xFFu);
                ci[k] = (127 - (int)(tab[(t * 2) * 16 + (flat >> 4)] & 0x7Fu)) * 128 + (127 - (int)(tab[(t * 2 + 1) * 16 + (flat & 15)] & 0x7Fu));
            }
            const float rs = 1.0f / ssum;
            const size_t ob = (size_t)(t0 + t) * 128 + h * 16;
#pragma unroll
            for (int k4 = 0; k4 < 4; ++k4) {
                *(int4*)(pidx + ob + k4 * 4) = make_int4(ci[k4 * 4], ci[k4 * 4 + 1], ci[k4 * 4 + 2], ci[k4 * 4 + 3]);
                *(f32x4*)(pgate + ob + k4 * 4) = (f32x4){ev[k4 * 4] * rs, ev[k4 * 4 + 1] * rs, ev[k4 * 4 + 2] * rs, ev[k4 * 4 + 3] * rs};
            }
        }
    }
}

template <int CTRL> __device__ __forceinline__ float dppf_add(float v) { return v + dppf<CTRL>(v); }
#define PG_ITEM(it) const int rsel_ = (it) >= ntw ? 1 : 0; const int tl_ = ts * tok_per + wid + 8 * ((it) - rsel_ * ntw); const int tok_ = layer == 3 ? tl_ + CTXL + (tl_ >= SEQ ? CTXL : 0) : tl_; const int range_ = cls + 8 * rsel_
#define PG_IDX(id, it, hf) do { PG_ITEM(it); const int* q_ = pidx + (size_t)tok_ * 128 + g * 16 + (hf) * 8; const int4 a_ = *(const int4*)q_, b_ = *(const int4*)(q_ + 4); \
        id[0] = a_.x; id[1] = a_.y; id[2] = a_.z; id[3] = a_.w; id[4] = b_.x; id[5] = b_.y; id[6] = b_.z; id[7] = b_.w; (void)range_; } while (0)
PHASE_FN void ph_peer_g1(KP p, int layer, LAS unsigned char* lds) {
    p = launder_kp(p);
    const int lane = TID & 63, wid = __builtin_amdgcn_readfirstlane(TID >> 6), g = lane >> 3, j = lane & 7, fm = lane & 15, kg = lane >> 4;
    const unsigned char* pu = p->ws + WS_PU + (size_t)layer * 16384 * 2048;
    const int* pidx = (const int*)(p->ws + WS_PIDX);
    const unsigned char* xq8 = p->ws + WS_XQ8;
    bf16_t* pdot = (bf16_t*)(p->ws + WS_Z);
    const int cls = BID & 7, ts = BID >> 3, nts = (NBLK + 7) >> 3;
    const int ntok = layer == 3 ? NB * SEQ : MROWS, tok_per = (ntok + nts - 1) / nts;
    const int nvalid = min(tok_per, ntok - ts * tok_per), ntw = nvalid > wid ? (nvalid - wid + 7) >> 3 : 0, nit = 2 * ntw;
    LAS unsigned char* buf0 = lds + wid * 18432; LAS unsigned char* buf1 = buf0 + 8192; LAS unsigned char* auxc = buf0 + 16384; LAS unsigned char* auxn = auxc + 1024;
#define G1_DMA(bufp, id, it) do { PG_ITEM(it); (void)tok_; const unsigned char* rb_ = pu + (size_t)range_ * (16384 * 128); \
        _Pragma("unroll") for (int i = 0; i < 8; ++i) { const int sw_ = (i & 1) * 4 + (g >> 1); \
            __builtin_amdgcn_global_load_lds((const unsigned*)(rb_ + (((unsigned)id[(i & 1) * 4 + (i >> 1)] << 7) + (unsigned)((j ^ sw_) << 4))), (LAS unsigned*)(bufp + i * 1024), 16, 0, 0); } } while (0)
#define G1_AUX(auxp, it) do { PG_ITEM(it); const unsigned char* s_ = lane < 32 ? (const unsigned char*)(pidx + (size_t)tok_ * 128) + lane * 16 : xq8 + (size_t)tok_ * DM + range_ * 128 + (lane & 7) * 16; \
        __builtin_amdgcn_global_load_lds((const unsigned*)s_, (LAS unsigned*)(auxp), 16, 0, 0); } while (0)
#define G1_IDS(id, auxp, hf) do { const u32x4 a_ = *(const LAS u32x4*)(auxp + (g * 16 + (hf) * 8) * 4), b_ = *(const LAS u32x4*)(auxp + (g * 16 + (hf) * 8 + 4) * 4); \
        id[0] = (int)a_.x; id[1] = (int)a_.y; id[2] = (int)a_.z; id[3] = (int)a_.w; id[4] = (int)b_.x; id[5] = (int)b_.y; id[6] = (int)b_.z; id[7] = (int)b_.w; } while (0)
#define G1_X(xv, auxp) do { _Pragma("unroll") for (int t = 0; t < 4; ++t) xv[t] = *(const LAS long*)(auxp + 512 + t * 32 + kg * 8); } while (0)
#define G1_COMP(bufp, hf, it, xv) do { f32x4 acc_[4]; \
        _Pragma("unroll") for (int mt = 0; mt < 4; ++mt) { acc_[mt] = (f32x4){0.f, 0.f, 0.f, 0.f}; \
            _Pragma("unroll") for (int t = 0; t < 4; ++t) { const int pos_ = (2 * t + (kg >> 1)) ^ ((fm >> 1) & 7); \
                const long a_ = *(const LAS long*)(bufp + (mt * 16 + fm) * 128 + pos_ * 16 + (kg & 1) * 8); \
                acc_[mt] = __builtin_amdgcn_mfma_f32_16x16x32_fp8_fp8(a_, xv[t], acc_[mt], 0, 0, 0); } } \
        const int r_ = fm & 3; float v_[4]; \
        _Pragma("unroll") for (int mt = 0; mt < 4; ++mt) v_[mt] = r_ == 0 ? acc_[mt][0] : r_ == 1 ? acc_[mt][1] : r_ == 2 ? acc_[mt][2] : acc_[mt][3]; \
        if (fm < 4) { PG_ITEM(it); const int s0_ = (4 * (kg & 1) + r_) * 16 + (hf) * 8 + (kg >> 1) * 4; u32x2 w_; w_.x = cvt_pk(v_[0], v_[1]); w_.y = cvt_pk(v_[2], v_[3]); \
            asm volatile("global_store_dwordx2 %0, %1, off" :: "v"(pdot + ((size_t)range_ * MROWS + tok_) * 128 + s0_), "v"(w_) : "memory"); } } while (0)
#define G1_WAITV(n) asm volatile("s_waitcnt vmcnt(" #n ")" ::: "memory")
#define G1_WAITL() asm volatile("s_waitcnt lgkmcnt(0)" ::: "memory")
    if (nit > 0) {
        int idA[8], idB[8]; long xb[4];
        G1_AUX(auxc, 0); G1_WAITV(0); G1_IDS(idA, auxc, 0); G1_WAITL();
        G1_AUX(auxn, (nit > 1 ? 1 : 0)); G1_DMA(buf0, idA, 0);
#pragma unroll 1
        for (int n = 0; n < nit; ++n) {
            const int n1 = n + 1 < nit ? n + 1 : nit - 1, n2 = n + 2 < nit ? n + 2 : nit - 1;
            G1_IDS(idB, auxc, 1); G1_WAITL();
            G1_DMA(buf1, idB, n);
            G1_WAITV(8);
            G1_X(xb, auxc);
            G1_COMP(buf0, 0, n, xb);
            G1_IDS(idA, auxn, 0); G1_WAITL();
            G1_AUX(auxc, n2);
            G1_DMA(buf0, idA, n1);
            G1_WAITV(9);
            G1_COMP(buf1, 1, n, xb);
            G1_WAITL();
            { LAS unsigned char* t_ = auxc; auxc = auxn; auxn = t_; }
        }
        G1_WAITV(0);
    }
#undef G1_DMA
#undef G1_AUX
#undef G1_IDS
#undef G1_X
#undef G1_COMP
#undef G1_WAITV
#undef G1_WAITL
}
constexpr int PCREC = 272;
PHASE_FN void ph_peer_g1b(KP p, int layer) {
    p = launder_kp(p);
    const int lane = TID & 63, wid = TID >> 6;
    const bf16_t* pdot = (const bf16_t*)(p->ws + WS_Z);
    const int* pidx = (const int*)(p->ws + WS_PIDX); const float* pgate = (const float*)(p->ws + WS_PGATE);
    const float* pus = (const float*)(p->ws + WS_PUS) + (size_t)layer * 16384; const float* pvs = (const float*)(p->ws + WS_PVS) + (size_t)layer * 16384;
    unsigned char* prec = p->ws + WS_PCOEF; const float* xs = (const float*)(p->ws + WS_XS);
    constexpr int TB = 4;
    const int ntok = layer == 3 ? NB * SEQ : MROWS;
#define G1B_ROW(tl) (layer == 3 ? (tl) + CTXL + ((tl) >= SEQ ? CTXL : 0) : (tl))
    for (int t0 = BID * NWAVES + wid; t0 < ntok; t0 += TB * NBLK * NWAVES) {
        unsigned w[TB][16]; int2 id[TB]; f32x2v gt[TB]; float xsc[TB];
#pragma unroll
        for (int u = 0; u < TB; ++u) {
            const int tok = G1B_ROW(min(t0 + u * NBLK * NWAVES, ntok - 1));
#pragma unroll
            for (int r = 0; r < 16; ++r) w[u][r] = __builtin_nontemporal_load((const unsigned*)(pdot + ((size_t)r * MROWS + tok) * 128 + 2 * lane));
            id[u] = *(const int2*)(pidx + (size_t)tok * 128 + 2 * lane);
            gt[u] = *(const f32x2v*)(pgate + (size_t)tok * 128 + 2 * lane);
            xsc[u] = xs[tok];
        }
        float us0[TB], us1[TB], vs0[TB], vs1[TB];
#pragma unroll
        for (int u = 0; u < TB; ++u) { us0[u] = pus[id[u].x]; us1[u] = pus[id[u].y]; vs0[u] = pvs[id[u].x]; vs1[u] = pvs[id[u].y]; }
#pragma unroll
        for (int u = 0; u < TB; ++u) {
            const int tl = t0 + u * NBLK * NWAVES, tok = G1B_ROW(tl);
            float s0 = 0.f, s1 = 0.f;
#pragma unroll
            for (int r = 0; r < 16; ++r) { s0 += bflo(w[u][r]); s1 += bfhi(w[u][r]); }
            f32x2v cf; cf.x = gt[u].x * gelu_tanh(s0 * xsc[u] * us0[u]) * vs0[u]; cf.y = gt[u].y * gelu_tanh(s1 * xsc[u] * us1[u]) * vs1[u];
            const float am = wave_max(fmaxf(fabsf(cf.x), fabsf(cf.y)));
            const float sc = am > 0.f ? am * (1.0f / 224.0f) : 1.0f, inv = 1.0f / sc;
            const float c0 = cf.x * inv, c1 = cf.y * inv;
            const int hi = __builtin_amdgcn_cvt_pk_fp8_f32(c0, c1, 0, false);
            const f32x2v hd = __builtin_amdgcn_cvt_pk_f32_fp8(hi, false);
            const int lo = __builtin_amdgcn_cvt_pk_fp8_f32((c0 - hd.x) * 16.0f, (c1 - hd.y) * 16.0f, 0, false);
            if (tl < ntok) {
                unsigned char* rec = prec + (size_t)tok * PCREC;
                *(unsigned short*)(rec + 2 * lane) = (unsigned short)hi; *(unsigned short*)(rec + 128 + 2 * lane) = (unsigned short)lo;
                if (lane == 0) *(float*)(rec + 256) = sc;
            }
        }
    }
}
#undef G1B_ROW
PHASE_FN void ph_peer_g2(KP p, int layer, LAS unsigned char* lds) {
    p = launder_kp(p);
    const int lane = TID & 63, wid = __builtin_amdgcn_readfirstlane(TID >> 6), g = lane >> 3, j = lane & 7, fm = lane & 15, kg = lane >> 4;
    const unsigned char* pv = p->ws + WS_PV + (size_t)layer * 16384 * 2048;
    const int* pidx = (const int*)(p->ws + WS_PIDX); const unsigned char* prec = p->ws + WS_PCOEF;
    bf16_t* fo = (bf16_t*)(p->ws + WS_YMIX);
    const int cls = BID & 7, ts = BID >> 3, nts = (NBLK + 7) >> 3;
    const int ntok = layer == 3 ? NB * SEQ : MROWS, tok_per = (ntok + nts - 1) / nts;
    const int nvalid = min(tok_per, ntok - ts * tok_per), ntw = nvalid > wid ? (nvalid - wid + 7) >> 3 : 0, nit = 2 * ntw;
    LAS unsigned char* buf0 = lds + wid * 18432; LAS unsigned char* buf1 = buf0 + 8192; LAS unsigned char* auxc = buf0 + 16384; LAS unsigned char* auxn = auxc + 1024;
#define G2_DMA(bufp, id, it) do { PG_ITEM(it); (void)tok_; const unsigned char* rb_ = pv + (size_t)range_ * (16384 * 128); \
        _Pragma("unroll") for (int i = 0; i < 8; ++i) { const int sw_ = (i & 1) * 4 + (g >> 1); \
            __builtin_amdgcn_global_load_lds((const unsigned*)(rb_ + (((unsigned)id[i] << 7) + (unsigned)((j ^ sw_) << 4))), (LAS unsigned*)(bufp + i * 1024), 16, 0, 0); } } while (0)
#define G2_AUX(auxp, it) do { PG_ITEM(it); (void)range_; const unsigned char* s_ = lane < 32 ? (const unsigned char*)(pidx + (size_t)tok_ * 128) + lane * 16 : prec + (size_t)tok_ * PCREC + min(lane - 32, 16) * 16; \
        __builtin_amdgcn_global_load_lds((const unsigned*)s_, (LAS unsigned*)(auxp), 16, 0, 0); } while (0)
#define G2_IDS(id, auxp, hf) do { _Pragma("unroll") for (int i = 0; i < 8; ++i) id[i] = *(const LAS int*)(auxp + ((hf) * 64 + i * 8 + g) * 4); } while (0)
    int va[8];
    { const int rb_ = (int)(uintptr_t)(lds + wid * 18432) + (kg * 8 + (fm >> 1)) * 128 + (fm & 1) * 8; const int sw_ = (kg & 1) * 4 + (fm >> 2);
#pragma unroll
      for (int ct = 0; ct < 8; ++ct) va[ct] = rb_ + ((ct ^ sw_) << 4); }
#define G2_TR(dst, ct, off) asm volatile("ds_read_b64_tr_b8 %0, %1 offset:%2" : "=&v"(dst) : "v"(va[ct]), "i"(off) : "memory")
#define G2_COMP(bo, hf) do { long b_[16]; \
        _Pragma("unroll") for (int ct = 0; ct < 8; ++ct) { G2_TR(b_[ct], ct, (bo)); G2_TR(b_[8 + ct], ct, (bo) + 4096); } \
        asm volatile("s_waitcnt lgkmcnt(0)" ::: "memory"); __builtin_amdgcn_sched_barrier(0); \
        _Pragma("unroll") for (int ct = 0; ct < 8; ++ct) { acc[ct] = __builtin_amdgcn_mfma_f32_16x16x32_fp8_fp8(av[(hf) * 2], b_[ct], acc[ct], 0, 0, 0); \
            acc[ct] = __builtin_amdgcn_mfma_f32_16x16x32_fp8_fp8(av[(hf) * 2 + 1], b_[8 + ct], acc[ct], 0, 0, 0); } } while (0)
#define G2_WAITV(n) asm volatile("s_waitcnt vmcnt(" #n ")" ::: "memory")
#define G2_WAITL() asm volatile("s_waitcnt lgkmcnt(0)" ::: "memory")
    if (nit > 0) {
        int idA[8], idB[8]; long av[4];
        G2_AUX(auxc, 0); G2_WAITV(0); G2_IDS(idA, auxc, 0); G2_WAITL();
        G2_AUX(auxn, (nit > 1 ? 1 : 0)); G2_DMA(buf0, idA, 0);
#pragma unroll 1
        for (int n = 0; n < nit; ++n) {
            const int n1 = n + 1 < nit ? n + 1 : nit - 1, n2 = n + 2 < nit ? n + 2 : nit - 1;
            f32x4 acc[8];
#pragma unroll
            for (int ct = 0; ct < 8; ++ct) acc[ct] = (f32x4){0.f, 0.f, 0.f, 0.f};
            G2_IDS(idB, auxc, 1);
#pragma unroll
            for (int q = 0; q < 4; ++q) { const long a_ = *(const LAS long*)(auxc + 512 + (fm & 1) * 128 + q * 32 + kg * 8); av[q] = (fm & 2) ? 0l : a_; }
            const float scl = *(const LAS float*)(auxc + 768);
            G2_WAITL();
            G2_DMA(buf1, idB, n);
            G2_WAITV(8);
            G2_COMP(0, 0);
            G2_IDS(idA, auxn, 0); G2_WAITL();
            G2_AUX(auxc, n2);
            G2_DMA(buf0, idA, n1);
            G2_WAITV(9);
            G2_COMP(8192, 1);
            {
                PG_ITEM(n);
                bf16_t* o_ = fo + (size_t)tok_ * DM + range_ * 128 + kg * 32 + fm;
#pragma unroll
                for (int e = 0; e < 2; ++e) {
                    const float h_ = kg == 0 ? acc[e][0] : kg == 1 ? acc[2 + e][0] : kg == 2 ? acc[4 + e][0] : acc[6 + e][0];
                    const float l_ = kg == 0 ? acc[e][1] : kg == 1 ? acc[2 + e][1] : kg == 2 ? acc[4 + e][1] : acc[6 + e][1];
                    const unsigned w_ = cvt_pk(scl * (h_ + l_ * 0.0625f), 0.f);
                    asm volatile("global_store_short %0, %1, off" :: "v"(o_ + e * 16), "v"(w_) : "memory");
                }
            }
            G2_WAITL();
            { LAS unsigned char* t_ = auxc; auxc = auxn; auxn = t_; }
        }
        G2_WAITV(0);
    }
#undef G2_DMA
#undef G2_AUX
#undef G2_IDS
#undef G2_COMP
#undef G2_TR
#undef G2_WAITV
#undef G2_WAITL
}
PHASE_FN void ph_peer_g3(KP p, int layer) {
    p = launder_kp(p);
    const int lane = TID & 63, wid = TID >> 6;
    float* h = (float*)(p->ws + WS_H); bf16_t* xin = (bf16_t*)(p->ws + WS_XIN);
    const bf16_t* fo = (const bf16_t*)(p->ws + WS_YMIX);
    const float* mvl = (const float*)(p->ws + WS_MVEC) + (size_t)layer * 3 * 12288;
    const float* mvn = (const float*)(p->ws + WS_MVEC) + (size_t)(layer < 3 ? layer + 1 : 3) * 3 * 12288;
    const float* lg = p->in[8] + (size_t)layer * DM; const float* lb = p->in[9] + (size_t)layer * DM;
    const int ntok = layer == 3 ? NB * SEQ : MROWS;
    for (int tl = BID * NWAVES + wid; tl < ntok; tl += NBLK * NWAVES) {
        const int tok = layer == 3 ? tl + CTXL + (tl >= SEQ ? CTXL : 0) : tl;
        const int b = tok / TPB, pos = tok - b * TPB, kind = pos < CTXL ? 2 : b;
        const float* mv = mvl + (size_t)kind * 12288; const float* mn = mvn + (size_t)kind * 12288;
        float x[32]; float s = 0.f;
#pragma unroll
        for (int c = 0; c < 4; ++c) {
            const int col = c * 512 + lane * 8;
            const f32x4 h0 = __builtin_nontemporal_load((const f32x4*)(h + (size_t)tok * DM + col)), h1 = __builtin_nontemporal_load((const f32x4*)(h + (size_t)tok * DM + col + 4));
            float y[8]; unpack8(__builtin_nontemporal_load((const u32x4*)(fo + (size_t)tok * DM + col)), y);
            const f32x4 g0 = *(const f32x4*)(mv + 5 * 2048 + col), g1 = *(const f32x4*)(mv + 5 * 2048 + col + 4);
#pragma unroll
            for (int k = 0; k < 4; ++k) { x[c * 8 + k] = DN_ALPHA * h0[k] + g0[k] * y[k]; x[c * 8 + 4 + k] = DN_ALPHA * h1[k] + g1[k] * y[4 + k]; }
#pragma unroll
            for (int k = 0; k < 8; ++k) s += x[c * 8 + k];
        }
        const float mean = wave_sum(s) * (1.0f / DM);
        float q = 0.f;
#pragma unroll
        for (int k = 0; k < 32; ++k) { x[k] -= mean; q += x[k] * x[k]; }
        const float rstd = rsqrtf(wave_sum(q) * (1.0f / DM) + LN_EPS);
#pragma unroll
        for (int c = 0; c < 4; ++c) {
            const int col = c * 512 + lane * 8;
            float hn[8], xf[8];
#pragma unroll
            for (int k = 0; k < 8; ++k) { hn[k] = x[c * 8 + k] * rstd * lg[col + k] + lb[col + k]; xf[k] = hn[k] * (1.0f + mn[2048 + col + k]) + mn[col + k]; }
            if (layer < 3) {
                __builtin_nontemporal_store((f32x4){hn[0], hn[1], hn[2], hn[3]}, (f32x4*)(h + (size_t)tok * DM + col));
                __builtin_nontemporal_store((f32x4){hn[4], hn[5], hn[6], hn[7]}, (f32x4*)(h + (size_t)tok * DM + col + 4));
                if ((layer & 1) == 0) *(u32x4*)(xin + ((size_t)(col >> 4) * MROWS + tok) * 16 + (col & 8)) = pack8(xf);
                else *(u32x4*)(xin + (size_t)tok * DM + col) = pack8(xf);
            } else if (pos >= CTXL) {
                float* o = p->out + ((size_t)b * SEQ + (pos - CTXL)) * DM + col;
                __builtin_nontemporal_store((f32x4){hn[0], hn[1], hn[2], hn[3]}, (f32x4*)o); __builtin_nontemporal_store((f32x4){hn[4], hn[5], hn[6], hn[7]}, (f32x4*)(o + 4));
            }
        }
    }
}

#ifndef REP_MASK
#define REP_MASK 0
#endif
constexpr int PH_PER_PAIR = 24, N_PHASES = 2 + 2 * PH_PER_PAIR;

PHASE_FN void ph_p0_convert(KP p, LAS unsigned char* lds) {
    p = launder_kp(p);
    for (int e = 0; e < 2; ++e) {
        transpose_cvt(p->in[10] + (size_t)e * 2048 * INW, 2048, INW, (bf16_t*)(p->ws + WS_WIN) + (size_t)e * 4096 * 2048, 4096, lds);
        transpose_cvt(p->in[23] + (size_t)e * 512 * 1536, 512, 1536, (bf16_t*)(p->ws + WS_WUQ) + (size_t)e * 1536 * 512, 1536, lds);
        transpose_cvt(p->in[25] + (size_t)e * 256 * 2048, 256, 2048, (bf16_t*)(p->ws + WS_WUKV) + (size_t)e * 2048 * 256, 2048, lds);
        transpose_cvt(p->in[26] + (size_t)e * 2048 * 2048, 2048, 2048, (bf16_t*)(p->ws + WS_WO) + (size_t)e * 2048 * 2048, 2048, lds);
        transpose_cvt(p->in[35] + (size_t)e * 2048 * 2048, 2048, 2048, (bf16_t*)(p->ws + WS_OD) + (size_t)e * 4096 * 2048, 2048, lds);
        transpose_cvt(p->in[36] + (size_t)e * 2048 * 2048, 2048, 2048, (bf16_t*)(p->ws + WS_OD) + (size_t)e * 4096 * 2048 + (size_t)2048 * 2048, 2048, lds);
    }
    for (int e = 0; e < 2; ++e) transpose_cvt(p->in[19] + (size_t)e * 64 * 4096, 64, 4096, (bf16_t*)(p->ws + WS_W4T) + (size_t)e * 4096 * 64, 4096, lds);
    for (int l = 0; l < 4; ++l)
        transpose_cvt(p->in[37] + (size_t)l * 2048 * 2048, 2048, 2048, (bf16_t*)(p->ws + WS_WQ) + (size_t)l * 2048 * 2048, 2048, lds);
    cvt_bf16(p->in[38], (bf16_t*)(p->ws + WS_KEYS), (size_t)4 * 8 * 2 * 128 * 128);
}
PHASE_FN void ph_gemm_plain(LAS unsigned char* lds, const bf16_t* A, const bf16_t* Bt, bf16_t* C, int N, int K, int ldc, int skip_ctx) {
    EpiBf16G<AddrPlain> E{{C, ldc}};
    run_gemm(lds, A, Bt, MROWS, N, K, E, skip_ctx);
}
PHASE_FN void ph_fill_table(KP p, int layer, int which, int nunits) {
    p = launder_kp(p);
    const int rem = nunits % NBLK, c = BID;
    int wkr, nwkr;
    if (rem == 0) { wkr = c; nwkr = NBLK; } else { if (c < rem) return; wkr = c - rem; nwkr = NBLK - rem; }
    cvt_fp8_rows(p->in[39 + which] + (size_t)layer * 16384 * 2048, p->ws + (which ? WS_PV : WS_PU) + (size_t)layer * 16384 * 2048, (float*)(p->ws + (which ? WS_PVS : WS_PUS)) + (size_t)layer * 16384, 16384, wkr, nwkr);
}
PHASE_FN void ph_gemm_q(LAS unsigned char* lds, const bf16_t* A, const bf16_t* Bt, bf16_t* Q) {
    EpiQ E{Q};
    run_gemm(lds, A, Bt, MROWS, 1536, QRANK, E);
}
PHASE_FN void ph_gemm_kv(LAS unsigned char* lds, const bf16_t* A, const bf16_t* Bt, bf16_t* K, bf16_t* V) {
    EpiKV E{K, V};
    run_gemm(lds, A, Bt, MROWS, 2048, KVRANK, E);
}

__global__ void __launch_bounds__(NTHREADS, 2) hybrid_fwd(Params pv) {
    extern __shared__ __attribute__((aligned(16))) unsigned char lds_raw[];
    LAS unsigned char* lds = (LAS unsigned char*)lds_raw;
    KP p = (KP)__builtin_amdgcn_kernarg_segment_ptr();
    volatile LAS unsigned* xbw = (volatile LAS unsigned*)(lds + LDS_BYTES - 64);
    if (threadIdx.x < 4) xbw[threadIdx.x] = 0u;
    __syncthreads();
    const int lo = pv.ph_lo, hi = pv.ph_hi;
    unsigned char* ws = pv.ws;
    XcdBarrier bar; bar.bar = (unsigned*)(ws + WS_CTL); bar.x = 0; bar.st = xbw;
    if (hi - lo > 1) bar = xcd_barrier_post((unsigned*)(ws + WS_CTL), xbw);
#define IN(k) (lo <= (k) && (k) < hi)
#define RUN(bit, ...) do { __VA_ARGS__; if (REP_MASK & (1 << (bit))) { __syncthreads(); __VA_ARGS__; } } while (0)
#define SEAM(k) do { if (IN(k) && IN((k) + 1)) { xcd_barrier(bar); if (REP_MASK & 1024) xcd_barrier(bar); } } while (0)

    if (IN(0)) { RUN(6, ph_mod(p, lds); ph_p0_convert(p, lds); ph_hdn3(p); ph_s5par(p); (void)0); }
    SEAM(0);
    if (IN(1)) { RUN(13, ph_hinit(p)); ph_hk(p); }
    SEAM(1);

#pragma unroll
    for (int pair = 0; pair < 2; ++pair) {
        const int pb = 2 + pair * PH_PER_PAIR;
        const int le = 2 * pair, lod = 2 * pair + 1;
        if (IN(pb + 0)) RUN(0, ph_gemm_plain(lds, (const bf16_t*)(ws + WS_XIN), (const bf16_t*)(ws + WS_WIN) + (size_t)pair * 4096 * 2048, (bf16_t*)(ws + WS_Z), INWP, DM, INWP, 0)); if (IN(pb + 0)) { if (pair == 0) ph_fill_table(p, 0, 0, (MROWS / 256) * (INWP / 256)); else ph_fill_table(p, 2, 1, (MROWS / 256) * (INWP / 256)); }
        SEAM(pb + 0);
        if (IN(pb + 1)) { RUN(5, ph_e2a_rows(p, pair); ph_e2a_conv(p, pair, lds)); }
        SEAM(pb + 1);
        if (IN(pb + 2)) {
            RUN(0, ph_gemm_q(lds, (const bf16_t*)(ws + WS_QN), (const bf16_t*)(ws + WS_WUQ) + (size_t)pair * 1536 * 512, (bf16_t*)(ws + WS_Q)));
            RUN(0, ph_gemm_kv(lds, (const bf16_t*)(ws + WS_KVN), (const bf16_t*)(ws + WS_WUKV) + (size_t)pair * 2048 * 256, (bf16_t*)(ws + WS_K), (bf16_t*)(ws + WS_V)));
        }
        SEAM(pb + 2);
        if (IN(pb + 3)) { RUN(1, ph_attention(p, lds)); RUN(2, ph_hyena(p, pair, lds)); }
        SEAM(pb + 3);
        if (IN(pb + 4)) RUN(5, ph_e4_transpose(p, lds));
        SEAM(pb + 4);
        if (IN(pb + 5)) RUN(0, ph_gemm_plain(lds, (const bf16_t*)(ws + WS_CAT), (const bf16_t*)(ws + WS_WO) + (size_t)pair * 2048 * 2048, (bf16_t*)(ws + WS_YMIX), DM, DM, DM, 0)); if (IN(pb + 5)) { if (pair == 0) ph_fill_table(p, 0, 1, (MROWS / 256) * (DM / 256)); else ph_fill_table(p, 3, 0, (MROWS / 256) * (DM / 256)); }
        SEAM(pb + 5);
        if (IN(pb + 6)) ph_ln_mix<false>(p, le);
        SEAM(pb + 6);
        if (IN(pb + 7)) RUN(0, ph_gemm_plain(lds, (const bf16_t*)(ws + WS_XFFN), (const bf16_t*)(ws + WS_WQ) + (size_t)le * 2048 * 2048, (bf16_t*)(ws + WS_PQ), DM, DM, DM, 0)); if (IN(pb + 7)) { if (pair == 0) ph_fill_table(p, 1, 0, (MROWS / 256) * (DM / 256)); else ph_fill_table(p, 3, 1, (MROWS / 256) * (DM / 256)); }
        SEAM(pb + 7);
        if (IN(pb + 8)) RUN(3, ph_peer_topk(p, le, lds));
        SEAM(pb + 8);
        if (IN(pb + 9)) RUN(7, ph_peer_g1(p, le, lds));
        SEAM(pb + 9);
        if (IN(pb + 10)) RUN(9, ph_peer_g1b(p, le));
        SEAM(pb + 10);
        if (IN(pb + 11)) RUN(8, ph_peer_g2(p, le, lds));
        SEAM(pb + 11);
        if (IN(pb + 12)) ph_peer_g3(p, le);
        SEAM(pb + 12);
        if (IN(pb + 13)) RUN(4, ph_s5_pass1(p, pair));
        SEAM(pb + 13);
        if (IN(pb + 14)) ph_s5_prefix(p, pair);
        SEAM(pb + 14);
        if (IN(pb + 15)) RUN(4, ph_s5_pass2(p, pair, lds));
        SEAM(pb + 15);
        if (IN(pb + 16)) RUN(0, ph_gemm_plain(lds, (const bf16_t*)(ws + WS_CAT), (const bf16_t*)(ws + WS_OD) + (size_t)pair * 4096 * 2048, (bf16_t*)(ws + WS_Z), 4096, DM, 4096, pair == 1)); if (IN(pb + 16) && pair == 0) ph_fill_table(p, 1, 1, (MROWS / 256) * (4096 / 256));
        SEAM(pb + 16);
        if (IN(pb + 17)) ph_ln_mix<true>(p, lod);
        SEAM(pb + 17);
        if (IN(pb + 18)) RUN(0, ph_gemm_plain(lds, (const bf16_t*)(ws + WS_XFFN), (const bf16_t*)(ws + WS_WQ) + (size_t)lod * 2048 * 2048, (bf16_t*)(ws + WS_PQ), DM, DM, DM, pair == 1)); if (IN(pb + 18) && pair == 0) ph_fill_table(p, 2, 0, (MROWS / 256) * (DM / 256));
        SEAM(pb + 18);
        if (IN(pb + 19)) RUN(3, ph_peer_topk(p, lod, lds));
        SEAM(pb + 19);
        if (IN(pb + 20)) RUN(7, ph_peer_g1(p, lod, lds));
        SEAM(pb + 20);
        if (IN(pb + 21)) RUN(9, ph_peer_g1b(p, lod));
        SEAM(pb + 21);
        if (IN(pb + 22)) RUN(8, ph_peer_g2(p, lod, lds));
        SEAM(pb + 22);
        if (IN(pb + 23)) ph_peer_g3(p, lod);
        SEAM(pb + 23);
    }
#undef IN
#undef SEAM
}

extern "C" void kernel_launch(void* const* d_in, const int* in_sizes, int n_in, void* d_out, int out_size, void* d_ws, size_t ws_size, hipStream_t stream) {
    static int grid = 0;
    if (grid == 0) {
        if (n_in != 41 || out_size != NB * SEQ * DM || ws_size < WS_END) {
            fprintf(stderr, "kernel_launch: built for 41 inputs, out %d, ws >= %zu; got n_in %d out %d ws %zu\n", NB * SEQ * DM, (size_t)WS_END, n_in, out_size, ws_size);
            grid = -1; return;
        }
        int dev = 0, cus = 0, per_cu = 0;
        if (hipGetDevice(&dev) != hipSuccess || hipDeviceGetAttribute(&cus, hipDeviceAttributeMultiprocessorCount, dev) != hipSuccess) { grid = -1; return; }
        if (hipFuncSetAttribute((const void*)hybrid_fwd, hipFuncAttributeMaxDynamicSharedMemorySize, LDS_BYTES) != hipSuccess) { fprintf(stderr, "kernel_launch: hipFuncSetAttribute failed\n"); grid = -1; return; }
        if (hipOccupancyMaxActiveBlocksPerMultiprocessor(&per_cu, (const void*)hybrid_fwd, NTHREADS, LDS_BYTES) != hipSuccess || per_cu < 1) {
            fprintf(stderr, "kernel_launch: occupancy query reports %d blocks per CU\n", per_cu); (void)hipGetLastError();
        }
        grid = (cus / 8) * 8;
    }
    if (grid < 0) return;
    (void)hipMemsetAsync((char*)d_ws + WS_CTL, 0, 16384, stream);
    Params a{};
    for (int i = 0; i < 41; ++i) a.in[i] = (const float*)d_in[i];
    a.out = (float*)d_out; a.ws = (unsigned char*)d_ws;
#if NLAUNCH == 1
    a.ph_lo = 0; a.ph_hi = N_PHASES;
    hipLaunchKernelGGL(hybrid_fwd, dim3(grid), dim3(NTHREADS), LDS_BYTES, stream, a);
#else
    for (int ph = 0; ph < N_PHASES; ++ph) {
        a.ph_lo = ph; a.ph_hi = ph + 1;
        hipLaunchKernelGGL(hybrid_fwd, dim3(grid), dim3(NTHREADS), LDS_BYTES, stream, a);
    }
#endif
    const hipError_t le = hipPeekAtLastError();
    if (le != hipSuccess) fprintf(stderr, "kernel_launch: launch failed: %s\n", hipGetErrorName(le));
}
```
